# Optimizing an MI355X kernel written in HIP

```python
import math
import jax, jax.numpy as jnp
from jax import lax
import numpy as np

D_MODEL = 2048
BATCH = 1
SEQ = 8192
DEPTH = 4

BLOCK = 128
DIFF_HEADS = 8
DIFF_QK_DIM = 64
DIFF_V_DIM = 2 * DIFF_QK_DIM
MLA_HEADS = 8
MLA_Q_RANK = 512
MLA_KV_RANK = 512
MLA_NOPE = 128
MLA_ROPE = 64
MLA_V = 128
GQA_HEADS = 8
GQA_KV_HEADS = 2
GQA_GROUP = GQA_HEADS // GQA_KV_HEADS
GQA_DIM = 128
WINDOW = 128
N_BRANCH = 3
BRANCH_WIDTH = 1024
MEM_LEN = 256
XA_HEADS = 4
XA_DIM = 128
D_FF = 5632
ROPE_THETA = 10000.0
EPS = 1e-6
DIFF_SUBLN_EPS = 1e-5
NEG_INF = -1e30

DIFF_Q_COLS = DIFF_HEADS * 2 * DIFF_QK_DIM
DIFF_K_COLS = DIFF_HEADS * 2 * DIFF_QK_DIM
DIFF_V_COLS = DIFF_HEADS * DIFF_V_DIM
GQA_Q_COLS = GQA_HEADS * GQA_DIM
GQA_KV_COLS = GQA_KV_HEADS * GQA_DIM
IN_WIDTHS = (DIFF_Q_COLS, DIFF_K_COLS, DIFF_V_COLS, MLA_Q_RANK, MLA_KV_RANK, MLA_ROPE,
             GQA_Q_COLS, GQA_KV_COLS, GQA_KV_COLS)
D_IN = sum(IN_WIDTHS)
IN_SPLITS = tuple(int(v) for v in np.cumsum(IN_WIDTHS)[:-1])

kernel_name = "hybrid_gated_diff_mla_swa_encoder"


def rms_norm(x, g, eps=EPS):
    xf = x.astype(jnp.float32)
    y = xf * lax.rsqrt(jnp.mean(xf * xf, axis=-1, keepdims=True) + eps)
    return (y * g.astype(jnp.float32)).astype(x.dtype)


def rope_tables(positions, dim):
    inv = ROPE_THETA ** (-jnp.arange(0, dim, 2, dtype=jnp.float32) / dim)
    ang = positions.astype(jnp.float32)[..., None] * inv
    return jnp.cos(ang), jnp.sin(ang)


def apply_rope(x, cos, sin):
    shape = cos.shape[:2] + (1,) * (x.ndim - 3) + cos.shape[-1:]
    c = cos.reshape(shape).astype(x.dtype)
    s = sin.reshape(shape).astype(x.dtype)
    x1, x2 = jnp.split(x, 2, axis=-1)
    return jnp.concatenate([x1 * c - x2 * s, x2 * c + x1 * s], axis=-1)


def to_query_blocks(t):
    b, s = t.shape[:2]
    t = t.reshape((b, s // BLOCK, BLOCK) + t.shape[2:])
    return jnp.moveaxis(t, 1, 0)


def from_query_blocks(t):
    t = jnp.moveaxis(t, 0, 1)
    return t.reshape((t.shape[0], t.shape[1] * t.shape[2]) + t.shape[3:])


def swiglu(x, w_gu, w_down):
    g, u = jnp.split(x @ w_gu, 2, axis=-1)
    return (jax.nn.silu(g) * u) @ w_down


def diff_attention(q, k, v, lam, sub_g, lambda_init):
    scale = DIFF_QK_DIM ** -0.5

    def block(qb):
        s = jnp.einsum('bqhcd,bkhcd->bhcqk', qb, k).astype(jnp.float32) * scale
        p = jax.nn.softmax(s, axis=-1)
        w = p[:, :, 0] - lam * p[:, :, 1]
        return jnp.einsum('bhqk,bkhd->bqhd', w.astype(v.dtype), v)

    o = from_query_blocks(lax.map(block, to_query_blocks(q)))
    o = rms_norm(o, sub_g, eps=DIFF_SUBLN_EPS) * (1.0 - lambda_init)
    return o.reshape(o.shape[:2] + (DIFF_HEADS * DIFF_V_DIM,))


def mla_attention(c_q, c_kv, k_rope, g_q, g_kv, w_uq, w_ukv, cos, sin):
    b, s = c_q.shape[:2]
    q = (rms_norm(c_q, g_q) @ w_uq).reshape(b, s, MLA_HEADS, MLA_NOPE + MLA_ROPE)
    q_nope = q[..., :MLA_NOPE]
    q_rope = apply_rope(q[..., MLA_NOPE:], cos, sin)
    kv = (rms_norm(c_kv, g_kv) @ w_ukv).reshape(b, s, MLA_HEADS, MLA_NOPE + MLA_V)
    k_nope = kv[..., :MLA_NOPE]
    v = kv[..., MLA_NOPE:]
    k_r = apply_rope(k_rope, cos, sin)
    scale = (MLA_NOPE + MLA_ROPE) ** -0.5

    def block(qs):
        qn, qr = qs
        sc = (jnp.einsum('bqhd,bkhd->bhqk', qn, k_nope).astype(jnp.float32)
              + jnp.einsum('bqhr,bkr->bhqk', qr, k_r).astype(jnp.float32)) * scale
        p = jax.nn.softmax(sc, axis=-1)
        return jnp.einsum('bhqk,bkhd->bqhd', p.astype(v.dtype), v)

    o = from_query_blocks(lax.map(block, (to_query_blocks(q_nope), to_query_blocks(q_rope))))
    return o.reshape(b, s, MLA_HEADS * MLA_V)


def window_gqa(q, k, v, sink):
    b, s = q.shape[:2]
    nb = s // BLOCK
    qb = q.reshape(b, nb, BLOCK, GQA_KV_HEADS, GQA_GROUP, GQA_DIM)

    def band(t):
        tb = t.reshape(b, nb, BLOCK, GQA_KV_HEADS, GQA_DIM)
        tp = jnp.pad(tb, ((0, 0), (1, 1), (0, 0), (0, 0), (0, 0)))
        return jnp.concatenate([tp[:, :-2], tp[:, 1:-1], tp[:, 2:]], axis=2)

    kb, vb = band(k), band(v)
    sc = jnp.einsum('bnqhgd,bnkhd->bnhgqk', qb, kb).astype(jnp.float32) * (GQA_DIM ** -0.5)
    r = jnp.arange(BLOCK)[:, None]
    c = jnp.arange(3 * BLOCK)[None, :]
    rel = c - BLOCK - r
    kpos = jnp.arange(nb)[:, None, None] * BLOCK - BLOCK + c
    valid = (jnp.abs(rel) <= WINDOW)[None] & (kpos >= 0) & (kpos < s)
    sc = jnp.where(valid[None, :, None, None], sc, NEG_INF)
    sink_col = jnp.broadcast_to(
        sink.astype(jnp.float32).reshape(1, 1, GQA_KV_HEADS, GQA_GROUP, 1, 1), sc.shape[:-1] + (1,))
    p = jax.nn.softmax(jnp.concatenate([sc, sink_col], axis=-1), axis=-1)[..., :-1]
    o = jnp.einsum('bnhgqk,bnkhd->bnqhgd', p.astype(v.dtype), vb)
    return o.reshape(b, s, GQA_HEADS * GQA_DIM)


def memory_cross_attention(hn, memn, wq, wkv, wo):
    b, s = hn.shape[:2]
    m = memn.shape[1]
    q = (hn @ wq).reshape(b, s, XA_HEADS, XA_DIM)
    kv = (memn @ wkv).reshape(b, m, 2, XA_HEADS, XA_DIM)
    sc = jnp.einsum('bqhd,bkhd->bhqk', q, kv[:, :, 0]).astype(jnp.float32) * (XA_DIM ** -0.5)
    p = jax.nn.softmax(sc, axis=-1)
    o = jnp.einsum('bhqk,bkhd->bqhd', p.astype(hn.dtype), kv[:, :, 1])
    return o.reshape(b, s, XA_HEADS * XA_DIM) @ wo


def setup_inputs(seed: int = 0) -> dict:
    key = jax.random.key(seed)
    ks = jax.random.split(key, 32)
    f32 = jnp.float32

    def w(k, shape, fan_in):
        return jax.random.normal(k, shape, f32) * (fan_in ** -0.5)

    def gain(k, shape):
        return 1.0 + 0.02 * jax.random.normal(k, shape, f32)

    L, D = DEPTH, D_MODEL
    return {
        'x': jax.random.normal(ks[0], (BATCH, SEQ, D), f32),
        'mem': jax.random.normal(ks[1], (BATCH, MEM_LEN, D), f32),
        'positions': jnp.broadcast_to(jnp.arange(SEQ, dtype=jnp.int32), (BATCH, SEQ)),
        'ffn1_norm': gain(ks[2], (L, D)),
        'ffn1_w_gu': w(ks[3], (L, D, 2 * D_FF), D),
        'ffn1_w_down': w(ks[4], (L, D_FF, D), D_FF),
        'mix_norm': gain(ks[5], (L, D)),
        'w_in': w(ks[6], (L, D, D_IN), D),
        'diff_lambda': 0.1 * jax.random.normal(ks[7], (L, 4, DIFF_QK_DIM), f32),
        'diff_subln': gain(ks[8], (L, DIFF_V_DIM)),
        'mla_q_norm': gain(ks[9], (L, MLA_Q_RANK)),
        'mla_kv_norm': gain(ks[10], (L, MLA_KV_RANK)),
        'mla_w_uq': w(ks[11], (L, MLA_Q_RANK, MLA_HEADS * (MLA_NOPE + MLA_ROPE)), MLA_Q_RANK),
        'mla_w_ukv': w(ks[12], (L, MLA_KV_RANK, MLA_HEADS * (MLA_NOPE + MLA_V)), MLA_KV_RANK),
        'gqa_sink': 0.5 * jax.random.normal(ks[13], (L, GQA_HEADS), f32),
        'w_branch': w(ks[14], (L, N_BRANCH, BRANCH_WIDTH, D), BRANCH_WIDTH),
        'w_gate': w(ks[15], (L, D, N_BRANCH * D), D),
        'b_gate': 0.02 * jax.random.normal(ks[16], (L, N_BRANCH * D), f32),
        'w_o': w(ks[17], (L, D, D), D),
        'xa_norm': gain(ks[18], (L, D)),
        'mem_norm': gain(ks[19], (L, D)),
        'xa_wq': w(ks[20], (L, D, XA_HEADS * XA_DIM), D),
        'xa_wkv': w(ks[21], (L, D, 2 * XA_HEADS * XA_DIM), D),
        'xa_wo': w(ks[22], (L, XA_HEADS * XA_DIM, D), XA_HEADS * XA_DIM),
        'ffn2_norm': gain(ks[23], (L, D)),
        'ffn2_w_gu': w(ks[24], (L, D, 2 * D_FF), D),
        'ffn2_w_down': w(ks[25], (L, D_FF, D), D_FF),
        'final_norm': gain(ks[26], (D,)),
    }


def reference(x, mem, positions, ffn1_norm, ffn1_w_gu, ffn1_w_down, mix_norm, w_in,
              diff_lambda, diff_subln, mla_q_norm, mla_kv_norm, mla_w_uq, mla_w_ukv,
              gqa_sink, w_branch, w_gate, b_gate, w_o, xa_norm, mem_norm, xa_wq, xa_wkv,
              xa_wo, ffn2_norm, ffn2_w_gu, ffn2_w_down, final_norm):
    b, s, d = x.shape
    cos64, sin64 = rope_tables(positions, DIFF_QK_DIM)
    cos128, sin128 = rope_tables(positions, GQA_DIM)
    h = x
    for l in range(DEPTH):
        lambda_init = 0.8 - 0.6 * math.exp(-0.3 * l)
        h = h + 0.5 * swiglu(rms_norm(h, ffn1_norm[l]), ffn1_w_gu[l], ffn1_w_down[l])

        u = rms_norm(h, mix_norm[l])
        dq, dk, dv, cq, ckv, kr, gq, gk, gv = jnp.split(u @ w_in[l], IN_SPLITS, axis=-1)

        dq = apply_rope(dq.reshape(b, s, DIFF_HEADS, 2, DIFF_QK_DIM), cos64, sin64)
        dk = apply_rope(dk.reshape(b, s, DIFF_HEADS, 2, DIFF_QK_DIM), cos64, sin64)
        dv = dv.reshape(b, s, DIFF_HEADS, DIFF_V_DIM)
        lp = diff_lambda[l].astype(jnp.float32)
        lam = jnp.exp(jnp.sum(lp[0] * lp[1])) - jnp.exp(jnp.sum(lp[2] * lp[3])) + lambda_init
        o_diff = diff_attention(dq, dk, dv, lam, diff_subln[l], lambda_init)

        o_mla = mla_attention(cq, ckv, kr, mla_q_norm[l], mla_kv_norm[l],
                              mla_w_uq[l], mla_w_ukv[l], cos64, sin64)

        gq = apply_rope(gq.reshape(b, s, GQA_HEADS, GQA_DIM), cos128, sin128)
        gk = apply_rope(gk.reshape(b, s, GQA_KV_HEADS, GQA_DIM), cos128, sin128)
        gv = gv.reshape(b, s, GQA_KV_HEADS, GQA_DIM)
        o_gqa = window_gqa(gq, gk, gv, gqa_sink[l])

        branches = jnp.stack([o_diff, o_mla, o_gqa], axis=2)
        gate = jax.nn.sigmoid((u @ w_gate[l] + b_gate[l]).astype(jnp.float32))
        gate = gate.astype(u.dtype).reshape(b, s, N_BRANCH, d)
        merged = jnp.sum(jnp.einsum('bsne,ned->bsnd', branches, w_branch[l]) * gate, axis=2)
        h = h + merged @ w_o[l]

        h = h + memory_cross_attention(rms_norm(h, xa_norm[l]), rms_norm(mem, mem_norm[l]),
                                       xa_wq[l], xa_wkv[l], xa_wo[l])

        h = h + 0.5 * swiglu(rms_norm(h, ffn2_norm[l]), ffn2_w_gu[l], ffn2_w_down[l])
    return rms_norm(h, final_norm)
```

```cpp
#include <hip/hip_runtime.h>
#include <cstdio>
#include <cmath>
#include <cstdint>
#ifndef MK_PER_PHASE
#define MK_PER_PHASE 0
#endif
#ifndef MK_ONLY
#define MK_ONLY -1
#endif
#ifndef MK_DUP
#define MK_DUP -1
#endif
namespace pg8 {
#define PG8_LAS __attribute__((address_space(3)))
typedef unsigned short bf16_t;
typedef short bf16x8 __attribute__((ext_vector_type(8)));
typedef float f32x4 __attribute__((ext_vector_type(4)));
typedef unsigned u32x4 __attribute__((ext_vector_type(4)));
constexpr int BM = 256, BK = 64, HALF = 128, HTB = HALF * BK * 2, STAGE_BYTES = 8 * HTB, NXCD = 8, WGM = 8;

__host__ __device__ __forceinline__ int lds_byte(int r, int c) { const int st = (r >> 4) * 2 + (c >> 5), rr = r & 15, cc = c & 31, ob = rr * 64 + cc * 2; return st * 1024 + (ob ^ (((ob >> 9) & 1) << 5)); }
__host__ __device__ __forceinline__ void stage_rc(int b, int& R, int& C) { const int st = b / 1024, sb = b % 1024, swz = sb ^ (((sb >> 9) & 1) << 5); R = (st >> 1) * 16 + swz / 64; C = (st & 1) * 32 + (swz % 64) / 2; }
__host__ __device__ __forceinline__ int perm32(int rho) { const int n = rho >> 4, i = rho & 15; return 8 * (i >> 2) + 4 * n + (i & 3); }

struct Unit { int pm, pn; };
struct Gemm { const bf16_t* A; const bf16_t* Bt; int M, N, K; };

struct StaticOrder {
    int nM, nN, nwg, G, c;
    __host__ __device__ void init(int M, int N, int G_, int c_) { nM = M / BM; nN = N / BM; nwg = nM * nN; G = G_; c = c_; }
    __host__ __device__ bool map(int L, Unit& u) const {
        if (L >= nwg) return false;
        int wgid = (int)L; { const int q = nwg / NXCD, r = nwg % NXCD, xcd = wgid % NXCD, off = wgid / NXCD; wgid = (xcd < r ? xcd * (q + 1) : r * (q + 1) + (xcd - r) * q) + off; }
        const int nig = WGM * nN, gid = wgid / nig, fm = gid * WGM, gsz = (nM - fm) < WGM ? (nM - fm) : WGM;
        u.pm = fm + ((wgid % nig) % gsz); u.pn = (wgid % nig) / gsz; return true;
    }
    __host__ __device__ bool next(int i, Unit& u) const { return map(i * G + c, u); }
    __device__ __forceinline__ void a_ready(const Unit&) const {}
    __device__ __forceinline__ void done(const Unit&) const {}
};

__device__ __forceinline__ unsigned cvt_pk_bf16(float lo, float hi) { unsigned r; asm volatile("v_cvt_pk_bf16_f32 %0, %1, %2" : "=v"(r) : "v"(lo), "v"(hi)); return r; }
__device__ __forceinline__ u32x4 pack8(const f32x4 v0, const f32x4 v1) { u32x4 w; w.x = cvt_pk_bf16(v0[0], v0[1]); w.y = cvt_pk_bf16(v0[2], v0[3]); w.z = cvt_pk_bf16(v1[0], v1[1]); w.w = cvt_pk_bf16(v1[2], v1[3]); return w; }
__device__ __forceinline__ void unpack8(const u32x4 w, f32x4& v0, f32x4& v1) {
    v0[0] = __uint_as_float(w.x << 16); v0[1] = __uint_as_float(w.x & 0xffff0000u); v0[2] = __uint_as_float(w.y << 16); v0[3] = __uint_as_float(w.y & 0xffff0000u);
    v1[0] = __uint_as_float(w.z << 16); v1[1] = __uint_as_float(w.z & 0xffff0000u); v1[2] = __uint_as_float(w.w << 16); v1[3] = __uint_as_float(w.w & 0xffff0000u); }

template <class Epi, class Sched, bool ALIGN_EPI = true, bool SP2 = true>
__device__ __forceinline__ void gemm_phase(PG8_LAS unsigned char* lds, const Gemm g, const Sched& S, const Epi& E) {
    int tid = threadIdx.x; asm volatile("" : "+v"(tid));
    const int wid = __builtin_amdgcn_readfirstlane(tid >> 6), lane = tid & 63, wr = wid >> 2, wc = wid & 3, fr = lane & 15, fq = lane >> 4;
    const int K = g.K, nt = K / BK;
    unsigned voffA[2], voffB[2];
#pragma unroll
    for (int i = 0; i < 2; ++i) { int R, C; stage_rc(tid * 16 + i * 8192, R, C); const int Rb = Epi::PERM ? ((R & ~31) + perm32(R & 31)) : R;
        voffA[i] = (unsigned)(R * K + C) * 2u; voffB[i] = (unsigned)(Rb * K + C) * 2u; }
    const size_t kstep = (size_t)(BK * 2);
    const size_t hstep = (size_t)HALF * K * 2;
    const size_t tstep = 2 * hstep;
    const unsigned ldsw = (unsigned)wid * 1024u;
    const int aoff = lds_byte(wr * 64 + fr, fq * 8), boff = lds_byte(wc * 32 + fr, fq * 8);
#define PG8_SA(b, h) (((b) * 2 + (h)) * HTB)
#define PG8_SB(b, h) ((4 + (b) * 2 + (h)) * HTB)
#define PG8_STAGE(bufoff, gbase, voff) do { _Pragma("unroll") for (int _i = 0; _i < 2; ++_i) \
        __builtin_amdgcn_global_load_lds((const unsigned*)((const char*)(gbase) + (voff)[_i]), (PG8_LAS unsigned*)(lds + (bufoff) + ldsw + _i * 8192), 16, 0, 0); } while (0)
#define PG8_LDA(dst, b, h) do { _Pragma("unroll") for (int m = 0; m < 4; ++m) _Pragma("unroll") for (int k = 0; k < 2; ++k) dst[m][k] = *(const PG8_LAS bf16x8*)(lds + PG8_SA(b, h) + aoff + m * 2048 + k * 1024); } while (0)
#define PG8_LDB(dst, b, h) do { _Pragma("unroll") for (int n = 0; n < 2; ++n) _Pragma("unroll") for (int k = 0; k < 2; ++k) dst[n][k] = *(const PG8_LAS bf16x8*)(lds + PG8_SB(b, h) + boff + n * 2048 + k * 1024); } while (0)
#define PG8_MMA(ai, bj, At, Bt) do { __builtin_amdgcn_s_setprio(1); _Pragma("unroll") for (int m = 0; m < 4; ++m) _Pragma("unroll") for (int n = 0; n < 2; ++n) _Pragma("unroll") for (int k = 0; k < 2; ++k) \
        acc[ai][bj][m][n] = __builtin_amdgcn_mfma_f32_16x16x32_bf16(Bt[n][k], At[m][k], acc[ai][bj][m][n], 0, 0, 0); __builtin_amdgcn_s_setprio(0); } while (0)
#define PG8_WAIT_V(n) asm volatile("s_waitcnt vmcnt(" #n ")" ::: "memory")
#define PG8_WAIT_L(n) asm volatile("s_waitcnt lgkmcnt(" #n ")" ::: "memory")
#define PG8_BAR __builtin_amdgcn_s_barrier()
#define PG8_SCHED __builtin_amdgcn_sched_barrier(0)
    Unit cur, nxt; int ui = 0;
    if (!S.next(0, cur)) return;
    f32x4 acc[2][2][4][2];
#pragma unroll
    for (int a = 0; a < 2; ++a)
#pragma unroll
        for (int b = 0; b < 2; ++b)
#pragma unroll
            for (int m = 0; m < 4; ++m)
#pragma unroll
                for (int n = 0; n < 2; ++n) acc[a][b][m][n] = (f32x4){0.f, 0.f, 0.f, 0.f};
    bf16x8 At[4][2], B0[2][2], B1[2][2];
    const char* cA = (const char*)g.A + (size_t)cur.pm * tstep; const char* cB = (const char*)g.Bt + (size_t)cur.pn * tstep;
    S.a_ready(cur);
    if constexpr (SP2) {
        PG8_STAGE(PG8_SB(0, 0), cB, voffB); PG8_STAGE(PG8_SB(0, 1), cB + hstep, voffB); PG8_STAGE(PG8_SA(0, 0), cA, voffA); PG8_STAGE(PG8_SA(0, 1), cA + hstep, voffA);
        if (wr == 1) PG8_BAR;
        PG8_WAIT_V(2); PG8_BAR;
        PG8_STAGE(PG8_SB(1, 0), cB + kstep, voffB); PG8_STAGE(PG8_SA(1, 0), cA + kstep, voffA); PG8_STAGE(PG8_SB(1, 1), cB + hstep + kstep, voffB);
        PG8_WAIT_V(6); PG8_BAR;
    } else {
        PG8_STAGE(PG8_SB(0, 0), cB, voffB); PG8_STAGE(PG8_SA(0, 0), cA, voffA); PG8_STAGE(PG8_SB(0, 1), cB + hstep, voffB); PG8_STAGE(PG8_SA(0, 1), cA + hstep, voffA);
        if (wr == 1) PG8_BAR;
        PG8_WAIT_V(4); PG8_BAR;
        PG8_STAGE(PG8_SB(1, 0), cB + kstep, voffB); PG8_STAGE(PG8_SA(1, 0), cA + kstep, voffA); PG8_STAGE(PG8_SB(1, 1), cB + hstep + kstep, voffB);
        PG8_WAIT_V(6); PG8_BAR;
    }
    for (;;) {
        const bool has_next = S.next(ui + 1, nxt);
        const char* nA = has_next ? (const char*)g.A + (size_t)nxt.pm * tstep : cA; const char* nB = has_next ? (const char*)g.Bt + (size_t)nxt.pn * tstep : cB;
        for (int t = 0; t < nt; t += 2) {
            const bool last = (t == nt - 2);
            const char* a1 = cA + (size_t)(t + 1) * kstep;
            const char* a2 = last ? nA : cA + (size_t)(t + 2) * kstep; const char* b2 = last ? nB : cB + (size_t)(t + 2) * kstep;
            const char* a3 = a2 + kstep; const char* b3 = b2 + kstep;
            if (last && has_next) S.a_ready(nxt);
            if constexpr (SP2) {
            PG8_LDB(B0, 0, 0); PG8_LDB(B1, 0, 1); PG8_SCHED; PG8_LDA(At, 0, 0); PG8_STAGE(PG8_SA(1, 1), a1 + hstep, voffA);
            PG8_WAIT_V(8); PG8_WAIT_L(0); PG8_BAR; PG8_MMA(0, 0, At, B0); PG8_MMA(0, 1, At, B1); PG8_BAR; PG8_SCHED;
            PG8_LDA(At, 0, 1); PG8_STAGE(PG8_SB(0, 0), b2, voffB); PG8_STAGE(PG8_SB(0, 1), b2 + hstep, voffB); PG8_STAGE(PG8_SA(0, 0), a2, voffA);
            PG8_WAIT_V(8); PG8_WAIT_L(0); PG8_BAR; PG8_MMA(1, 0, At, B0); PG8_MMA(1, 1, At, B1); PG8_BAR; PG8_SCHED;
            PG8_LDB(B0, 1, 0); PG8_LDB(B1, 1, 1); PG8_SCHED; PG8_LDA(At, 1, 0); PG8_STAGE(PG8_SA(0, 1), a2 + hstep, voffA);
            PG8_WAIT_V(8); PG8_WAIT_L(0); PG8_BAR; PG8_MMA(0, 0, At, B0); PG8_MMA(0, 1, At, B1); PG8_BAR; PG8_SCHED;
            PG8_LDA(At, 1, 1); PG8_STAGE(PG8_SB(1, 0), b3, voffB); PG8_STAGE(PG8_SB(1, 1), b3 + hstep, voffB); PG8_STAGE(PG8_SA(1, 0), a3, voffA);
            PG8_WAIT_V(8); PG8_WAIT_L(0); PG8_BAR; PG8_MMA(1, 0, At, B0); PG8_MMA(1, 1, At, B1); PG8_BAR; PG8_SCHED;
            } else {
            PG8_LDB(B0, 0, 0); PG8_SCHED; PG8_LDA(At, 0, 0); PG8_STAGE(PG8_SA(1, 1), a1 + hstep, voffA);
            PG8_WAIT_L(8); PG8_BAR; PG8_WAIT_L(0); PG8_MMA(0, 0, At, B0); PG8_BAR; PG8_SCHED;
            PG8_LDB(B1, 0, 1); PG8_STAGE(PG8_SB(0, 0), b2, voffB);
            PG8_BAR; PG8_WAIT_L(0); PG8_MMA(0, 1, At, B1); PG8_BAR;
            PG8_LDA(At, 0, 1); PG8_STAGE(PG8_SA(0, 0), a2, voffA);
            PG8_BAR; PG8_WAIT_L(0); PG8_MMA(1, 0, At, B0); PG8_BAR; PG8_SCHED;
            PG8_STAGE(PG8_SB(0, 1), b2 + hstep, voffB);
            PG8_WAIT_V(6); PG8_BAR; PG8_MMA(1, 1, At, B1); PG8_BAR;
            PG8_LDB(B0, 1, 0); PG8_SCHED; PG8_LDA(At, 1, 0); PG8_STAGE(PG8_SA(0, 1), a2 + hstep, voffA);
            PG8_WAIT_L(8); PG8_BAR; PG8_WAIT_L(0); PG8_MMA(0, 0, At, B0); PG8_BAR; PG8_SCHED;
            PG8_LDB(B1, 1, 1); PG8_STAGE(PG8_SB(1, 0), b3, voffB);
            PG8_BAR; PG8_WAIT_L(0); PG8_MMA(0, 1, At, B1); PG8_BAR;
            PG8_LDA(At, 1, 1); PG8_STAGE(PG8_SA(1, 0), a3, voffA);
            PG8_BAR; PG8_WAIT_L(0); PG8_MMA(1, 0, At, B0); PG8_BAR; PG8_SCHED;
            PG8_STAGE(PG8_SB(1, 1), b3 + hstep, voffB);
            PG8_WAIT_V(6); PG8_BAR; PG8_MMA(1, 1, At, B1); PG8_BAR;
            }
        }
        if constexpr (ALIGN_EPI) { if (wr == 0) PG8_BAR; }
        E(acc, cur, wr, wc, fr, fq); S.done(cur);
        if (!has_next) break;
        bool keep = false;
        if constexpr (Epi::CHAIN) keep = E.keep(cur);
        if (!keep) {
#pragma unroll
        for (int a = 0; a < 2; ++a)
#pragma unroll
            for (int b = 0; b < 2; ++b)
#pragma unroll
                for (int m = 0; m < 4; ++m)
#pragma unroll
                    for (int n = 0; n < 2; ++n) acc[a][b][m][n] = (f32x4){0.f, 0.f, 0.f, 0.f};
        }
        cur = nxt; cA = nA; cB = nB; ++ui;
        if constexpr (ALIGN_EPI) { if (wr == 1) PG8_BAR; }
    }
    PG8_WAIT_V(0);
    if constexpr (!ALIGN_EPI) { if (wr == 0) PG8_BAR; }
    PG8_BAR;
#undef PG8_SA
#undef PG8_SB
#undef PG8_STAGE
#undef PG8_LDA
#undef PG8_LDB
#undef PG8_MMA
#undef PG8_WAIT_V
#undef PG8_WAIT_L
#undef PG8_BAR
#undef PG8_SCHED
}
}
namespace mk {
using pg8::bf16_t; using pg8::f32x4; using pg8::u32x4; using pg8::Unit; using pg8::pack8; using pg8::unpack8;
constexpr int S = 8192, D = 2048, DEPTH = 4, DFF = 5632, DIN = 5696, MEMLEN = 256;
constexpr int NIN = 12032;
constexpr float LOG2E = 1.4426950408889634f;

#define GA1 __attribute__((address_space(1)))
#define LA3 __attribute__((address_space(3)))
typedef float rss_t;
constexpr int RSS_LDS_OFF = 131072 + 1024;
__device__ __forceinline__ float rss_rstd(const rss_t* p  , float inv_n) {
    const f32x4 a = *(const GA1 f32x4*)p, b = *(const GA1 f32x4*)(p + 4);
    return rsqrtf((((a[0] + a[1]) + (a[2] + a[3])) + ((b[0] + b[1]) + (b[2] + b[3]))) * inv_n + 1e-6f);
}
typedef float f32x2e __attribute__((ext_vector_type(2)));
__device__ __forceinline__ float rss_rstd2(const rss_t* p  , float inv_n) { const f32x2e a = *(const GA1 f32x2e*)p; return rsqrtf((a[0] + a[1]) * inv_n + 1e-6f); }
__device__ __forceinline__ void rss_reduce_store(const float (&ssv)[2][4], int wr, int wc, int fr, int fq, LA3 unsigned char* ldsbase, rss_t* out, int stride) {
    LA3 float* P = (LA3 float*)(ldsbase + RSS_LDS_OFF);
    if (fq == 0) {
#pragma unroll
        for (int ai = 0; ai < 2; ++ai)
#pragma unroll
            for (int m = 0; m < 4; ++m) P[(ai * 128 + wr * 64 + m * 16 + fr) * 4 + wc] = ssv[ai][m]; }
    asm volatile("s_waitcnt lgkmcnt(0)" ::: "memory"); __builtin_amdgcn_s_barrier(); asm volatile("" ::: "memory");
    const int t = (wr * 4 + wc) * 64 + fq * 16 + fr;
    if (t < 256) { const LA3 f32x4* pr = (const LA3 f32x4*)(P + t * 4); const f32x4 v = *pr; ((GA1 rss_t*)out)[(size_t)t * stride] = (v[0] + v[1]) + (v[2] + v[3]); }
}
__device__ __forceinline__ float fast_sigmoid(float x) { return __builtin_amdgcn_rcpf(1.f + __builtin_amdgcn_exp2f(-x * LOG2E)); }


struct EpiSwiglu {
    static constexpr bool PERM = true, CHAIN = false;
    bf16_t* HID; const rss_t* rss;
    __device__ __forceinline__ void operator()(f32x4 (&acc)[2][2][4][2], const Unit& u, int wr, int wc, int fr, int fq) const {
        const int row0 = u.pm * 256 + wr * 64 + fr, col = u.pn * 128 + wc * 32 + 8 * fq;
        float rsv[2][4];
#pragma unroll
        for (int ai = 0; ai < 2; ++ai)
#pragma unroll
            for (int m = 0; m < 4; ++m) rsv[ai][m] = rss_rstd(rss + (size_t)(row0 + ai * 128 + m * 16) * 8, 1.f / D);
#pragma unroll
        for (int ai = 0; ai < 2; ++ai)
#pragma unroll
            for (int m = 0; m < 4; ++m) {
                const float rs = rsv[ai][m];
                f32x4 h0, h1;
#pragma unroll
                for (int j = 0; j < 4; ++j) { const float g0 = acc[ai][0][m][0][j] * rs, g1 = acc[ai][0][m][1][j] * rs;
                    h0[j] = g0 * fast_sigmoid(g0) * (acc[ai][1][m][0][j] * rs); h1[j] = g1 * fast_sigmoid(g1) * (acc[ai][1][m][1][j] * rs); }
                *(GA1 u32x4*)(HID + (size_t)(row0 + ai * 128 + m * 16) * DFF + col) = pack8(h0, h1);
            }
    }
};
struct EpiResid {
    static constexpr bool PERM = true, CHAIN = false;
    float* H; float alpha; bf16_t* an; rss_t* rss; LA3 unsigned char* ldsb;
    __device__ __forceinline__ void operator()(f32x4 (&acc)[2][2][4][2], const Unit& u, int wr, int wc, int fr, int fq) const {
        const int row0 = u.pm * 256 + wr * 64 + fr, col0 = u.pn * 256 + wc * 32 + 8 * fq;
        float ssv[2][4];
#pragma unroll
        for (int ai = 0; ai < 2; ++ai) {
            f32x4 h[4][2][2];
#pragma unroll
            for (int m = 0; m < 4; ++m) { const float* rp = H + (size_t)(row0 + ai * 128 + m * 16) * D + col0;
#pragma unroll
                for (int bj = 0; bj < 2; ++bj)
#pragma unroll
                    for (int n = 0; n < 2; ++n) h[m][bj][n] = *(const GA1 f32x4*)(rp + bj * 128 + 4 * n); }
#pragma unroll
            for (int m = 0; m < 4; ++m) { const int row = row0 + ai * 128 + m * 16; float* rp = H + (size_t)row * D + col0; float ss = 0.f;
#pragma unroll
                for (int bj = 0; bj < 2; ++bj) {
#pragma unroll
                    for (int n = 0; n < 2; ++n) { const f32x4 v = h[m][bj][n] + acc[ai][bj][m][n] * alpha; h[m][bj][n] = v; *(GA1 f32x4*)(rp + bj * 128 + 4 * n) = v;
                        ss += (v[0] * v[0] + v[1] * v[1]) + (v[2] * v[2] + v[3] * v[3]); }
                    if (an) *(GA1 u32x4*)(an + (size_t)row * D + col0 + bj * 128) = pack8(h[m][bj][0], h[m][bj][1]); }
                ss += __shfl_xor(ss, 16); ss += __shfl_xor(ss, 32); ssv[ai][m] = ss; }
        }
        if (an) rss_reduce_store(ssv, wr, wc, fr, fq, ldsb, rss + (size_t)u.pm * 256 * 8 + u.pn, 8);
    }
};
struct EpiPlain {
    static constexpr bool PERM = true, CHAIN = false;
    bf16_t* O; int ldc; int npp; const rss_t* rss;
    __device__ __forceinline__ void operator()(f32x4 (&acc)[2][2][4][2], const Unit& u, int wr, int wc, int fr, int fq) const {
        const int row0 = u.pm * 256 + wr * 64 + fr, col0 = (u.pn - u.pm * npp) * 256 + wc * 32 + 8 * fq;
        float rsv[2][4];
#pragma unroll
        for (int ai = 0; ai < 2; ++ai)
#pragma unroll
            for (int m = 0; m < 4; ++m) rsv[ai][m] = rss ? rss_rstd(rss + (size_t)(row0 + ai * 128 + m * 16) * 8, 1.f / D) : 1.f;
#pragma unroll
        for (int ai = 0; ai < 2; ++ai)
#pragma unroll
            for (int m = 0; m < 4; ++m) { const int row = row0 + ai * 128 + m * 16; bf16_t* rp = O + (size_t)row * ldc + col0;
                const float rs = rsv[ai][m];
#pragma unroll
                for (int bj = 0; bj < 2; ++bj) *(GA1 u32x4*)(rp + bj * 128) = pack8(acc[ai][bj][m][0] * rs, acc[ai][bj][m][1] * rs); }
    }
};
__device__ __forceinline__ void rope8_apply(f32x4& v0, f32x4& v1, const f32x4 t0, const f32x4 t1) {
    const f32x4 c = {t0[0], t0[2], t1[0], t1[2]}, s = {t0[1], t0[3], t1[1], t1[3]};
    const f32x4 y1 = v0 * c - v1 * s, y2 = v1 * c + v0 * s; v0 = y1; v1 = y2;
}
__device__ __forceinline__ void rope8(f32x4& v0, f32x4& v1, const float2* cs) { rope8_apply(v0, v1, *(const GA1 f32x4*)cs, *(const GA1 f32x4*)(cs + 2)); }
struct EpiIn {
    static constexpr bool PERM = true, CHAIN = false;
    bf16_t *QD, *KD, *VD, *CQR, *CKVR, *QG, *KG, *VG, *KM, *GATE; const float2 *cs64, *cs128; const float* bg; const rss_t* rss; rss_t* rssm; LA3 unsigned char* ldsb;
    __device__ __forceinline__ void operator()(f32x4 (&acc)[2][2][4][2], const Unit& u, int wr, int wc, int fr, int fq) const {
        const int pn = u.pn, row0 = u.pm * 256 + wr * 64 + fr, c8 = wc * 32 + 8 * fq;
        int kind, ld, colt; bf16_t* base;
        if (pn < 4)        { kind = 1; base = QD;   ld = 1024; colt = 256 * pn; }
        else if (pn < 8)   { kind = 1; base = KD;   ld = 1024; colt = 256 * (pn - 4); }
        else if (pn < 12)  { kind = 0; base = VD;   ld = 1024; colt = 256 * (pn - 8); }
        else if (pn < 14)  { kind = 0; base = CQR;  ld = 512;  colt = 256 * (pn - 12); }
        else if (pn < 16)  { kind = 0; base = CKVR; ld = 512;  colt = 256 * (pn - 14); }
        else if (pn < 20)  { kind = 2; base = QG;   ld = 1024; colt = 256 * (pn - 16); }
        else if (pn == 20) { kind = 2; base = KG;   ld = 256;  colt = 0; }
        else if (pn == 21) { kind = 0; base = VG;   ld = 256;  colt = 0; }
        else if (pn == 22) { kind = 4; base = KM;   ld = 1536; colt = 0; }
        else               { kind = 3; base = GATE; ld = 6144; colt = 256 * (pn - 23); }
        float rsv[2][4];
#pragma unroll
        for (int ai = 0; ai < 2; ++ai)
#pragma unroll
            for (int m = 0; m < 4; ++m) rsv[ai][m] = rss_rstd(rss + (size_t)(row0 + ai * 128 + m * 16) * 8, 1.f / D);
        if (pn >= 12 && pn < 16) {
            float ssv[2][4];
#pragma unroll
            for (int ai = 0; ai < 2; ++ai)
#pragma unroll
                for (int m = 0; m < 4; ++m) { const int row = row0 + ai * 128 + m * 16; const float rs = rsv[ai][m]; float ss = 0.f;
#pragma unroll
                    for (int bj = 0; bj < 2; ++bj) { const f32x4 v0 = acc[ai][bj][m][0] * rs, v1 = acc[ai][bj][m][1] * rs;
                        ss += (v0[0] * v0[0] + v0[1] * v0[1]) + (v0[2] * v0[2] + v0[3] * v0[3]) + (v1[0] * v1[0] + v1[1] * v1[1]) + (v1[2] * v1[2] + v1[3] * v1[3]);
                        *(GA1 u32x4*)(base + (size_t)row * ld + colt + bj * 128 + c8) = pack8(v0, v1); }
                    ss += __shfl_xor(ss, 16); ss += __shfl_xor(ss, 32); ssv[ai][m] = ss; }
            if (rssm) rss_reduce_store(ssv, wr, wc, fr, fq, ldsb, rssm + ((size_t)(pn >= 14 ? S : 0) + (size_t)u.pm * 256) * 2 + (pn & 1), 2);
            return;
        }
#pragma unroll
        for (int ai = 0; ai < 2; ++ai)
#pragma unroll
            for (int m = 0; m < 4; ++m) { const int row = row0 + ai * 128 + m * 16; const float rs = rsv[ai][m];
#pragma unroll
                for (int bj = 0; bj < 2; ++bj) { const int col = colt + bj * 128 + c8; f32x4 v0 = acc[ai][bj][m][0] * rs, v1 = acc[ai][bj][m][1] * rs;
                    if (kind == 1) rope8(v0, v1, cs64 + (size_t)row * 32 + ((col & 63) >> 3) * 4);
                    else if (kind == 2) rope8(v0, v1, cs128 + (size_t)row * 64 + ((col & 127) >> 3) * 4);
                    else if (kind == 3) { const f32x4 b0 = *(const GA1 f32x4*)(bg + col), b1 = *(const GA1 f32x4*)(bg + col + 4);
#pragma unroll
                        for (int j = 0; j < 4; ++j) { v0[j] = fmaxf(fast_sigmoid(v0[j] + b0[j]), 1e-20f); v1[j] = fmaxf(fast_sigmoid(v1[j] + b1[j]), 1e-20f); } }
                    if (kind == 4) {
                        if (bj == 0 && wc < 2) { rope8(v0, v1, cs64 + (size_t)row * 32 + (c8 >> 3) * 4); const u32x4 w = pack8(v0, v1);
#pragma unroll
                            for (int h = 0; h < 8; ++h) *(GA1 u32x4*)(KM + (size_t)row * 1536 + h * 192 + 128 + c8) = w; }
                    } else *(GA1 u32x4*)(base + (size_t)row * ld + col) = pack8(v0, v1);
                } }
    }
};
struct EpiMlaUp {
    static constexpr bool PERM = true, CHAIN = false;
    bf16_t *QM, *KM, *VM; const float2* cs64; const rss_t* rssm;
    __device__ __forceinline__ void operator()(f32x4 (&acc)[2][2][4][2], const Unit& u, int wr, int wc, int fr, int fq) const {
        const int c8 = wc * 32 + 8 * fq;
        if (u.pm < 32) {
            const int row0 = u.pm * 256 + wr * 64 + fr;
            float rsv[2][4];
#pragma unroll
            for (int ai = 0; ai < 2; ++ai)
#pragma unroll
                for (int m = 0; m < 4; ++m) rsv[ai][m] = rss_rstd2(rssm + (size_t)(row0 + ai * 128 + m * 16) * 2, 1.f / 512.f);
#pragma unroll
            for (int bj = 0; bj < 2; ++bj) { const int col = u.pn * 256 + bj * 128 + c8, p = col % 192; const bool rp = p >= 128; const int a = rp ? ((p - 128) >> 3) : 0;
#pragma unroll
                for (int ai = 0; ai < 2; ++ai) {
                    f32x4 tb[4][2];
#pragma unroll
                    for (int m = 0; m < 4; ++m) { const float2* cs = cs64 + (size_t)(row0 + ai * 128 + m * 16) * 32 + a * 4; tb[m][0] = *(const GA1 f32x4*)cs; tb[m][1] = *(const GA1 f32x4*)(cs + 2); }
#pragma unroll
                    for (int m = 0; m < 4; ++m) { const int row = row0 + ai * 128 + m * 16; const float rs = rsv[ai][m]; f32x4 v0 = acc[ai][bj][m][0] * rs, v1 = acc[ai][bj][m][1] * rs;
                        if (rp) rope8_apply(v0, v1, tb[m][0], tb[m][1]);
                        *(GA1 u32x4*)(QM + (size_t)row * 1536 + col) = pack8(v0, v1); } } }
        } else {
            const int row0 = (u.pm - 32) * 256 + wr * 64 + fr, h = u.pn - 6;
            float rsv[2][4];
#pragma unroll
            for (int ai = 0; ai < 2; ++ai)
#pragma unroll
                for (int m = 0; m < 4; ++m) rsv[ai][m] = rss_rstd2(rssm + (size_t)(S + row0 + ai * 128 + m * 16) * 2, 1.f / 512.f);
#pragma unroll
            for (int ai = 0; ai < 2; ++ai)
#pragma unroll
                for (int m = 0; m < 4; ++m) { const int row = row0 + ai * 128 + m * 16; const float rs = rsv[ai][m];
                    *(GA1 u32x4*)(KM + (size_t)row * 1536 + h * 192 + c8) = pack8(acc[ai][0][m][0] * rs, acc[ai][0][m][1] * rs);
                    *(GA1 u32x4*)(VM + (size_t)row * 1024 + h * 128 + c8) = pack8(acc[ai][1][m][0] * rs, acc[ai][1][m][1] * rs); }
        }
    }
};
struct EpiBranch {
    static constexpr bool PERM = true, CHAIN = true;
    const bf16_t* GATE; bf16_t* MG;
    __device__ __forceinline__ bool keep(const Unit& u) const { return (u.pm >> 5) < 2; }
    __device__ __forceinline__ void operator()(f32x4 (&acc)[2][2][4][2], const Unit& u, int wr, int wc, int fr, int fq) const {
        const int n = u.pm >> 5, row0 = (u.pm & 31) * 256 + wr * 64 + fr, col0 = (u.pn - 8 * n) * 256 + wc * 32 + 8 * fq;
#pragma unroll
        for (int ai = 0; ai < 2; ++ai)
#pragma unroll
            for (int m = 0; m < 4; ++m) { const int row = row0 + ai * 128 + m * 16;
#pragma unroll
                for (int bj = 0; bj < 2; ++bj) { const int col = col0 + bj * 128;
                    f32x4 g0, g1; unpack8(*(const GA1 u32x4*)(GATE + (size_t)row * 6144 + n * 2048 + col), g0, g1);
                    if (n < 2) { f32x4 h0, h1; unpack8(*(const GA1 u32x4*)(GATE + (size_t)row * 6144 + (n + 1) * 2048 + col), h0, h1);
#pragma unroll
                        for (int j = 0; j < 4; ++j) { acc[ai][bj][m][0][j] *= g0[j] * __builtin_amdgcn_rcpf(h0[j]); acc[ai][bj][m][1][j] *= g1[j] * __builtin_amdgcn_rcpf(h1[j]); }
                    } else *(GA1 u32x4*)(MG + (size_t)row * D + col) = pack8(acc[ai][bj][m][0] * g0, acc[ai][bj][m][1] * g1);
                } }
    }
};

struct MlaOrder {
    int G, c;
    __device__ bool next(int i, Unit& u) const { const int L = i * G + c; if (L < 192) { u.pm = L & 31; u.pn = L >> 5; return true; } if (L < 448) { const int l2 = L - 192; u.pm = 32 + (l2 & 31); u.pn = 6 + (l2 >> 5); return true; } return false; }
    __device__ __forceinline__ void a_ready(const Unit&) const {}
    __device__ __forceinline__ void done(const Unit&) const {}
};
struct BranchOrder {
    pg8::StaticOrder so;
    __device__ bool next(int i, Unit& u) const { const int t = i / 3, n = i - 3 * t; if (!so.map(t * so.G + so.c, u)) return false; u.pm += 32 * n; u.pn += 8 * n; return true; }
    __device__ __forceinline__ void a_ready(const Unit&) const {}
    __device__ __forceinline__ void done(const Unit&) const {}
};
struct KvxOrder {
    int G, c;
    __device__ bool next(int i, Unit& u) const { const int L = i * G + c; if (L >= 16) return false; u.pm = L >> 2; u.pn = L; return true; }
    __device__ __forceinline__ void a_ready(const Unit&) const {}
    __device__ __forceinline__ void done(const Unit&) const {}
};
}
namespace at {
typedef unsigned short bf16;
using bf16x8 = __attribute__((ext_vector_type(8))) short;
using s16x4  = __attribute__((ext_vector_type(4))) short;
using f32x16 = __attribute__((ext_vector_type(16))) float;
using u32x4  = __attribute__((ext_vector_type(4))) unsigned;
typedef const __attribute__((address_space(1))) bf16x8* gp8;
constexpr int KVBLK = 64, SHM_V = KVBLK * 128 * 2;
constexpr float THR = 8.f;
#define AT_SBAR() __builtin_amdgcn_sched_barrier(0)
#ifndef AT_GRP
#define AT_GRP 0
#endif
#ifndef AT_PRIO
#define AT_PRIO 1
#endif
#ifndef AT_QPIPE
#define AT_QPIPE 1
#endif
#ifndef AT_VPIPE
#define AT_VPIPE 1
#endif
__device__ __forceinline__ int crow(int r, int hi) { return (r & 3) + 8 * (r >> 2) + 4 * hi; }
__device__ __forceinline__ unsigned cvtpk(float lo, float hi) { unsigned r; asm volatile("v_cvt_pk_bf16_f32 %0, %1, %2" : "=v"(r) : "v"(lo), "v"(hi)); return r; }

template <bool WIN>
__device__ __forceinline__ void partialSM(f32x16& p0, f32x16& p1, float& m_reg, float& mn, float& alpha, float C, float thr_raw, int krel, int hi) {
  if (WIN) {
#pragma unroll
    for (int r = 0; r < 16; ++r) { const int d0 = krel + crow(r, hi), d1 = d0 + 32;
      if (d0 > 128 || d0 < -128) p0[r] = -1e30f; if (d1 > 128 || d1 < -128) p1[r] = -1e30f; }
  }
  float pmax = p0[0];
#pragma unroll
  for (int r = 1; r < 16; ++r) pmax = fmaxf(pmax, p0[r]);
#pragma unroll
  for (int r = 0; r < 16; ++r) pmax = fmaxf(pmax, p1[r]);
  { auto rr = __builtin_amdgcn_permlane32_swap(__float_as_uint(pmax), __float_as_uint(pmax), false, false);
    pmax = fmaxf(__uint_as_float(rr[0]), __uint_as_float(rr[1])); }
  if (__builtin_expect(__all(pmax - m_reg <= thr_raw), 1)) { mn = m_reg; alpha = 1.f; }
  else { mn = fmaxf(m_reg, pmax); alpha = __builtin_amdgcn_exp2f((m_reg - mn) * C); m_reg = mn; }
  const float mnC = -mn * C;
#pragma unroll
  for (int r = 0; r < 16; ++r) p0[r] = fmaf(p0[r], C, mnC);
#pragma unroll
  for (int r = 0; r < 16; ++r) p1[r] = fmaf(p1[r], C, mnC);
#pragma unroll
  for (int r = 0; r < 16; ++r) p0[r] = __builtin_amdgcn_exp2f(p0[r]);
}
__device__ __forceinline__ void finishSM(f32x16& p0, f32x16& p1, float alpha, float& l_reg, bf16x8& pa0, bf16x8& pa1, bf16x8& pa2, bf16x8& pa3) {
#pragma unroll
  for (int r = 0; r < 16; ++r) p1[r] = __builtin_amdgcn_exp2f(p1[r]);
  float ps = 0;
#pragma unroll
  for (int r = 0; r < 16; ++r) ps += p0[r];
#pragma unroll
  for (int r = 0; r < 16; ++r) ps += p1[r];
  { auto rr = __builtin_amdgcn_permlane32_swap(__float_as_uint(ps), __float_as_uint(ps), false, false);
    ps = __uint_as_float(rr[0]) + __uint_as_float(rr[1]); }
  l_reg = l_reg * alpha + ps;
#define AT_PK4(P, BASE, OUT) do { unsigned a0 = cvtpk(P[BASE + 0], P[BASE + 1]), a1 = cvtpk(P[BASE + 2], P[BASE + 3]);   \
    unsigned b0 = cvtpk(P[BASE + 4], P[BASE + 5]), b1 = cvtpk(P[BASE + 6], P[BASE + 7]);                              \
    auto r0 = __builtin_amdgcn_permlane32_swap(a0, b0, false, false); auto r1 = __builtin_amdgcn_permlane32_swap(a1, b1, false, false); \
    u32x4 w = {r0[0], r1[0], r0[1], r1[1]}; OUT = *reinterpret_cast<bf16x8*>(&w); } while (0)
  AT_PK4(p0, 0, pa0); AT_PK4(p0, 8, pa1); AT_PK4(p1, 0, pa2); AT_PK4(p1, 8, pa3);
#undef AT_PK4
}
template <int DQK> __device__ __forceinline__ int kswz_x(int row) { return DQK == 128 ? (row & 15) : ((row >> 1) & 7); }
template <int DQK> __device__ __forceinline__ int kswz(int row, int colB) { return row * (DQK * 2) + (colB ^ (kswz_x<DQK>(row) << 4)); }
template <int DQK, int QL, int GRP>
__device__ __forceinline__ void qkt(f32x16& p0, f32x16& p1, int ks  , const int (&kb)[8], const bf16x8* qr, int qa, int r32, int hi) {
  typedef const __attribute__((address_space(3))) bf16x8* lp;
  p0 = f32x16{}; p1 = f32x16{};
  if (QL > 0) asm volatile("" : "+v"(qa));
#if AT_QPIPE
  const int ka0 = DQK == 128 ? kb[0] : kb[0];
  bf16x8 b0 = *(lp)(uintptr_t)(unsigned)(ks + ka0), b1 = *(lp)(uintptr_t)(unsigned)(ks + ka0 + 32 * DQK * 2);
#pragma unroll
  for (int d0 = 0; d0 < DQK / 16; ++d0) {
    bf16x8 n0 = b0, n1 = b1;
    if (d0 + 1 < DQK / 16) { const int g = (d0 + 1) >> 2, e = (d0 + 1) & 3; const int ka = DQK == 128 ? kb[e + 4 * g] : kb[e] + g * 128;
      n0 = *(lp)(uintptr_t)(unsigned)(ks + ka); n1 = *(lp)(uintptr_t)(unsigned)(ks + ka + 32 * DQK * 2); }
    bf16x8 q;
    if (d0 < DQK / 16 - QL) q = qr[d0]; else q = *(lp)(uintptr_t)(unsigned)(qa + (d0 - (DQK / 16 - QL)) * 1024);
    AT_SBAR();
    if (AT_PRIO) __builtin_amdgcn_s_setprio(1);
    p0 = __builtin_amdgcn_mfma_f32_32x32x16_bf16(b0, q, p0, 0, 0, 0);
    p1 = __builtin_amdgcn_mfma_f32_32x32x16_bf16(b1, q, p1, 0, 0, 0);
    if (AT_PRIO) __builtin_amdgcn_s_setprio(0);
    AT_SBAR();
    b0 = n0; b1 = n1; }
#else
#pragma unroll
  for (int d0 = 0; d0 < DQK / 16; ++d0) { const int g = d0 >> 2, e = d0 & 3;
    const int ka = DQK == 128 ? kb[e + 4 * g] : kb[e] + g * 128;
    const bf16x8 b0 = *(lp)(uintptr_t)(unsigned)(ks + ka);
    const bf16x8 b1 = *(lp)(uintptr_t)(unsigned)(ks + ka + 32 * DQK * 2);
    bf16x8 q;
    if (d0 < DQK / 16 - QL) q = qr[d0]; else q = *(lp)(uintptr_t)(unsigned)(qa + (d0 - (DQK / 16 - QL)) * 1024);
    p0 = __builtin_amdgcn_mfma_f32_32x32x16_bf16(b0, q, p0, 0, 0, 0);
    p1 = __builtin_amdgcn_mfma_f32_32x32x16_bf16(b1, q, p1, 0, 0, 0);
    if (GRP > 0 && (d0 % (GRP > 0 ? GRP : 1)) == (GRP > 0 ? GRP : 1) - 1) AT_SBAR(); }
#endif
}
__device__ __forceinline__ int v_st(int k, int c) { const int kk = (k & ~0xC) | ((k & 4) << 1) | ((k & 8) >> 1); return ((kk >> 3) * 4 + (c >> 5)) * 512 + ((kk & 7) * 32 + (c & 31)) * 2; }
__device__ __forceinline__ int v_rd_base(int lane) { return ((lane & 3) << 3) | (((lane >> 2) & 3) << 6) | (((lane >> 4) & 1) << 5) | (((lane >> 5) & 1) << 8); }
constexpr int v_rd_off(int d0, int ks, int half) { return d0 * 512 + ks * 4096 + half * 2048; }
template <int OFF> __device__ __forceinline__ s16x4 tr_read(int vb) {
  s16x4 r; asm volatile("ds_read_b64_tr_b16 %0, %1 offset:%2" : "=&v"(r) : "v"(vb), "i"(OFF) : "memory"); return r;
}
struct VFrag { s16x4 l0, h0, l1, h1, l2, h2, l3, h3; };
template <int D0> __device__ __forceinline__ void pv_load(VFrag& f, int vb) {
  f.l0 = tr_read<v_rd_off(D0, 0, 0)>(vb); f.h0 = tr_read<v_rd_off(D0, 0, 1)>(vb); f.l1 = tr_read<v_rd_off(D0, 1, 0)>(vb); f.h1 = tr_read<v_rd_off(D0, 1, 1)>(vb);
  f.l2 = tr_read<v_rd_off(D0, 2, 0)>(vb); f.h2 = tr_read<v_rd_off(D0, 2, 1)>(vb); f.l3 = tr_read<v_rd_off(D0, 3, 0)>(vb); f.h3 = tr_read<v_rd_off(D0, 3, 1)>(vb);
}
#define AT_PK(L, H) (bf16x8){L[0], L[1], L[2], L[3], H[0], H[1], H[2], H[3]}
__device__ __forceinline__ void pv_mma(f32x16& od, const VFrag& f, bf16x8 pa0, bf16x8 pa1, bf16x8 pa2, bf16x8 pa3) {
  if (AT_PRIO) __builtin_amdgcn_s_setprio(1);
  od = __builtin_amdgcn_mfma_f32_32x32x16_bf16(pa0, AT_PK(f.l0, f.h0), od, 0, 0, 0);
  od = __builtin_amdgcn_mfma_f32_32x32x16_bf16(pa1, AT_PK(f.l1, f.h1), od, 0, 0, 0);
  od = __builtin_amdgcn_mfma_f32_32x32x16_bf16(pa2, AT_PK(f.l2, f.h2), od, 0, 0, 0);
  od = __builtin_amdgcn_mfma_f32_32x32x16_bf16(pa3, AT_PK(f.l3, f.h3), od, 0, 0, 0);
  if (AT_PRIO) __builtin_amdgcn_s_setprio(0);
}
template <int D0> __device__ __forceinline__ void pv_one(f32x16& od, int vb, bf16x8 pa0, bf16x8 pa1, bf16x8 pa2, bf16x8 pa3) {
  VFrag f; pv_load<D0>(f, vb);
  asm volatile("s_waitcnt lgkmcnt(0)" ::: "memory"); AT_SBAR();
  pv_mma(od, f, pa0, pa1, pa2, pa3);
}
__device__ __forceinline__ void pv_d0(f32x16* o, int vb, bf16x8 pa0, bf16x8 pa1, bf16x8 pa2, bf16x8 pa3) {
#if AT_VPIPE
  VFrag fa, fb;
  pv_load<0>(fa, vb); pv_load<1>(fb, vb);
  asm volatile("s_waitcnt lgkmcnt(8)" ::: "memory"); AT_SBAR();
  pv_mma(o[0], fa, pa0, pa1, pa2, pa3); AT_SBAR();
  pv_load<2>(fa, vb);
  asm volatile("s_waitcnt lgkmcnt(8)" ::: "memory"); AT_SBAR();
  pv_mma(o[1], fb, pa0, pa1, pa2, pa3); AT_SBAR();
  pv_load<3>(fb, vb);
  asm volatile("s_waitcnt lgkmcnt(8)" ::: "memory"); AT_SBAR();
  pv_mma(o[2], fa, pa0, pa1, pa2, pa3); AT_SBAR();
  asm volatile("s_waitcnt lgkmcnt(0)" ::: "memory"); AT_SBAR();
  pv_mma(o[3], fb, pa0, pa1, pa2, pa3);
#else
  pv_one<0>(o[0], vb, pa0, pa1, pa2, pa3); pv_one<1>(o[1], vb, pa0, pa1, pa2, pa3); pv_one<2>(o[2], vb, pa0, pa1, pa2, pa3); pv_one<3>(o[3], vb, pa0, pa1, pa2, pa3);
#endif
}
#undef AT_PK

template <int DQK, bool WIN, int SDEPTH, int QL = 0>
__device__ __forceinline__ void attn_core(const bf16* __restrict__ Qb, int ldq, const bf16* __restrict__ Kh, int ldk, const bf16* __restrict__ Vh, int ldv,
                                          int NT, float C, float thr_raw, float m_init, float l_init, int qrel0, char* lds, f32x16 (&o)[4], float (&rli)[16]) {
  constexpr int SHM_K = KVBLK * DQK * 2, CPR = DQK / 8, NKC = DQK / 64;
  int tid = threadIdx.x; asm volatile("" : "+v"(tid));
  const int wid = tid >> 6, lane = tid & 63, r32 = lane & 31, hi = lane >> 5;
  char* V_lds = lds; char* K_lds = lds + 2 * SHM_V;
  float* ws = (float*)(lds + 2 * SHM_V + 2 * SHM_K) + wid * 64; float* li_l = ws; float* al_l = ws + 32;
  float m_reg = m_init, l_reg = l_init; bf16x8 qr[DQK / 16 - QL];
  char* qlds = lds + 2 * SHM_V + 2 * SHM_K + 2048 + wid * 4096 + lane * 16;
#pragma unroll
  for (int d = 0; d < 4; ++d) o[d] = f32x16{};
  const bf16* Qw = Qb + (long)(wid * 32 + r32) * ldq + hi * 8;
#pragma unroll
  for (int d0 = 0; d0 < DQK / 16 - QL; ++d0) qr[d0] = *(gp8)(Qw + d0 * 16);
  const int qme = qrel0 + wid * 32 + r32;
  const int sr = tid >> 4, sc = (tid & 15) * 8, vst0 = v_st(sr, sc), vst1 = v_st(32 + sr, sc);
  const unsigned vgo0 = (unsigned)(sr * ldv + sc) * 2u, vgo1 = vgo0 + 64u * (unsigned)ldv;
  unsigned kgo[NKC]; int klo[NKC];
#pragma unroll
  for (int i = 0; i < NKC; ++i) { const int id = tid + 512 * i, row = id / CPR, ch = id % CPR; kgo[i] = (unsigned)(row * ldk + ch * 8) * 2u; klo[i] = kswz<DQK>(row, ch * 16); }
  const int vb0 = (int)(uintptr_t)V_lds + v_rd_base(lane);
  const int ksa = (int)(uintptr_t)K_lds, qa0 = (int)(uintptr_t)qlds; int kb[8];
#pragma unroll
  for (int e = 0; e < 8; ++e) kb[e] = (DQK == 128 || e < 4) ? kswz<DQK>(r32, ((((e & 3) << 1) | hi) + 8 * (e >> 2)) << 4) : 0;
  struct { bf16x8 vs0, vs1, ks[NKC]; } sr_[SDEPTH];
#define AT_SLOAD(i, k0) do { const char* vb_ = (const char*)Vh + (size_t)(k0) * (size_t)ldv * 2; const char* kb_ = (const char*)Kh + (size_t)(k0) * (size_t)ldk * 2; \
    sr_[i].vs0 = *(gp8)(vb_ + vgo0); sr_[i].vs1 = *(gp8)(vb_ + vgo1); \
    _Pragma("unroll") for (int _c = 0; _c < NKC; ++_c) sr_[i].ks[_c] = *(gp8)(kb_ + kgo[_c]); } while (0)
#define AT_SWRITE(b, i) do { *(bf16x8*)(V_lds + (b) * SHM_V + vst0) = sr_[i].vs0; *(bf16x8*)(V_lds + (b) * SHM_V + vst1) = sr_[i].vs1; \
    _Pragma("unroll") for (int _c = 0; _c < NKC; ++_c) *(bf16x8*)(K_lds + (b) * SHM_K + klo[_c]) = sr_[i].ks[_c]; } while (0)
#define AT_SWAIT() do { if constexpr (SDEPTH == 2) asm volatile("s_waitcnt vmcnt(%0)" :: "n"(2 + NKC) : "memory"); else asm volatile("s_waitcnt vmcnt(0)" ::: "memory"); } while (0)
#define AT_RESC(a) do { if (__any((a) < 1.f)) { if (hi == 0) al_l[r32] = (a); asm volatile("s_waitcnt lgkmcnt(0)" ::: "memory"); \
    _Pragma("unroll") for (int d = 0; d < 4; ++d) _Pragma("unroll") for (int r = 0; r < 16; ++r) o[d][r] *= al_l[crow(r, hi)]; } } while (0)
  f32x16 pA0, pA1, pB0, pB1; float mnA, mnB, alA, alB; bf16x8 pa0, pa1, pa2, pa3;
  constexpr int SE = 0, SO = SDEPTH - 1;
  __syncthreads();
#pragma unroll
  for (int d0 = 0; d0 < QL; ++d0) *reinterpret_cast<bf16x8*>(qlds + d0 * 1024) = *(gp8)(Qw + (DQK / 16 - QL + d0) * 16);
  AT_SLOAD(SE, 0); asm volatile("s_waitcnt vmcnt(0)" ::: "memory"); AT_SWRITE(0, SE); __syncthreads();
  qkt<DQK, QL, AT_GRP>(pA0, pA1, ksa, kb, qr, qa0, r32, hi); partialSM<WIN>(pA0, pA1, m_reg, mnA, alA, C, thr_raw, 0 - qme, hi);
  AT_SLOAD(SO, KVBLK); if constexpr (SDEPTH == 2) { if (2 < NT) AT_SLOAD(SE, 2 * KVBLK); }
  if (SDEPTH == 2 && 2 < NT) AT_SWAIT(); else asm volatile("s_waitcnt vmcnt(0)" ::: "memory");
  AT_SWRITE(1, SO); __syncthreads();
  for (int j = 1; j + 1 < NT; j += 2) {
    AT_SBAR(); qkt<DQK, QL, AT_GRP>(pB0, pB1, ksa + SHM_K, kb, qr, qa0, r32, hi);
    finishSM(pA0, pA1, alA, l_reg, pa0, pa1, pa2, pa3); AT_SBAR();
    AT_SLOAD(SO, (j + SDEPTH) * KVBLK); AT_SBAR();
    pv_d0(o, vb0, pa0, pa1, pa2, pa3); partialSM<WIN>(pB0, pB1, m_reg, mnB, alB, C, thr_raw, j * KVBLK - qme, hi);
    __syncthreads(); AT_SWAIT(); AT_SWRITE(0, SE);
    AT_RESC(alB); __syncthreads();
    AT_SBAR(); qkt<DQK, QL, AT_GRP>(pA0, pA1, ksa, kb, qr, qa0, r32, hi);
    finishSM(pB0, pB1, alB, l_reg, pa0, pa1, pa2, pa3); AT_SBAR();
    if (SDEPTH == 1 || j + 3 < NT) AT_SLOAD(SE, (j + 1 + SDEPTH) * KVBLK); AT_SBAR();
    pv_d0(o, vb0 + SHM_V, pa0, pa1, pa2, pa3); partialSM<WIN>(pA0, pA1, m_reg, mnA, alA, C, thr_raw, (j + 1) * KVBLK - qme, hi);
    __syncthreads(); if (SDEPTH == 1 || j + 3 < NT) AT_SWAIT(); else asm volatile("s_waitcnt vmcnt(0)" ::: "memory");
    AT_SWRITE(1, SO);
    AT_RESC(alA); __syncthreads();
  }
  AT_SBAR(); qkt<DQK, QL, AT_GRP>(pB0, pB1, ksa + SHM_K, kb, qr, qa0, r32, hi);
  finishSM(pA0, pA1, alA, l_reg, pa0, pa1, pa2, pa3); AT_SBAR();
  pv_d0(o, vb0, pa0, pa1, pa2, pa3); partialSM<WIN>(pB0, pB1, m_reg, mnB, alB, C, thr_raw, (NT - 1) * KVBLK - qme, hi);
  __syncthreads(); AT_RESC(alB);
  finishSM(pB0, pB1, alB, l_reg, pa0, pa1, pa2, pa3); AT_SBAR();
  pv_d0(o, vb0 + SHM_V, pa0, pa1, pa2, pa3);
  if (hi == 0) li_l[r32] = l_reg; asm volatile("s_waitcnt lgkmcnt(0)" ::: "memory");
#pragma unroll
  for (int r = 0; r < 16; ++r) rli[r] = __builtin_amdgcn_rcpf(li_l[crow(r, hi)]);
#undef AT_SLOAD
#undef AT_SWRITE
#undef AT_SWAIT
#undef AT_RESC
}
template <int DQK, bool WIN>
__device__ __forceinline__ void attn_core1(const bf16* __restrict__ Qb, int ldq, const bf16* __restrict__ Kh, int ldk, const bf16* __restrict__ Vh, int ldv,
                                           int NT, float C, float thr_raw, float m_init, float l_init, int qrel0, char* lds, f32x16 (&o)[4], float (&rli)[16]) {
  constexpr int SHM_K = KVBLK * DQK * 2, CPR = DQK / 8, NKC = DQK / 64;
  int tid = threadIdx.x; asm volatile("" : "+v"(tid));
  const int wid = tid >> 6, lane = tid & 63, r32 = lane & 31, hi = lane >> 5;
  char* V_lds = lds; char* K_lds = lds + 2 * SHM_V;
  float* ws = (float*)(lds + 2 * SHM_V + 2 * SHM_K) + wid * 64; float* li_l = ws; float* al_l = ws + 32;
  float m_reg = m_init, l_reg = l_init; bf16x8 qr[DQK / 16];
#pragma unroll
  for (int d = 0; d < 4; ++d) o[d] = f32x16{};
  const bf16* Qw = Qb + (long)(wid * 32 + r32) * ldq + hi * 8;
#pragma unroll
  for (int d0 = 0; d0 < DQK / 16; ++d0) qr[d0] = *(gp8)(Qw + d0 * 16);
  const int qme = qrel0 + wid * 32 + r32;
  const int sr = tid >> 4, sc = (tid & 15) * 8, vst0 = v_st(sr, sc), vst1 = v_st(32 + sr, sc);
  const unsigned vgo0 = (unsigned)(sr * ldv + sc) * 2u, vgo1 = vgo0 + 64u * (unsigned)ldv;
  unsigned kgo[NKC]; int klo[NKC];
#pragma unroll
  for (int i = 0; i < NKC; ++i) { const int id = tid + 512 * i, row = id / CPR, ch = id % CPR; kgo[i] = (unsigned)(row * ldk + ch * 8) * 2u; klo[i] = kswz<DQK>(row, ch * 16); }
  const int vb0 = (int)(uintptr_t)V_lds + v_rd_base(lane);
  const int ksa = (int)(uintptr_t)K_lds; int kb[8];
#pragma unroll
  for (int e = 0; e < 8; ++e) kb[e] = (DQK == 128 || e < 4) ? kswz<DQK>(r32, ((((e & 3) << 1) | hi) + 8 * (e >> 2)) << 4) : 0;
  bf16x8 vs0, vs1, ks[NKC];
#define A1_LOAD(k0) do { const char* vb_ = (const char*)Vh + (size_t)(k0) * (size_t)ldv * 2; const char* kb_ = (const char*)Kh + (size_t)(k0) * (size_t)ldk * 2; \
    vs0 = *(gp8)(vb_ + vgo0); vs1 = *(gp8)(vb_ + vgo1); \
    _Pragma("unroll") for (int _c = 0; _c < NKC; ++_c) ks[_c] = *(gp8)(kb_ + kgo[_c]); } while (0)
#define A1_WRITE(b) do { *(bf16x8*)(V_lds + (b) * SHM_V + vst0) = vs0; *(bf16x8*)(V_lds + (b) * SHM_V + vst1) = vs1; \
    _Pragma("unroll") for (int _c = 0; _c < NKC; ++_c) *(bf16x8*)(K_lds + (b) * SHM_K + klo[_c]) = ks[_c]; } while (0)
  __syncthreads();
  A1_LOAD(0); A1_WRITE(0);
  if (NT > 1) A1_LOAD(KVBLK);
  __syncthreads();
  for (int j = 0; j < NT; ++j) {
    const int b = j & 1;
    f32x16 p0, p1; float mn, al; bf16x8 pa0, pa1, pa2, pa3;
    qkt<DQK, 0, AT_GRP>(p0, p1, ksa + b * SHM_K, kb, qr, 0, r32, hi);
    partialSM<WIN>(p0, p1, m_reg, mn, al, C, thr_raw, j * KVBLK - qme, hi);
    if (__any(al < 1.f)) { if (hi == 0) al_l[r32] = al; asm volatile("s_waitcnt lgkmcnt(0)" ::: "memory");
#pragma unroll
      for (int d = 0; d < 4; ++d)
#pragma unroll
        for (int r = 0; r < 16; ++r) o[d][r] *= al_l[crow(r, hi)]; }
    finishSM(p0, p1, al, l_reg, pa0, pa1, pa2, pa3);
    if (j + 1 < NT) { A1_WRITE(b ^ 1); if (j + 2 < NT) A1_LOAD((j + 2) * KVBLK); }
    AT_SBAR();
    pv_d0(o, vb0 + b * SHM_V, pa0, pa1, pa2, pa3);
    __syncthreads();
  }
  if (hi == 0) li_l[r32] = l_reg; asm volatile("s_waitcnt lgkmcnt(0)" ::: "memory");
#pragma unroll
  for (int r = 0; r < 16; ++r) rli[r] = __builtin_amdgcn_rcpf(li_l[crow(r, hi)]);
#undef A1_LOAD
#undef A1_WRITE
}
template <int DQK, bool WIN>
__device__ __forceinline__ void attn_core2(const bf16* __restrict__ Qb, int ldq, const bf16* __restrict__ Kh, int ldk, const bf16* __restrict__ Vh, int ldv,
                                           int NT, float C, float thr_raw, float m_init, float l_init, int qrel0, char* lds, f32x16 (&o)[4], float (&rli)[16]) {
  constexpr int SHM_K = KVBLK * DQK * 2, CPR = DQK / 8, NKC = DQK / 64;
  int tid = threadIdx.x; asm volatile("" : "+v"(tid));
  const int wid = __builtin_amdgcn_readfirstlane(tid >> 6), lane = tid & 63, r32 = lane & 31, hi = lane >> 5, grp = wid >> 2;
  char* V_lds = lds; char* K_lds = lds + 3 * SHM_V;
  float* ws = (float*)(lds + 3 * SHM_V + 2 * SHM_K) + wid * 64; float* li_l = ws; float* al_l = ws + 32;
  float m_reg = m_init, l_reg = l_init; bf16x8 qr[DQK / 16];
#pragma unroll
  for (int d = 0; d < 4; ++d) o[d] = f32x16{};
  const bf16* Qw = Qb + (long)(wid * 32 + r32) * ldq + hi * 8;
#pragma unroll
  for (int d0 = 0; d0 < DQK / 16; ++d0) qr[d0] = *(gp8)(Qw + d0 * 16);
  const int qme = qrel0 + wid * 32 + r32;
  const int sr = tid >> 4, sc = (tid & 15) * 8, vst0 = v_st(sr, sc), vst1 = v_st(32 + sr, sc);
  const unsigned vgo0 = (unsigned)(sr * ldv + sc) * 2u, vgo1 = vgo0 + 64u * (unsigned)ldv;
  unsigned kgo[NKC]; int klo[NKC];
#pragma unroll
  for (int i = 0; i < NKC; ++i) { const int id = tid + 512 * i, row = id / CPR, ch = id % CPR; kgo[i] = (unsigned)(row * ldk + ch * 8) * 2u; klo[i] = kswz<DQK>(row, ch * 16); }
  const int vb0 = (int)(uintptr_t)V_lds + v_rd_base(lane);
  const int ksa = (int)(uintptr_t)K_lds; int kb[8];
#pragma unroll
  for (int e = 0; e < 8; ++e) kb[e] = (DQK == 128 || e < 4) ? kswz<DQK>(r32, ((((e & 3) << 1) | hi) + 8 * (e >> 2)) << 4) : 0;
  bf16x8 vs0, vs1, ks[NKC];
  f32x16 p0, p1; float mn, al = 1.f; bf16x8 pa0, pa1, pa2, pa3;
#define C2_LOAD(k0) do { const char* vb_ = (const char*)Vh + (size_t)(k0) * (size_t)ldv * 2; const char* kb_ = (const char*)Kh + (size_t)(k0) * (size_t)ldk * 2; \
    vs0 = *(gp8)(vb_ + vgo0); vs1 = *(gp8)(vb_ + vgo1); \
    _Pragma("unroll") for (int _c = 0; _c < NKC; ++_c) ks[_c] = *(gp8)(kb_ + kgo[_c]); } while (0)
#define C2_WRITE(kbuf, vbuf) do { *(bf16x8*)(V_lds + (vbuf) * SHM_V + vst0) = vs0; *(bf16x8*)(V_lds + (vbuf) * SHM_V + vst1) = vs1; \
    _Pragma("unroll") for (int _c = 0; _c < NKC; ++_c) *(bf16x8*)(K_lds + (kbuf) * SHM_K + klo[_c]) = ks[_c]; } while (0)
#define C2_QKSM(j, kbuf) do { qkt<DQK, 0, AT_GRP>(p0, p1, ksa + (kbuf) * SHM_K, kb, qr, 0, r32, hi); \
    partialSM<WIN>(p0, p1, m_reg, mn, al, C, thr_raw, (j) * KVBLK - qme, hi); finishSM(p0, p1, al, l_reg, pa0, pa1, pa2, pa3); } while (0)
#define C2_RESC() do { if (__any(al < 1.f)) { if (hi == 0) al_l[r32] = al; asm volatile("s_waitcnt lgkmcnt(0)" ::: "memory"); \
    _Pragma("unroll") for (int d = 0; d < 4; ++d) _Pragma("unroll") for (int r = 0; r < 16; ++r) o[d][r] *= al_l[crow(r, hi)]; } } while (0)
#define C2_STAGE(j, kbuf, vnext) do { if ((j) + 1 < NT) { C2_WRITE((kbuf) ^ 1, vnext); if ((j) + 2 < NT) C2_LOAD(((j) + 2) * KVBLK); } } while (0)
  __syncthreads();
  C2_LOAD(0); C2_WRITE(0, 0);
  if (NT > 1) C2_LOAD(KVBLK);
  __syncthreads();
  int vprev = 2, vcur = 0, vnext = 1;
  for (int j = 0; j < NT; ++j) {
    const int kbuf = j & 1;
    if (grp == 0) {
      C2_QKSM(j, kbuf);
      C2_STAGE(j, kbuf, vnext);
      C2_RESC(); AT_SBAR();
      pv_d0(o, vb0 + vcur * SHM_V, pa0, pa1, pa2, pa3);
    } else {
      if (j > 0) { C2_RESC(); AT_SBAR(); pv_d0(o, vb0 + vprev * SHM_V, pa0, pa1, pa2, pa3); }
      AT_SBAR();
      C2_QKSM(j, kbuf);
      C2_STAGE(j, kbuf, vnext);
    }
    asm volatile("s_waitcnt lgkmcnt(0)" ::: "memory"); __builtin_amdgcn_s_barrier(); asm volatile("" ::: "memory");
    const int t_ = vprev; vprev = vcur; vcur = vnext; vnext = t_;
  }
  if (grp == 1) { C2_RESC(); AT_SBAR(); pv_d0(o, vb0 + vprev * SHM_V, pa0, pa1, pa2, pa3); }
  if (hi == 0) li_l[r32] = l_reg; asm volatile("s_waitcnt lgkmcnt(0)" ::: "memory");
#pragma unroll
  for (int r = 0; r < 16; ++r) rli[r] = __builtin_amdgcn_rcpf(li_l[crow(r, hi)]);
#undef C2_LOAD
#undef C2_WRITE
#undef C2_QKSM
#undef C2_RESC
#undef C2_STAGE
}
__device__ __forceinline__ void store_o(bf16* Ob, int ldo, const f32x16 (&o)[4], const float (&rli)[16]) {
  int tid = threadIdx.x; asm volatile("" : "+v"(tid));
  const int wid = tid >> 6, lane = tid & 63, r32 = lane & 31, hi = lane >> 5;
  bf16* Ow = Ob + (long)(wid * 32) * ldo + r32;
#pragma unroll
  for (int r = 0; r < 16; ++r) { const int orow = crow(r, hi);
#pragma unroll
    for (int d0 = 0; d0 < 4; ++d0) ((__attribute__((address_space(1))) bf16*)Ow)[(long)orow * ldo + d0 * 32] = (bf16)(cvtpk(o[d0][r] * rli[r], 0.f) & 0xffffu); }
}
}
namespace mk {
#define GAS __attribute__((address_space(1)))
#define LAS __attribute__((address_space(3)))
constexpr size_t MiB = 1u << 20;
constexpr size_t al256(size_t x) { return (x + 255) & ~(size_t)255; }
constexpr size_t WS_CTL = 0, CTL_ZERO_BYTES = 1 * MiB;
constexpr size_t WS_PART = WS_CTL + CTL_ZERO_BYTES;
constexpr size_t WS_PARTM = WS_PART + (size_t)20 * S * 8 * 4;
constexpr size_t WS_CS64 = WS_PARTM + (size_t)4 * 2 * S * 2 * 4;
constexpr size_t WS_CS128 = WS_CS64 + (size_t)S * 32 * 8;
constexpr size_t WS_H = WS_CS128 + (size_t)S * 64 * 8;
constexpr size_t WS_AN = WS_H + (size_t)S * D * 4;
constexpr size_t WS_HID = WS_AN + (size_t)S * D * 2;
constexpr size_t WS_QD = WS_HID + (size_t)S * DFF * 2;
constexpr size_t WS_KD = WS_QD + (size_t)S * 1024 * 2, WS_VD = WS_KD + (size_t)S * 1024 * 2;
constexpr size_t WS_CQR = WS_VD + (size_t)S * 1024 * 2, WS_CKVR = WS_CQR + (size_t)S * 512 * 2;
constexpr size_t WS_ACQ = WS_CKVR + (size_t)S * 512 * 2;
constexpr size_t WS_QG = WS_ACQ + (size_t)2 * S * 512 * 2, WS_KG = WS_QG + (size_t)S * 1024 * 2, WS_VG = WS_KG + (size_t)S * 256 * 2;
constexpr size_t WS_QM = WS_VG + (size_t)S * 256 * 2, WS_KM = WS_QM + (size_t)S * 1536 * 2, WS_VM = WS_KM + (size_t)S * 1536 * 2;
constexpr size_t WS_GATE = WS_VM + (size_t)S * 1024 * 2;
constexpr size_t WS_OB = WS_GATE + (size_t)S * 6144 * 2;
constexpr size_t WS_MG = WS_OB + (size_t)3 * S * 1024 * 2;
constexpr size_t WS_ATMP = WS_MG + (size_t)S * D * 2;
constexpr size_t WS_QX = WS_ATMP + (size_t)256 * 64 * 512 * 4, WS_OX = WS_QX + (size_t)S * 512 * 2;
constexpr size_t WS_MEMN = WS_OX + (size_t)S * 512 * 2;
constexpr size_t WS_KVX = WS_MEMN + (size_t)4 * 256 * D * 2;
constexpr size_t WS_WXKV = WS_KVX + (size_t)4 * 256 * 1024 * 2;
constexpr size_t WS_LW = WS_WXKV + (size_t)4 * 1024 * D * 2;
constexpr size_t LW_GU1 = 0, LW_DN1 = LW_GU1 + (size_t)2 * DFF * D, LW_IN = LW_DN1 + (size_t)D * DFF, LW_UQKV = LW_IN + (size_t)NIN * D, LW_BR = LW_UQKV + (size_t)(1536 + 2048) * 512,
                 LW_WO = LW_BR + (size_t)3 * D * 1024, LW_XQ = LW_WO + (size_t)D * D, LW_XO = LW_XQ + (size_t)512 * D, LW_GU2 = LW_XO + (size_t)D * 512, LW_DN2 = LW_GU2 + (size_t)2 * DFF * D,
                 LW_ELEMS = LW_DN2 + (size_t)D * DFF;
constexpr size_t WS_END = WS_LW + 4 * LW_ELEMS * 2;
constexpr int CW_BAR = 4096;
constexpr int RING_BYTES = 131072, MISC_OFF = RING_BYTES + 320, LDS_BYTES = 147456;
constexpr int NWAVES = 8;

typedef unsigned v4u __attribute__((ext_vector_type(4)));
#define LDS_WAIT() asm volatile("s_waitcnt lgkmcnt(0)" ::: "memory")
__device__ __forceinline__ unsigned f2bf(float f) { unsigned u = __builtin_bit_cast(unsigned, f); return (u + 0x7fffu + ((u >> 16) & 1u)) >> 16; }
__device__ __forceinline__ unsigned pk2(float lo, float hi) { return f2bf(lo) | (f2bf(hi) << 16); }
__device__ __forceinline__ float wave_sum(float v) {
#pragma unroll
    for (int o = 1; o < 64; o <<= 1) v += __shfl_xor(v, o);
    return v;
}

#define XB_TMO      128
#define XB_XCNT(j)  (256  + 64 * (j))
#define XB_XSUB(j)  (1280 + 64 * (j))
#define XB_XGEN(j)  (2304 + 64 * (j))
#define XB_TOP      3328
#define XB_TOPGEN   3392
#define XCD_BAR_WORDS 3456
#define XB_SPIN_CAP (1u << 18)
__device__ __forceinline__ unsigned xb_ld(unsigned* p)              { return __hip_atomic_load(p, __ATOMIC_RELAXED, __HIP_MEMORY_SCOPE_AGENT); }
__device__ __forceinline__ unsigned xb_add(unsigned* p, unsigned v) { return __hip_atomic_fetch_add(p, v, __ATOMIC_RELAXED, __HIP_MEMORY_SCOPE_AGENT); }
__device__ __forceinline__ unsigned xb_xcc_id() { return (unsigned)__builtin_amdgcn_s_getreg((3 << 11) | 20) & 0xFu; }
#define XB_SPIN(cond, bar) do { unsigned _sp = 0; while (cond) { __builtin_amdgcn_s_sleep(1); \
    if ((++_sp & 255u) == 0u) { if (xb_ld(&(bar)[XB_TMO])) break; if (_sp > XB_SPIN_CAP) { atomicAdd(&(bar)[XB_TMO], 1u); break; } } } } while (0)
struct XcdBarrier { unsigned* bar; unsigned x; volatile LAS unsigned* st; };
__device__ __forceinline__ XcdBarrier xcd_barrier_post(unsigned* bar, volatile LAS unsigned* st) {
    XcdBarrier b; b.bar = bar; b.x = xb_xcc_id(); b.st = st;
    if (threadIdx.x == 0) (void)xb_add(&bar[XB_XCNT(b.x)], 1u);
    return b;
}
__device__ __forceinline__ void xcd_barrier_complete(unsigned* bar, unsigned x, unsigned& nloc, unsigned& nx) {
    const unsigned G = gridDim.x * gridDim.y * gridDim.z;
    unsigned sum, cnt, mine, sp = 0u;
    for (;;) {
        sum = 0u; cnt = 0u; mine = 0u;
#pragma unroll
        for (unsigned j = 0; j < 16; ++j) { const unsigned c = xb_ld(&bar[XB_XCNT(j)]); sum += c; cnt += (c > 0u) ? 1u : 0u; mine = (j == x) ? c : mine; }
        if (sum == G) break;
        __builtin_amdgcn_s_sleep(1);
        if ((++sp & 255u) == 0u) { if (xb_ld(&bar[XB_TMO])) break; if (sp > XB_SPIN_CAP) { atomicAdd(&bar[XB_TMO], 1u); break; } }
    }
    nloc = mine > 0u ? mine : 1u; nx = cnt > 0u ? cnt : 1u;
}
__device__ __forceinline__ void xcd_barrier(const XcdBarrier& b) {
    asm volatile("s_waitcnt vmcnt(0)" ::: "memory");
    __syncthreads();
    if (threadIdx.x == 0) {
        unsigned* bar = b.bar; asm volatile("" : "+s"(bar));
        __builtin_amdgcn_s_waitcnt(0);
        unsigned nloc = b.st[0], nx = b.st[1];
        if (nloc == 0u) { xcd_barrier_complete(bar, b.x, nloc, nx); b.st[0] = nloc; b.st[1] = nx; }
        const unsigned old = xb_add(&bar[XB_XSUB(b.x)], 1u);
        const unsigned gen = old / nloc;
        if (old + 1u == (gen + 1u) * nloc) {
            __builtin_amdgcn_fence(__ATOMIC_RELEASE, "agent");
            asm volatile("s_waitcnt vmcnt(0)" ::: "memory");
            const unsigned og = xb_add(&bar[XB_TOP], 1u);
            const unsigned tg = og / nx;
            if (og + 1u == (tg + 1u) * nx) xb_add(&bar[XB_TOPGEN], 1u);
            else XB_SPIN(xb_ld(&bar[XB_TOPGEN]) == tg, bar);
            __builtin_amdgcn_fence(__ATOMIC_ACQUIRE, "agent");
            xb_add(&bar[XB_XGEN(b.x)], 1u);
            asm volatile("s_waitcnt vmcnt(0)" ::: "memory");
        } else {
            XB_SPIN(xb_ld(&bar[XB_XGEN(b.x)]) == gen, bar);
            __builtin_amdgcn_fence(__ATOMIC_ACQUIRE, "agent");
            asm volatile("s_waitcnt vmcnt(0)" ::: "memory");
        }
    }
    __syncthreads();
}

struct Args { const void* in[28]; float* out; unsigned char* ws; int ph_lo, ph_hi; };

__device__ __forceinline__ int perm64(int p) { const int a = p >> 3, j = p & 7; return j < 4 ? 4 * a + j : 32 + 4 * a + (j - 4); }
__device__ __forceinline__ int perm128(int p) { const int a = p >> 3, j = p & 7; return j < 4 ? 4 * a + j : 64 + 4 * a + (j - 4); }
__device__ __forceinline__ int srccol(int kind, int n) {
    if (kind == 0) return n;
    if (kind == 1) { const int pn = n >> 8, j = n & 255; return j < 128 ? pn * 128 + j : DFF + pn * 128 + (j - 128); }
    if (kind == 2) {
        if (n < 2048) return (n & ~63) + perm64(n & 63);
        if (n < 4096) return n;
        if (n < 5376) { const int m = n - 4096; return 4160 + (m & ~127) + perm128(m & 127); }
        if (n < 5632) return 5440 + (n - 5376);
        const int j = n - 5632; return j < 64 ? 4096 + perm64(j) : -1;
    }
    { const int h = n / 192, p = n - 192 * h; return p < 128 ? n : h * 192 + 128 + perm64(p - 128); }
}
__device__ __forceinline__ void cvt_matrix(const float* W, int ldw, int K, int Nd, bf16_t* WT, int kind, const float* gain, LAS float* scr, int gw, int NGW, int lane) {
    const int nblk = Nd / 32, items = (K / 64) * nblk;
    const int l8 = lane & 7, r8 = lane >> 3;
    f32x4 v[8];
    int it = gw;
#define CVT_LOAD(item) do { const int kb_ = (item) / nblk, nb_ = (item) - kb_ * nblk; const int sc_ = srccol(kind, 32 * nb_ + 4 * l8); \
        const float* wp_ = W + (size_t)(64 * kb_ + r8) * ldw + (sc_ >= 0 ? sc_ : 0); \
        _Pragma("unroll") for (int i = 0; i < 8; ++i) { v[i] = *(const GAS f32x4*)(wp_ + (size_t)(8 * i) * ldw); if (sc_ < 0) v[i] = (f32x4){0.f, 0.f, 0.f, 0.f}; } } while (0)
    if (it < items) CVT_LOAD(it);
    while (it < items) {
        const int kb = it / nblk, nb = it - kb * nblk, k0 = 64 * kb, n0 = 32 * nb;
#pragma unroll
        for (int i = 0; i < 8; ++i) { const int kk = 8 * i + r8; f32x4 x = v[i]; if (gain) x = x * ((const GAS float*)gain)[k0 + kk];
            LAS float* d = scr + kk * 33 + 4 * l8; d[0] = x[0]; d[1] = x[1]; d[2] = x[2]; d[3] = x[3]; }
        const int nit = it + NGW;
        if (nit < items) CVT_LOAD(nit);
        LDS_WAIT(); asm volatile("" ::: "memory");
#pragma unroll
        for (int j = 0; j < 4; ++j) { const int n = r8 + 8 * j; const LAS float* s = scr + (8 * l8) * 33 + n;
            v4u o; o.x = pg8::cvt_pk_bf16(s[0 * 33], s[1 * 33]); o.y = pg8::cvt_pk_bf16(s[2 * 33], s[3 * 33]); o.z = pg8::cvt_pk_bf16(s[4 * 33], s[5 * 33]); o.w = pg8::cvt_pk_bf16(s[6 * 33], s[7 * 33]);
            *(GAS v4u*)(WT + (size_t)(n0 + n) * K + k0 + 8 * l8) = o; }
        LDS_WAIT(); asm volatile("" ::: "memory");
        it = nit;
    }
#undef CVT_LOAD
}
__device__ __forceinline__ void norm_row_bf16(const float* xrow, const float* g, bf16_t* orow, int lane) {
    const f32x4* xr = (const f32x4*)xrow + lane; const f32x4* gr = (const f32x4*)g + lane;
    f32x4 v[8]; float s = 0.f;
#pragma unroll
    for (int j = 0; j < 8; ++j) { v[j] = xr[64 * j]; s += (v[j][0] * v[j][0] + v[j][1] * v[j][1]) + (v[j][2] * v[j][2] + v[j][3] * v[j][3]); }
    const float r = rsqrtf(wave_sum(s) * (1.f / D) + 1e-6f);
    unsigned long long* o8 = (unsigned long long*)orow + lane;
#pragma unroll
    for (int j = 0; j < 8; ++j) { const f32x4 gg = gr[64 * j]; o8[64 * j] = (unsigned long long)pk2(v[j][0] * r * gg[0], v[j][1] * r * gg[1]) | ((unsigned long long)pk2(v[j][2] * r * gg[2], v[j][3] * r * gg[3]) << 32); }
}
__device__ __forceinline__ void norm_row_f32(const float* xrow, const float* g, float* orow, int lane) {
    const f32x4* xr = (const f32x4*)xrow + lane; const f32x4* gr = (const f32x4*)g + lane;
    f32x4 v[8]; float s = 0.f;
#pragma unroll
    for (int j = 0; j < 8; ++j) { v[j] = xr[64 * j]; s += (v[j][0] * v[j][0] + v[j][1] * v[j][1]) + (v[j][2] * v[j][2] + v[j][3] * v[j][3]); }
    const float r = rsqrtf(wave_sum(s) * (1.f / D) + 1e-6f);
    f32x4* o = (f32x4*)orow + lane;
#pragma unroll
    for (int j = 0; j < 8; ++j) o[64 * j] = v[j] * r * gr[64 * j];
}
__device__ __forceinline__ void norm_phase(const float* H, const float* g, bf16_t* AN, int gw, int NGW, int lane) {
    for (int m = gw; m < S; m += NGW) norm_row_bf16(H + (size_t)m * D, g, AN + (size_t)m * D, lane);
}
__device__ __forceinline__ void mla_norm_phase(const bf16_t* CQR, const bf16_t* CKVR, const float* gq, const float* gkv, bf16_t* ACQ, int gw, int NGW, int lane) {
    for (int m = gw; m < 2 * S; m += NGW) {
        const bool kv = m >= S; const int row = kv ? m - S : m;
        const bf16_t* src = (kv ? CKVR : CQR) + (size_t)row * 512 + lane * 8; const float* g = (kv ? gkv : gq) + lane * 8;
        f32x4 v0, v1; unpack8(*(const u32x4*)src, v0, v1);
        const float s = (v0[0] * v0[0] + v0[1] * v0[1]) + (v0[2] * v0[2] + v0[3] * v0[3]) + (v1[0] * v1[0] + v1[1] * v1[1]) + (v1[2] * v1[2] + v1[3] * v1[3]);
        const float r = rsqrtf(wave_sum(s) * (1.f / 512.f) + 1e-6f);
        const f32x4 g0 = *(const f32x4*)g, g1 = *(const f32x4*)(g + 4);
        *(u32x4*)(ACQ + (size_t)m * 512 + lane * 8) = pack8(v0 * r * g0, v1 * r * g1);
    }
}

#ifndef SD_DIFF
#define SD_DIFF 2
#endif
#ifndef QL_MLA
#define QL_MLA 4
#endif
#ifndef SD_MLA
#define SD_MLA 1
#endif
#ifndef SD_GQA
#define SD_GQA 1
#endif
#ifndef SD_X
#define SD_X 2
#endif
constexpr float C_DIFF = 0.125f * LOG2E, C_MLA = 0.07216878364870323f * LOG2E, C_128 = 0.08838834764831845f * LOG2E;
__device__ __forceinline__ void diff_unit(const bf16_t* QD, const bf16_t* KD, const bf16_t* VD, float* atmp, bf16_t* OB0, const float* subln, float lam, float one_m_li, int h, int qb, char* lds) {
    int tid = threadIdx.x; asm volatile("" : "+v"(tid));
    const int lane = tid & 63, r32 = lane & 31;
    at::f32x16 o[4]; float rli[16];
    f32x4* tp = (f32x4*)(atmp + ((size_t)blockIdx.x * 512 + tid) * 64);
    for (int c = 0; c < 2; ++c) {
        at::attn_core1<64, false>(QD + (size_t)qb * 256 * 1024 + (2 * h + c) * 64, 1024, KD + (2 * h + c) * 64, 1024, VD + h * 128, 1024, S / 64, C_DIFF, at::THR / 0.125f, -1e30f, 0.f, 0, lds, o, rli);
        if (c == 0) {
#pragma unroll
            for (int d0 = 0; d0 < 4; ++d0)
#pragma unroll
                for (int r4 = 0; r4 < 4; ++r4) tp[d0 * 4 + r4] = (f32x4){o[d0][4 * r4] * rli[4 * r4], o[d0][4 * r4 + 1] * rli[4 * r4 + 1], o[d0][4 * r4 + 2] * rli[4 * r4 + 2], o[d0][4 * r4 + 3] * rli[4 * r4 + 3]};
        }
    }
    float ss[16];
#pragma unroll
    for (int r = 0; r < 16; ++r) ss[r] = 0.f;
#pragma unroll
    for (int d0 = 0; d0 < 4; ++d0) {
#pragma unroll
        for (int r4 = 0; r4 < 4; ++r4) { const f32x4 t = tp[d0 * 4 + r4];
#pragma unroll
            for (int j = 0; j < 4; ++j) { const int r = 4 * r4 + j; const float v = t[j] - lam * (o[d0][r] * rli[r]); o[d0][r] = v; ss[r] += v * v; } }
        asm volatile("" ::: "memory"); }
#pragma unroll
    for (int r = 0; r < 16; ++r) { float s = ss[r]; s += __shfl_xor(s, 1); s += __shfl_xor(s, 2); s += __shfl_xor(s, 4); s += __shfl_xor(s, 8); s += __shfl_xor(s, 16);
        rli[r] = rsqrtf(s * (1.f / 128.f) + 1e-5f) * one_m_li; }
#pragma unroll
    for (int d0 = 0; d0 < 4; ++d0) { const float g = subln[d0 * 32 + r32];
#pragma unroll
        for (int r = 0; r < 16; ++r) o[d0][r] *= g; }
    at::store_o(OB0 + (size_t)qb * 256 * 1024 + h * 128, 1024, o, rli);
}
__device__ __forceinline__ void mla_unit(const bf16_t* QM, const bf16_t* KM, const bf16_t* VM, bf16_t* OB1, int h, int qb, char* lds) {
    at::f32x16 o[4]; float rli[16];
    at::attn_core1<192, false>(QM + (size_t)qb * 256 * 1536 + h * 192, 1536, KM + h * 192, 1536, VM + h * 128, 1024, S / 64, C_MLA, at::THR / 0.07216878364870323f, -1e30f, 0.f, 0, lds, o, rli);
    at::store_o(OB1 + (size_t)qb * 256 * 1024 + h * 128, 1024, o, rli);
}
__device__ __forceinline__ void gqa_unit(const bf16_t* QG, const bf16_t* KG, const bf16_t* VG, bf16_t* OB2, const float* sink, int h, int qb, char* lds) {
    at::f32x16 o[4]; float rli[16];
    int k0 = qb * 256 - 128; if (k0 < 0) k0 = 0; int k1 = qb * 256 + 384; if (k1 > S) k1 = S;
    const int kvh = h >> 2;
    at::attn_core1<128, true>(QG + (size_t)qb * 256 * 1024 + h * 128, 1024, KG + (size_t)k0 * 256 + kvh * 128, 256, VG + (size_t)k0 * 256 + kvh * 128, 256, (k1 - k0) / 64, C_128,
                             at::THR / 0.08838834764831845f, sink[h] / 0.08838834764831845f, 1.f, qb * 256 - k0, lds, o, rli);
    at::store_o(OB2 + (size_t)qb * 256 * 1024 + h * 128, 1024, o, rli);
}
__device__ __forceinline__ void xattn_unit(const bf16_t* QX, const bf16_t* KVX, bf16_t* OX, int h, int qb, char* lds) {
    at::f32x16 o[4]; float rli[16];
    at::attn_core1<128, false>(QX + (size_t)qb * 256 * 512 + h * 128, 512, KVX + h * 128, 1024, KVX + 512 + h * 128, 1024, MEMLEN / 64, C_128, at::THR / 0.08838834764831845f, -1e30f, 0.f, 0, lds, o, rli);
    at::store_o(OX + (size_t)qb * 256 * 512 + h * 128, 512, o, rli);
}

constexpr int PH_PER_LAYER = 12, N_PHASES = 2 + DEPTH * PH_PER_LAYER + 1;

__device__ __forceinline__ unsigned char* ldptr(volatile LAS unsigned* PT, int i) {
    const unsigned lo = PT[2 * i], hi = PT[2 * i + 1];
    return (unsigned char*)(((unsigned long long)(unsigned)__builtin_amdgcn_readfirstlane((int)hi) << 32) | (unsigned)__builtin_amdgcn_readfirstlane((int)lo));
}
#define PIN(i) ((const float*)ldptr(PT, (i)))
#define WSP(T, off) ((T*)(ws + (off)))
#define PHASE_BEGIN() int tid = threadIdx.x; asm volatile("" : "+v"(tid)); const int lane = tid & 63, wave = __builtin_amdgcn_readfirstlane(tid >> 6), gw = bx * NWAVES + wave; \
    unsigned char* ws = ldptr(PT, 29); (void)lane; (void)gw; (void)ws

__device__ __forceinline__ bool in_rng(int k, int lo, int hi) { asm volatile("" : "+s"(k)); return lo <= k && k < hi; }
__global__ void __launch_bounds__(NWAVES * 64, 2) mega(Args args) {
    extern __shared__ __attribute__((aligned(16))) unsigned char lds_raw[];
    LAS unsigned char* lds = (LAS unsigned char*)lds_raw;
    volatile LAS unsigned* MISC = (volatile LAS unsigned*)(lds + MISC_OFF);
    volatile LAS unsigned* PT = (volatile LAS unsigned*)(lds + MISC_OFF + 256);
    const int G = gridDim.x, bx = blockIdx.x, NGW = G * NWAVES;
    for (int u = threadIdx.x; u < (LDS_BYTES - RING_BYTES) / 4; u += NWAVES * 64) ((LAS unsigned*)(lds + RING_BYTES))[u] = 0u;
    __syncthreads();
    if (threadIdx.x == 0) {
#define PT_SET(i, p) do { const unsigned long long v_ = (unsigned long long)(p); PT[2 * (i)] = (unsigned)v_; PT[2 * (i) + 1] = (unsigned)(v_ >> 32); } while (0)
        PT_SET(0, args.in[0]); PT_SET(1, args.in[1]); PT_SET(2, args.in[2]); PT_SET(3, args.in[3]); PT_SET(4, args.in[4]); PT_SET(5, args.in[5]); PT_SET(6, args.in[6]);
        PT_SET(7, args.in[7]); PT_SET(8, args.in[8]); PT_SET(9, args.in[9]); PT_SET(10, args.in[10]); PT_SET(11, args.in[11]); PT_SET(12, args.in[12]); PT_SET(13, args.in[13]);
        PT_SET(14, args.in[14]); PT_SET(15, args.in[15]); PT_SET(16, args.in[16]); PT_SET(17, args.in[17]); PT_SET(18, args.in[18]); PT_SET(19, args.in[19]); PT_SET(20, args.in[20]);
        PT_SET(21, args.in[21]); PT_SET(22, args.in[22]); PT_SET(23, args.in[23]); PT_SET(24, args.in[24]); PT_SET(25, args.in[25]); PT_SET(26, args.in[26]); PT_SET(27, args.in[27]);
        PT_SET(28, args.out); PT_SET(29, args.ws);
#undef PT_SET
    }
    __syncthreads();
#if MK_PER_PHASE
#define GRID_BAR() do { } while (0)
#else
    XcdBarrier bar = xcd_barrier_post((unsigned*)(args.ws + WS_CTL) + CW_BAR, MISC + 8);
#define GRID_BAR() xcd_barrier(bar)
#endif
    const int lo = args.ph_lo, hi = args.ph_hi;
#define IN(k) in_rng((k), lo, hi)
#define PH_ON(j) (MK_ONLY < 0 || MK_ONLY == (j))
#define BOTH(k) (IN(k) && IN((k) + 1))

    if (PH_ON(0) && IN(0)) {
        PHASE_BEGIN();
        LAS float* scr = (LAS float*)(lds + wave * 16384);
        bf16_t* LW = WSP(bf16_t, WS_LW); bf16_t* WXKV = WSP(bf16_t, WS_WXKV); bf16_t* MEMN = WSP(bf16_t, WS_MEMN);
        for (int rep = 0; rep < (MK_DUP == 100 ? 2 : 1); ++rep)
        for (int l = 0; l < DEPTH; ++l) {
            bf16_t* lw = LW + (size_t)l * LW_ELEMS;
            cvt_matrix(PIN(4) + (size_t)l * D * 2 * DFF, 2 * DFF, D, 2 * DFF, lw + LW_GU1, 1, PIN(3) + (size_t)l * D, scr, gw, NGW, lane);
            cvt_matrix(PIN(5) + (size_t)l * DFF * D, D, DFF, D, lw + LW_DN1, 0, nullptr, scr, gw, NGW, lane);
            cvt_matrix(PIN(7) + (size_t)l * D * DIN, DIN, D, 5888, lw + LW_IN, 2, PIN(6) + (size_t)l * D, scr, gw, NGW, lane);
            cvt_matrix(PIN(16) + (size_t)l * D * 3 * D, 3 * D, D, 3 * D, lw + LW_IN + (size_t)5888 * D, 0, PIN(6) + (size_t)l * D, scr, gw, NGW, lane);
            cvt_matrix(PIN(12) + (size_t)l * 512 * 1536, 1536, 512, 1536, lw + LW_UQKV, 3, PIN(10) + (size_t)l * 512, scr, gw, NGW, lane);
            cvt_matrix(PIN(13) + (size_t)l * 512 * 2048, 2048, 512, 2048, lw + LW_UQKV + (size_t)1536 * 512, 0, PIN(11) + (size_t)l * 512, scr, gw, NGW, lane);
            for (int n = 0; n < 3; ++n) cvt_matrix(PIN(15) + ((size_t)l * 3 + n) * 1024 * D, D, 1024, D, lw + LW_BR + (size_t)n * D * 1024, 0, nullptr, scr, gw, NGW, lane);
            cvt_matrix(PIN(18) + (size_t)l * D * D, D, D, D, lw + LW_WO, 0, nullptr, scr, gw, NGW, lane);
            cvt_matrix(PIN(21) + (size_t)l * D * 512, 512, D, 512, lw + LW_XQ, 0, PIN(19) + (size_t)l * D, scr, gw, NGW, lane);
            cvt_matrix(PIN(22) + (size_t)l * D * 1024, 1024, D, 1024, WXKV + (size_t)l * 1024 * D, 0, nullptr, scr, gw, NGW, lane);
            cvt_matrix(PIN(23) + (size_t)l * 512 * D, D, 512, D, lw + LW_XO, 0, nullptr, scr, gw, NGW, lane);
            cvt_matrix(PIN(25) + (size_t)l * D * 2 * DFF, 2 * DFF, D, 2 * DFF, lw + LW_GU2, 1, PIN(24) + (size_t)l * D, scr, gw, NGW, lane);
            cvt_matrix(PIN(26) + (size_t)l * DFF * D, D, DFF, D, lw + LW_DN2, 0, nullptr, scr, gw, NGW, lane);
            for (int m = gw; m < MEMLEN; m += NGW) norm_row_bf16(PIN(1) + (size_t)m * D, PIN(20) + (size_t)l * D, MEMN + ((size_t)l * MEMLEN + m) * D, lane);
        }
        { float2* CS64 = WSP(float2, WS_CS64); float2* CS128 = WSP(float2, WS_CS128); const int* pos = (const int*)PIN(2);
          for (int idx = bx * 512 + tid; idx < S * 96; idx += G * 512) {
            const int s = idx / 96, j = idx - 96 * s; const int dim = j < 32 ? 64 : 128, i = j < 32 ? j : j - 32;
            const float inv = powf(10000.0f, -((float)(2 * i) / (float)dim)); const float ang = (float)pos[s] * inv;
            const float2 v = make_float2(cosf(ang), sinf(ang));
            if (j < 32) CS64[s * 32 + i] = v; else CS128[s * 64 + i] = v; } }
        { const float* x = PIN(0); float* H = WSP(float, WS_H); bf16_t* AN = WSP(bf16_t, WS_AN); rss_t* RSS0 = (rss_t*)(ws + WS_PART);
          for (int m = gw; m < S; m += NGW) {
            const f32x4* xr = (const f32x4*)(x + (size_t)m * D) + lane; f32x4* hr = (f32x4*)(H + (size_t)m * D) + lane; unsigned long long* o8 = (unsigned long long*)(AN + (size_t)m * D) + lane; float s = 0.f;
#pragma unroll
            for (int j = 0; j < 8; ++j) { const f32x4 v = xr[64 * j]; hr[64 * j] = v; s += (v[0] * v[0] + v[1] * v[1]) + (v[2] * v[2] + v[3] * v[3]);
                o8[64 * j] = (unsigned long long)pg8::cvt_pk_bf16(v[0], v[1]) | ((unsigned long long)pg8::cvt_pk_bf16(v[2], v[3]) << 32); }
            s = wave_sum(s); if (lane < 8) RSS0[(size_t)m * 8 + lane] = lane == 0 ? s : 0.f; } }
        if (BOTH(0)) GRID_BAR();
    }
    for (int l = 0; l < DEPTH; ++l) {
        const int pb = 2 + l * PH_PER_LAYER;
        const float lambda_init = 0.8f - 0.6f * expf(-0.3f * (float)l);
#define NREP(j) ((MK_DUP == (j) && l == 0) ? 2 : 1)
#define LWP(off) (WSP(bf16_t, WS_LW) + (size_t)l * LW_ELEMS + (off))
#define RSSP(k) ((rss_t*)(ws + WS_PART) + (size_t)(4 * l + (k)) * S * 8)
#define RSSMP() ((rss_t*)(ws + WS_PARTM) + (size_t)l * 2 * S * 2)
        for (int rep = 0; rep < NREP(0); ++rep) if (PH_ON(2 + 0) && IN(pb + 0)) {
            PHASE_BEGIN();
            pg8::Gemm g{WSP(bf16_t, WS_AN), LWP(LW_GU1), S, 2 * DFF, D}; pg8::StaticOrder O; O.init(S, 2 * DFF, G, bx); EpiSwiglu E{WSP(bf16_t, WS_HID), RSSP(0)};
            pg8::gemm_phase<EpiSwiglu, pg8::StaticOrder>(lds, g, O, E);
            if (BOTH(pb + 0)) GRID_BAR();
        }
        for (int rep = 0; rep < NREP(1); ++rep) if (PH_ON(2 + 1) && IN(pb + 1)) {
            PHASE_BEGIN();
            pg8::Gemm g{WSP(bf16_t, WS_HID), LWP(LW_DN1), S, D, DFF}; pg8::StaticOrder O; O.init(S, D, G, bx); EpiResid E{WSP(float, WS_H), rep ? 0.f : 0.5f, rep ? nullptr : WSP(bf16_t, WS_AN), RSSP(1), lds};
            pg8::gemm_phase<EpiResid, pg8::StaticOrder>(lds, g, O, E);
            if (BOTH(pb + 1)) GRID_BAR();
        }
        for (int rep = 0; rep < NREP(2); ++rep) if (PH_ON(2 + 2) && IN(pb + 2)) {
            PHASE_BEGIN();
            pg8::Gemm g{WSP(bf16_t, WS_AN), LWP(LW_IN), S, NIN, D}; pg8::StaticOrder O; O.init(S, NIN, G, bx);
            EpiIn E{WSP(bf16_t, WS_QD), WSP(bf16_t, WS_KD), WSP(bf16_t, WS_VD), WSP(bf16_t, WS_CQR), WSP(bf16_t, WS_CKVR), WSP(bf16_t, WS_QG), WSP(bf16_t, WS_KG), WSP(bf16_t, WS_VG), WSP(bf16_t, WS_KM),
                    WSP(bf16_t, WS_GATE), WSP(float2, WS_CS64), WSP(float2, WS_CS128), PIN(17) + (size_t)l * 3 * D, RSSP(1), rep ? (rss_t*)nullptr : RSSMP(), lds};
            pg8::gemm_phase<EpiIn, pg8::StaticOrder>(lds, g, O, E);
            if (BOTH(pb + 2)) GRID_BAR();
        }
        for (int rep = 0; rep < NREP(3); ++rep) if (PH_ON(2 + 3) && IN(pb + 3)) {
            PHASE_BEGIN();
            pg8::Gemm g{WSP(bf16_t, WS_CQR), LWP(LW_UQKV), 2 * S, 1536 + 2048, 512}; MlaOrder O{G, bx}; EpiMlaUp E{WSP(bf16_t, WS_QM), WSP(bf16_t, WS_KM), WSP(bf16_t, WS_VM), WSP(float2, WS_CS64), RSSMP()};
            pg8::gemm_phase<EpiMlaUp, MlaOrder>(lds, g, O, E);
            if (BOTH(pb + 3)) GRID_BAR();
        }
        for (int rep = 0; rep < NREP(4); ++rep) if (PH_ON(2 + 4) && IN(pb + 4)) {
            { PHASE_BEGIN();
              const float* lp = PIN(8) + (size_t)l * 256;
              const float lam = expf(wave_sum(lp[lane] * lp[64 + lane])) - expf(wave_sum(lp[128 + lane] * lp[192 + lane])) + lambda_init;
              for (int r2 = 0; r2 < NREP(60); ++r2) for (int L = bx; L < 256; L += G) diff_unit(WSP(bf16_t, WS_QD), WSP(bf16_t, WS_KD), WSP(bf16_t, WS_VD), WSP(float, WS_ATMP), WSP(bf16_t, WS_OB), PIN(9) + (size_t)l * 128, lam, 1.f - lambda_init, L & 7, L >> 3, (char*)lds_raw); }
            { PHASE_BEGIN();
              for (int r2 = 0; r2 < NREP(61); ++r2) for (int L = bx; L < 256; L += G) mla_unit(WSP(bf16_t, WS_QM), WSP(bf16_t, WS_KM), WSP(bf16_t, WS_VM), WSP(bf16_t, WS_OB) + (size_t)S * 1024, L & 7, L >> 3, (char*)lds_raw); }
            { PHASE_BEGIN();
              for (int r2 = 0; r2 < NREP(62); ++r2) for (int L = bx; L < 256; L += G) gqa_unit(WSP(bf16_t, WS_QG), WSP(bf16_t, WS_KG), WSP(bf16_t, WS_VG), WSP(bf16_t, WS_OB) + (size_t)2 * S * 1024, PIN(14) + (size_t)l * 8, L & 7, L >> 3, (char*)lds_raw); }
            __syncthreads();
            if (BOTH(pb + 4)) GRID_BAR();
        }
        for (int rep = 0; rep < NREP(5); ++rep) if (PH_ON(2 + 5) && IN(pb + 5)) {
            PHASE_BEGIN();
            pg8::Gemm g{WSP(bf16_t, WS_OB), LWP(LW_BR), 3 * S, 3 * D, 1024}; BranchOrder O; O.so.init(S, D, G, bx); EpiBranch E{WSP(bf16_t, WS_GATE), WSP(bf16_t, WS_MG)};
            pg8::gemm_phase<EpiBranch, BranchOrder>(lds, g, O, E);
            if (BOTH(pb + 5)) GRID_BAR();
        }
        for (int rep = 0; rep < NREP(6); ++rep) if (PH_ON(2 + 6) && IN(pb + 6)) {
            PHASE_BEGIN();
            pg8::Gemm g{WSP(bf16_t, WS_MG), LWP(LW_WO), S, D, D}; pg8::StaticOrder O; O.init(S, D, G, bx); EpiResid E{WSP(float, WS_H), rep ? 0.f : 1.f, rep ? nullptr : WSP(bf16_t, WS_AN), RSSP(2), lds};
            pg8::gemm_phase<EpiResid, pg8::StaticOrder>(lds, g, O, E);
            if (BOTH(pb + 6)) GRID_BAR();
        }
        for (int rep = 0; rep < NREP(7); ++rep) if (PH_ON(2 + 7) && IN(pb + 7)) {
            PHASE_BEGIN();
            if (l == 0 && bx >= 64) {
                pg8::Gemm g{WSP(bf16_t, WS_MEMN), WSP(bf16_t, WS_WXKV), 4 * MEMLEN, 4 * 1024, D}; KvxOrder O{G - 64, bx - 64}; EpiPlain E{WSP(bf16_t, WS_KVX), 1024, 4, nullptr};
                pg8::gemm_phase<EpiPlain, KvxOrder>(lds, g, O, E);
            } else {
            pg8::Gemm g{WSP(bf16_t, WS_AN), LWP(LW_XQ), S, 512, D}; pg8::StaticOrder O; O.init(S, 512, G, bx); EpiPlain E{WSP(bf16_t, WS_QX), 512, 0, RSSP(2)};
            pg8::gemm_phase<EpiPlain, pg8::StaticOrder>(lds, g, O, E);
            }
            if (BOTH(pb + 7)) GRID_BAR();
        }
        for (int rep = 0; rep < NREP(8); ++rep) if (PH_ON(2 + 8) && IN(pb + 8)) {
            PHASE_BEGIN();
            for (int L = bx; L < 128; L += G) xattn_unit(WSP(bf16_t, WS_QX), WSP(bf16_t, WS_KVX) + (size_t)l * MEMLEN * 1024, WSP(bf16_t, WS_OX), L & 3, L >> 2, (char*)lds_raw);
            __syncthreads();
            if (BOTH(pb + 8)) GRID_BAR();
        }
        for (int rep = 0; rep < NREP(9); ++rep) if (PH_ON(2 + 9) && IN(pb + 9)) {
            PHASE_BEGIN();
            pg8::Gemm g{WSP(bf16_t, WS_OX), LWP(LW_XO), S, D, 512}; pg8::StaticOrder O; O.init(S, D, G, bx); EpiResid E{WSP(float, WS_H), rep ? 0.f : 1.f, rep ? nullptr : WSP(bf16_t, WS_AN), RSSP(3), lds};
            pg8::gemm_phase<EpiResid, pg8::StaticOrder>(lds, g, O, E);
            if (BOTH(pb + 9)) GRID_BAR();
        }
        for (int rep = 0; rep < NREP(10); ++rep) if (PH_ON(2 + 10) && IN(pb + 10)) {
            PHASE_BEGIN();
            pg8::Gemm g{WSP(bf16_t, WS_AN), LWP(LW_GU2), S, 2 * DFF, D}; pg8::StaticOrder O; O.init(S, 2 * DFF, G, bx); EpiSwiglu E{WSP(bf16_t, WS_HID), RSSP(3)};
            pg8::gemm_phase<EpiSwiglu, pg8::StaticOrder>(lds, g, O, E);
            if (BOTH(pb + 10)) GRID_BAR();
        }
        for (int rep = 0; rep < NREP(11); ++rep) if (PH_ON(2 + 11) && IN(pb + 11)) {
            PHASE_BEGIN();
            pg8::Gemm g{WSP(bf16_t, WS_HID), LWP(LW_DN2), S, D, DFF}; pg8::StaticOrder O; O.init(S, D, G, bx); EpiResid E{WSP(float, WS_H), rep ? 0.f : 0.5f, rep ? nullptr : WSP(bf16_t, WS_AN), RSSP(4), lds};
            pg8::gemm_phase<EpiResid, pg8::StaticOrder>(lds, g, O, E);
            if (BOTH(pb + 11)) GRID_BAR();
        }
#undef LWP
#undef RSSP
#undef RSSMP
    }
    if (PH_ON(14) && IN(2 + DEPTH * PH_PER_LAYER)) {
        PHASE_BEGIN();
        const float* H = WSP(float, WS_H); const float* fg = PIN(27); float* out = (float*)ldptr(PT, 28);
        for (int m = gw; m < S; m += NGW) norm_row_f32(H + (size_t)m * D, fg, out + (size_t)m * D, lane);
    }
#undef IN
#undef BOTH
}
}

extern "C" void kernel_launch(void* const* d_in, const int* in_sizes, int n_in, void* d_out, int out_size, void* d_ws, size_t ws_size, hipStream_t stream) {
    using namespace mk;
    static int grid = 0;
    if (grid == 0) {
        if (n_in != 28 || out_size != S * D || ws_size < WS_END) { fprintf(stderr, "kernel_launch: unexpected n_in %d out %d ws %zu (need %zu)\n", n_in, out_size, ws_size, (size_t)WS_END); grid = -1; return; }
        int dev = 0, cus = 0, per_cu = 0;
        if (hipGetDevice(&dev) != hipSuccess || hipDeviceGetAttribute(&cus, hipDeviceAttributeMultiprocessorCount, dev) != hipSuccess) { grid = -1; return; }
        if (hipFuncSetAttribute((const void*)mega, hipFuncAttributeMaxDynamicSharedMemorySize, LDS_BYTES) != hipSuccess) { fprintf(stderr, "kernel_launch: hipFuncSetAttribute failed\n"); grid = -1; return; }
        if (hipOccupancyMaxActiveBlocksPerMultiprocessor(&per_cu, (const void*)mega, NWAVES * 64, LDS_BYTES) != hipSuccess || per_cu < 1) { fprintf(stderr, "kernel_launch: occupancy query says %d\n", per_cu); }
        (void)hipGetLastError();
        grid = cus;
    }
    if (grid < 0) return;
    (void)hipMemsetAsync((char*)d_ws + WS_CTL, 0, CTL_ZERO_BYTES, stream);
    Args a{};
    for (int i = 0; i < 28; ++i) a.in[i] = d_in[i];
    a.out = (float*)d_out; a.ws = (unsigned char*)d_ws;
#if MK_PER_PHASE
    for (int p = 0; p < N_PHASES; ++p) { a.ph_lo = p; a.ph_hi = p + 1; hipLaunchKernelGGL(mega, dim3(grid), dim3(NWAVES * 64), LDS_BYTES, stream, a); }
#else
    a.ph_lo = 0; a.ph_hi = N_PHASES; hipLaunchKernelGGL(mega, dim3(grid), dim3(NWAVES * 64), LDS_BYTES, stream, a);
#endif
    const hipError_t le = hipPeekAtLastError();
    if (le != hipSuccess) fprintf(stderr, "kernel_launch: launch failed: %s\n", hipGetErrorName(le));
}
```

```cpp
#include <hip/hip_runtime.h>
#include <cstdio>
#include <cmath>
#include <cstdint>
#ifndef MK_PER_PHASE
#define MK_PER_PHASE 0
#endif
#ifndef MK_ONLY
#define MK_ONLY -1
#endif
#ifndef MK_DUP
#define MK_DUP -1
#endif
#ifndef MK_STAMP
#define MK_STAMP -1
#endif
#ifndef MK_SPLIT_IN
#define MK_SPLIT_IN 1
#endif
namespace pg8 {
#define PG8_LAS __attribute__((address_space(3)))
typedef unsigned short bf16_t;
typedef short bf16x8 __attribute__((ext_vector_type(8)));
typedef float f32x4 __attribute__((ext_vector_type(4)));
typedef unsigned u32x4 __attribute__((ext_vector_type(4)));
constexpr int BM = 256, BK = 64, HALF = 128, HTB = HALF * BK * 2, STAGE_BYTES = 8 * HTB, NXCD = 8, WGM = 8;

__host__ __device__ __forceinline__ int lds_byte(int r, int c) { const int st = (r >> 4) * 2 + (c >> 5), rr = r & 15, cc = c & 31, ob = rr * 64 + cc * 2; return st * 1024 + (ob ^ (((ob >> 9) & 1) << 5)); }
__host__ __device__ __forceinline__ void stage_rc(int b, int& R, int& C) { const int st = b / 1024, sb = b % 1024, swz = sb ^ (((sb >> 9) & 1) << 5); R = (st >> 1) * 16 + swz / 64; C = (st & 1) * 32 + (swz % 64) / 2; }
__host__ __device__ __forceinline__ int perm32(int rho) { const int n = rho >> 4, i = rho & 15; return 8 * (i >> 2) + 4 * n + (i & 3); }

struct Unit { int pm, pn; };
struct Gemm { const bf16_t* A; const bf16_t* Bt; int M, N, K; };

struct StaticOrder {
    int nM, nN, nwg, G, c;
    __host__ __device__ void init(int M, int N, int G_, int c_) { nM = M / BM; nN = N / BM; nwg = nM * nN; G = G_; c = c_; }
    __host__ __device__ bool map(int L, Unit& u) const {
        if (L >= nwg) return false;
        int wgid = (int)L; { const int q = nwg / NXCD, r = nwg % NXCD, xcd = wgid % NXCD, off = wgid / NXCD; wgid = (xcd < r ? xcd * (q + 1) : r * (q + 1) + (xcd - r) * q) + off; }
        const int nig = WGM * nN, gid = wgid / nig, fm = gid * WGM, gsz = (nM - fm) < WGM ? (nM - fm) : WGM;
        u.pm = fm + ((wgid % nig) % gsz); u.pn = (wgid % nig) / gsz; return true;
    }
    __host__ __device__ bool next(int i, Unit& u) const { return map(i * G + c, u); }
    __device__ __forceinline__ void a_ready(const Unit&) const {}
    __device__ __forceinline__ void done(const Unit&) const {}
};

__device__ __forceinline__ unsigned cvt_pk_bf16(float lo, float hi) { unsigned r; asm volatile("v_cvt_pk_bf16_f32 %0, %1, %2" : "=v"(r) : "v"(lo), "v"(hi)); return r; }
__device__ __forceinline__ u32x4 pack8(const f32x4 v0, const f32x4 v1) { u32x4 w; w.x = cvt_pk_bf16(v0[0], v0[1]); w.y = cvt_pk_bf16(v0[2], v0[3]); w.z = cvt_pk_bf16(v1[0], v1[1]); w.w = cvt_pk_bf16(v1[2], v1[3]); return w; }
__device__ __forceinline__ void unpack8(const u32x4 w, f32x4& v0, f32x4& v1) {
    v0[0] = __uint_as_float(w.x << 16); v0[1] = __uint_as_float(w.x & 0xffff0000u); v0[2] = __uint_as_float(w.y << 16); v0[3] = __uint_as_float(w.y & 0xffff0000u);
    v1[0] = __uint_as_float(w.z << 16); v1[1] = __uint_as_float(w.z & 0xffff0000u); v1[2] = __uint_as_float(w.w << 16); v1[3] = __uint_as_float(w.w & 0xffff0000u); }

template <class Epi, class Sched, bool ALIGN_EPI = true, bool SP2 = true>
__device__ __forceinline__ void gemm_phase(PG8_LAS unsigned char* lds, const Gemm g, const Sched& S, const Epi& E) {
    int tid = threadIdx.x; asm volatile("" : "+v"(tid));
    const int wid = __builtin_amdgcn_readfirstlane(tid >> 6), lane = tid & 63, wr = wid >> 2, wc = wid & 3, fr = lane & 15, fq = lane >> 4;
    const int K = g.K, nt = K / BK;
    unsigned voffA[2], voffB[2];
#pragma unroll
    for (int i = 0; i < 2; ++i) { int R, C; stage_rc(tid * 16 + i * 8192, R, C); const int Rb = Epi::PERM ? ((R & ~31) + perm32(R & 31)) : R;
        voffA[i] = (unsigned)(R * K + C) * 2u; voffB[i] = (unsigned)(Rb * K + C) * 2u; }
    const size_t kstep = (size_t)(BK * 2);
    const size_t hstep = (size_t)HALF * K * 2;
    const size_t tstep = 2 * hstep;
    const unsigned ldsw = (unsigned)wid * 1024u;
    const int aoff = lds_byte(wr * 64 + fr, fq * 8), boff = lds_byte(wc * 32 + fr, fq * 8);
#define PG8_SA(b, h) (((b) * 2 + (h)) * HTB)
#define PG8_SB(b, h) ((4 + (b) * 2 + (h)) * HTB)
#define PG8_STAGE(bufoff, gbase, voff) do { _Pragma("unroll") for (int _i = 0; _i < 2; ++_i) \
        __builtin_amdgcn_global_load_lds((const unsigned*)((const char*)(gbase) + (voff)[_i]), (PG8_LAS unsigned*)(lds + (bufoff) + ldsw + _i * 8192), 16, 0, 0); } while (0)
#define PG8_LDA(dst, b, h) do { _Pragma("unroll") for (int m = 0; m < 4; ++m) _Pragma("unroll") for (int k = 0; k < 2; ++k) dst[m][k] = *(const PG8_LAS bf16x8*)(lds + PG8_SA(b, h) + aoff + m * 2048 + k * 1024); } while (0)
#define PG8_LDB(dst, b, h) do { _Pragma("unroll") for (int n = 0; n < 2; ++n) _Pragma("unroll") for (int k = 0; k < 2; ++k) dst[n][k] = *(const PG8_LAS bf16x8*)(lds + PG8_SB(b, h) + boff + n * 2048 + k * 1024); } while (0)
#define PG8_MMA(ai, bj, At, Bt) do { __builtin_amdgcn_s_setprio(1); _Pragma("unroll") for (int m = 0; m < 4; ++m) _Pragma("unroll") for (int n = 0; n < 2; ++n) _Pragma("unroll") for (int k = 0; k < 2; ++k) \
        acc[ai][bj][m][n] = __builtin_amdgcn_mfma_f32_16x16x32_bf16(Bt[n][k], At[m][k], acc[ai][bj][m][n], 0, 0, 0); __builtin_amdgcn_s_setprio(0); } while (0)
#define PG8_WAIT_V(n) asm volatile("s_waitcnt vmcnt(" #n ")" ::: "memory")
#define PG8_WAIT_L(n) asm volatile("s_waitcnt lgkmcnt(" #n ")" ::: "memory")
#define PG8_BAR __builtin_amdgcn_s_barrier()
#define PG8_SCHED __builtin_amdgcn_sched_barrier(0)
    Unit cur, nxt; int ui = 0;
    if (!S.next(0, cur)) return;
    f32x4 acc[2][2][4][2];
#pragma unroll
    for (int a = 0; a < 2; ++a)
#pragma unroll
        for (int b = 0; b < 2; ++b)
#pragma unroll
            for (int m = 0; m < 4; ++m)
#pragma unroll
                for (int n = 0; n < 2; ++n) acc[a][b][m][n] = (f32x4){0.f, 0.f, 0.f, 0.f};
    bf16x8 At[4][2], B0[2][2], B1[2][2];
    const char* cA = (const char*)g.A + (size_t)cur.pm * tstep; const char* cB = (const char*)g.Bt + (size_t)cur.pn * tstep;
    S.a_ready(cur);
    if constexpr (SP2) {
        PG8_STAGE(PG8_SB(0, 0), cB, voffB); PG8_STAGE(PG8_SB(0, 1), cB + hstep, voffB); PG8_STAGE(PG8_SA(0, 0), cA, voffA); PG8_STAGE(PG8_SA(0, 1), cA + hstep, voffA);
        if (wr == 1) PG8_BAR;
        PG8_WAIT_V(2); PG8_BAR;
        PG8_STAGE(PG8_SB(1, 0), cB + kstep, voffB); PG8_STAGE(PG8_SA(1, 0), cA + kstep, voffA); PG8_STAGE(PG8_SB(1, 1), cB + hstep + kstep, voffB);
        PG8_WAIT_V(6); PG8_BAR;
    } else {
        PG8_STAGE(PG8_SB(0, 0), cB, voffB); PG8_STAGE(PG8_SA(0, 0), cA, voffA); PG8_STAGE(PG8_SB(0, 1), cB + hstep, voffB); PG8_STAGE(PG8_SA(0, 1), cA + hstep, voffA);
        if (wr == 1) PG8_BAR;
        PG8_WAIT_V(4); PG8_BAR;
        PG8_STAGE(PG8_SB(1, 0), cB + kstep, voffB); PG8_STAGE(PG8_SA(1, 0), cA + kstep, voffA); PG8_STAGE(PG8_SB(1, 1), cB + hstep + kstep, voffB);
        PG8_WAIT_V(6); PG8_BAR;
    }
    for (;;) {
        const bool has_next = S.next(ui + 1, nxt);
        const char* nA = has_next ? (const char*)g.A + (size_t)nxt.pm * tstep : cA; const char* nB = has_next ? (const char*)g.Bt + (size_t)nxt.pn * tstep : cB;
        for (int t = 0; t < nt; t += 2) {
            const bool last = (t == nt - 2);
            const char* a1 = cA + (size_t)(t + 1) * kstep;
            const char* a2 = last ? nA : cA + (size_t)(t + 2) * kstep; const char* b2 = last ? nB : cB + (size_t)(t + 2) * kstep;
            const char* a3 = a2 + kstep; const char* b3 = b2 + kstep;
            if (last && has_next) S.a_ready(nxt);
            if constexpr (SP2) {
            PG8_LDB(B0, 0, 0); PG8_LDB(B1, 0, 1); PG8_SCHED; PG8_LDA(At, 0, 0); PG8_STAGE(PG8_SA(1, 1), a1 + hstep, voffA);
            PG8_WAIT_V(8); PG8_WAIT_L(0); PG8_BAR; PG8_MMA(0, 0, At, B0); PG8_MMA(0, 1, At, B1); PG8_BAR; PG8_SCHED;
            PG8_LDA(At, 0, 1); PG8_STAGE(PG8_SB(0, 0), b2, voffB); PG8_STAGE(PG8_SB(0, 1), b2 + hstep, voffB); PG8_STAGE(PG8_SA(0, 0), a2, voffA);
            PG8_WAIT_V(8); PG8_WAIT_L(0); PG8_BAR; PG8_MMA(1, 0, At, B0); PG8_MMA(1, 1, At, B1); PG8_BAR; PG8_SCHED;
            PG8_LDB(B0, 1, 0); PG8_LDB(B1, 1, 1); PG8_SCHED; PG8_LDA(At, 1, 0); PG8_STAGE(PG8_SA(0, 1), a2 + hstep, voffA);
            PG8_WAIT_V(8); PG8_WAIT_L(0); PG8_BAR; PG8_MMA(0, 0, At, B0); PG8_MMA(0, 1, At, B1); PG8_BAR; PG8_SCHED;
            PG8_LDA(At, 1, 1); PG8_STAGE(PG8_SB(1, 0), b3, voffB); PG8_STAGE(PG8_SB(1, 1), b3 + hstep, voffB); PG8_STAGE(PG8_SA(1, 0), a3, voffA);
            PG8_WAIT_V(8); PG8_WAIT_L(0); PG8_BAR; PG8_MMA(1, 0, At, B0); PG8_MMA(1, 1, At, B1); PG8_BAR; PG8_SCHED;
            } else {
            PG8_LDB(B0, 0, 0); PG8_SCHED; PG8_LDA(At, 0, 0); PG8_STAGE(PG8_SA(1, 1), a1 + hstep, voffA);
            PG8_WAIT_L(8); PG8_BAR; PG8_WAIT_L(0); PG8_MMA(0, 0, At, B0); PG8_BAR; PG8_SCHED;
            PG8_LDB(B1, 0, 1); PG8_STAGE(PG8_SB(0, 0), b2, voffB);
            PG8_BAR; PG8_WAIT_L(0); PG8_MMA(0, 1, At, B1); PG8_BAR;
            PG8_LDA(At, 0, 1); PG8_STAGE(PG8_SA(0, 0), a2, voffA);
            PG8_BAR; PG8_WAIT_L(0); PG8_MMA(1, 0, At, B0); PG8_BAR; PG8_SCHED;
            PG8_STAGE(PG8_SB(0, 1), b2 + hstep, voffB);
            PG8_WAIT_V(6); PG8_BAR; PG8_MMA(1, 1, At, B1); PG8_BAR;
            PG8_LDB(B0, 1, 0); PG8_SCHED; PG8_LDA(At, 1, 0); PG8_STAGE(PG8_SA(0, 1), a2 + hstep, voffA);
            PG8_WAIT_L(8); PG8_BAR; PG8_WAIT_L(0); PG8_MMA(0, 0, At, B0); PG8_BAR; PG8_SCHED;
            PG8_LDB(B1, 1, 1); PG8_STAGE(PG8_SB(1, 0), b3, voffB);
            PG8_BAR; PG8_WAIT_L(0); PG8_MMA(0, 1, At, B1); PG8_BAR;
            PG8_LDA(At, 1, 1); PG8_STAGE(PG8_SA(1, 0), a3, voffA);
            PG8_BAR; PG8_WAIT_L(0); PG8_MMA(1, 0, At, B0); PG8_BAR; PG8_SCHED;
            PG8_STAGE(PG8_SB(1, 1), b3 + hstep, voffB);
            PG8_WAIT_V(6); PG8_BAR; PG8_MMA(1, 1, At, B1); PG8_BAR;
            }
        }
        if constexpr (ALIGN_EPI) { if (wr == 0) PG8_BAR; }
        E(acc, cur, wr, wc, fr, fq); S.done(cur);
        if (!has_next) break;
        bool keep = false;
        if constexpr (Epi::CHAIN) keep = E.keep(cur);
        if (!keep) {
#pragma unroll
        for (int a = 0; a < 2; ++a)
#pragma unroll
            for (int b = 0; b < 2; ++b)
#pragma unroll
                for (int m = 0; m < 4; ++m)
#pragma unroll
                    for (int n = 0; n < 2; ++n) acc[a][b][m][n] = (f32x4){0.f, 0.f, 0.f, 0.f};
        }
        cur = nxt; cA = nA; cB = nB; ++ui;
        if constexpr (ALIGN_EPI) { if (wr == 1) PG8_BAR; }
    }
    PG8_WAIT_V(0);
    if constexpr (!ALIGN_EPI) { if (wr == 0) PG8_BAR; }
    PG8_BAR;
#undef PG8_SA
#undef PG8_SB
#undef PG8_STAGE
#undef PG8_LDA
#undef PG8_LDB
#undef PG8_MMA
#undef PG8_WAIT_V
#undef PG8_WAIT_L
#undef PG8_BAR
#undef PG8_SCHED
}
}
namespace mk {
using pg8::bf16_t; using pg8::f32x4; using pg8::u32x4; using pg8::Unit; using pg8::pack8; using pg8::unpack8;
constexpr int S = 8192, D = 2048, DEPTH = 4, DFF = 5632, DIN = 5696, MEMLEN = 256;
constexpr int NIN = 12032;
constexpr float LOG2E = 1.4426950408889634f;

#define GA1 __attribute__((address_space(1)))
#define LA3 __attribute__((address_space(3)))
typedef float rss_t;
constexpr int RSS_LDS_OFF = 131072 + 1024;
__device__ __forceinline__ float rss_rstd(const rss_t* p  , float inv_n) {
    const f32x4 a = *(const GA1 f32x4*)p, b = *(const GA1 f32x4*)(p + 4);
    return rsqrtf((((a[0] + a[1]) + (a[2] + a[3])) + ((b[0] + b[1]) + (b[2] + b[3]))) * inv_n + 1e-6f);
}
typedef float f32x2e __attribute__((ext_vector_type(2)));
__device__ __forceinline__ float rss_rstd2(const rss_t* p  , float inv_n) { const f32x2e a = *(const GA1 f32x2e*)p; return rsqrtf((a[0] + a[1]) * inv_n + 1e-6f); }
__device__ __forceinline__ void rss_reduce_store(const float (&ssv)[2][4], int wr, int wc, int fr, int fq, LA3 unsigned char* ldsbase, rss_t* out, int stride) {
    LA3 float* P = (LA3 float*)(ldsbase + RSS_LDS_OFF);
    if (fq == 0) {
#pragma unroll
        for (int ai = 0; ai < 2; ++ai)
#pragma unroll
            for (int m = 0; m < 4; ++m) P[(ai * 128 + wr * 64 + m * 16 + fr) * 4 + wc] = ssv[ai][m]; }
    asm volatile("s_waitcnt lgkmcnt(0)" ::: "memory"); __builtin_amdgcn_s_barrier(); asm volatile("" ::: "memory");
    const int t = (wr * 4 + wc) * 64 + fq * 16 + fr;
    if (t < 256) { const LA3 f32x4* pr = (const LA3 f32x4*)(P + t * 4); const f32x4 v = *pr; ((GA1 rss_t*)out)[(size_t)t * stride] = (v[0] + v[1]) + (v[2] + v[3]); }
}
__device__ __forceinline__ void rstd_cached(const rss_t* rss  , int pm, int tag, LA3 unsigned char* ldsb, int wr, int wc, int fr, int fq, float (&rsv)[2][4]) {
    LA3 float* T = (LA3 float*)(ldsb + RSS_LDS_OFF + 4096); volatile LA3 int* TAG = (volatile LA3 int*)(ldsb + RSS_LDS_OFF + 4096 + 1024);
    const int t = (wr * 4 + wc) * 64 + fq * 16 + fr;
    if (__builtin_amdgcn_readfirstlane(*TAG) != tag) {
        if (t < 256) T[t] = rss_rstd(rss + (size_t)(pm * 256 + t) * 8, 1.f / D);
        asm volatile("s_waitcnt lgkmcnt(0)" ::: "memory"); __builtin_amdgcn_s_barrier(); asm volatile("" ::: "memory");
        if (t == 0) *TAG = tag;
    }
#pragma unroll
    for (int ai = 0; ai < 2; ++ai)
#pragma unroll
        for (int m = 0; m < 4; ++m) rsv[ai][m] = T[ai * 128 + wr * 64 + m * 16 + fr];
}
__device__ __forceinline__ float fast_sigmoid(float x) { return __builtin_amdgcn_rcpf(1.f + __builtin_amdgcn_exp2f(-x * LOG2E)); }


struct EpiSwiglu {
    static constexpr bool PERM = true, CHAIN = false;
    bf16_t* HID; const rss_t* rss; LA3 unsigned char* ldsb; int tag0;
    __device__ __forceinline__ void operator()(f32x4 (&acc)[2][2][4][2], const Unit& u, int wr, int wc, int fr, int fq) const {
        const int row0 = u.pm * 256 + wr * 64 + fr, col = u.pn * 128 + wc * 32 + 8 * fq;
        float rsv[2][4]; rstd_cached(rss, u.pm, tag0 + u.pm, ldsb, wr, wc, fr, fq, rsv);
#pragma unroll
        for (int ai = 0; ai < 2; ++ai)
#pragma unroll
            for (int m = 0; m < 4; ++m) {
                const float rs = rsv[ai][m];
                f32x4 h0, h1;
#pragma unroll
                for (int j = 0; j < 4; ++j) { const float g0 = acc[ai][0][m][0][j] * rs, g1 = acc[ai][0][m][1][j] * rs;
                    h0[j] = g0 * fast_sigmoid(g0) * (acc[ai][1][m][0][j] * rs); h1[j] = g1 * fast_sigmoid(g1) * (acc[ai][1][m][1][j] * rs); }
                *(GA1 u32x4*)(HID + (size_t)(row0 + ai * 128 + m * 16) * DFF + col) = pack8(h0, h1);
            }
    }
};
typedef _Float16 h16x8 __attribute__((ext_vector_type(8)));
typedef float f32x8e __attribute__((ext_vector_type(8)));
struct EpiResid {
    static constexpr bool PERM = true, CHAIN = false;
    _Float16* h16; bf16_t* an; float alpha; bool stats; rss_t* rss; LA3 unsigned char* ldsb;
    __device__ __forceinline__ void operator()(f32x4 (&acc)[2][2][4][2], const Unit& u, int wr, int wc, int fr, int fq) const {
        const int row0 = u.pm * 256 + wr * 64 + fr, col0 = u.pn * 256 + wc * 32 + 8 * fq;
        float ssv[2][4];
#pragma unroll
        for (int ai = 0; ai < 2; ++ai) {
            h16x8 hb[4][2];
#pragma unroll
            for (int m = 0; m < 4; ++m)
#pragma unroll
                for (int bj = 0; bj < 2; ++bj) hb[m][bj] = *(const GA1 h16x8*)(h16 + (size_t)(row0 + ai * 128 + m * 16) * D + col0 + bj * 128);
#pragma unroll
            for (int m = 0; m < 4; ++m) { const int row = row0 + ai * 128 + m * 16; float ss = 0.f;
#pragma unroll
                for (int bj = 0; bj < 2; ++bj) { const f32x8e hf = __builtin_convertvector(hb[m][bj], f32x8e);
                    f32x4 h0 = {hf[0], hf[1], hf[2], hf[3]}, h1 = {hf[4], hf[5], hf[6], hf[7]};
                    h0 = h0 + acc[ai][bj][m][0] * alpha; h1 = h1 + acc[ai][bj][m][1] * alpha;
                    ss += (h0[0] * h0[0] + h0[1] * h0[1]) + (h0[2] * h0[2] + h0[3] * h0[3]) + (h1[0] * h1[0] + h1[1] * h1[1]) + (h1[2] * h1[2] + h1[3] * h1[3]);
                    const f32x8e hn = {h0[0], h0[1], h0[2], h0[3], h1[0], h1[1], h1[2], h1[3]};
                    *(GA1 h16x8*)(h16 + (size_t)row * D + col0 + bj * 128) = __builtin_convertvector(hn, h16x8);
                    *(GA1 u32x4*)(an + (size_t)row * D + col0 + bj * 128) = pack8(h0, h1); }
                ss += __shfl_xor(ss, 16); ss += __shfl_xor(ss, 32); ssv[ai][m] = ss; }
        }
        if (stats) rss_reduce_store(ssv, wr, wc, fr, fq, ldsb, rss + (size_t)u.pm * 256 * 8 + u.pn, 8);
    }
};
struct EpiPlain {
    static constexpr bool PERM = true, CHAIN = false;
    bf16_t* O; int ldc; int npp; const rss_t* rss; LA3 unsigned char* ldsb; int tag0;
    __device__ __forceinline__ void operator()(f32x4 (&acc)[2][2][4][2], const Unit& u, int wr, int wc, int fr, int fq) const {
        const int row0 = u.pm * 256 + wr * 64 + fr, col0 = (u.pn - u.pm * npp) * 256 + wc * 32 + 8 * fq;
        float rsv[2][4];
        if (rss) rstd_cached(rss, u.pm, tag0 + u.pm, ldsb, wr, wc, fr, fq, rsv);
        else {
#pragma unroll
            for (int ai = 0; ai < 2; ++ai)
#pragma unroll
                for (int m = 0; m < 4; ++m) rsv[ai][m] = 1.f; }
#pragma unroll
        for (int ai = 0; ai < 2; ++ai)
#pragma unroll
            for (int m = 0; m < 4; ++m) { const int row = row0 + ai * 128 + m * 16; bf16_t* rp = O + (size_t)row * ldc + col0;
                const float rs = rsv[ai][m];
#pragma unroll
                for (int bj = 0; bj < 2; ++bj) *(GA1 u32x4*)(rp + bj * 128) = pack8(acc[ai][bj][m][0] * rs, acc[ai][bj][m][1] * rs); }
    }
};
__device__ __forceinline__ void rope8_apply(f32x4& v0, f32x4& v1, const f32x4 t0, const f32x4 t1) {
    const f32x4 c = {t0[0], t0[2], t1[0], t1[2]}, s = {t0[1], t0[3], t1[1], t1[3]};
    const f32x4 y1 = v0 * c - v1 * s, y2 = v1 * c + v0 * s; v0 = y1; v1 = y2;
}
__device__ __forceinline__ void rope8(f32x4& v0, f32x4& v1, const float2* cs) { rope8_apply(v0, v1, *(const GA1 f32x4*)cs, *(const GA1 f32x4*)(cs + 2)); }
struct EpiIn {
    static constexpr bool PERM = true, CHAIN = false;
    bf16_t *QD, *KD, *VD, *CQR, *CKVR, *QG, *KG, *VG, *KM, *GATE; const float2 *cs64, *cs128; const float* bg; const rss_t* rss; rss_t* rssm; LA3 unsigned char* ldsb; int tag0;
    __device__ __forceinline__ void operator()(f32x4 (&acc)[2][2][4][2], const Unit& u, int wr, int wc, int fr, int fq) const {
        const int pn = u.pn, row0 = u.pm * 256 + wr * 64 + fr, c8 = wc * 32 + 8 * fq;
        int kind, ld, colt; bf16_t* base;
        if (pn < 4)        { kind = 1; base = QD;   ld = 1024; colt = 256 * pn; }
        else if (pn < 8)   { kind = 1; base = KD;   ld = 1024; colt = 256 * (pn - 4); }
        else if (pn < 12)  { kind = 0; base = VD;   ld = 1024; colt = 256 * (pn - 8); }
        else if (pn < 14)  { kind = 0; base = CQR;  ld = 512;  colt = 256 * (pn - 12); }
        else if (pn < 16)  { kind = 0; base = CKVR; ld = 512;  colt = 256 * (pn - 14); }
        else if (pn < 20)  { kind = 2; base = QG;   ld = 1024; colt = 256 * (pn - 16); }
        else if (pn == 20) { kind = 2; base = KG;   ld = 256;  colt = 0; }
        else if (pn == 21) { kind = 0; base = VG;   ld = 256;  colt = 0; }
        else if (pn == 22) { kind = 4; base = KM;   ld = 1536; colt = 0; }
        else               { kind = 3; base = GATE; ld = 6144; colt = 256 * (pn - 23); }
        float rsv[2][4]; rstd_cached(rss, u.pm, tag0 + u.pm, ldsb, wr, wc, fr, fq, rsv);
        if (pn >= 12 && pn < 16) {
            float ssv[2][4];
#pragma unroll
            for (int ai = 0; ai < 2; ++ai)
#pragma unroll
                for (int m = 0; m < 4; ++m) { const int row = row0 + ai * 128 + m * 16; const float rs = rsv[ai][m]; float ss = 0.f;
#pragma unroll
                    for (int bj = 0; bj < 2; ++bj) { const f32x4 v0 = acc[ai][bj][m][0] * rs, v1 = acc[ai][bj][m][1] * rs;
                        ss += (v0[0] * v0[0] + v0[1] * v0[1]) + (v0[2] * v0[2] + v0[3] * v0[3]) + (v1[0] * v1[0] + v1[1] * v1[1]) + (v1[2] * v1[2] + v1[3] * v1[3]);
                        *(GA1 u32x4*)(base + (size_t)row * ld + colt + bj * 128 + c8) = pack8(v0, v1); }
                    ss += __shfl_xor(ss, 16); ss += __shfl_xor(ss, 32); ssv[ai][m] = ss; }
            if (rssm) rss_reduce_store(ssv, wr, wc, fr, fq, ldsb, rssm + ((size_t)(pn >= 14 ? S : 0) + (size_t)u.pm * 256) * 2 + (pn & 1), 2);
            return;
        }
        if (kind == 1 || kind == 2) {
            const float2* cs = (kind == 1 ? cs64 + (size_t)row0 * 32 : cs128 + (size_t)row0 * 64) + (((colt + c8) & (kind == 1 ? 63 : 127)) >> 3) * 4;
            const int rstr = kind == 1 ? 32 : 64;
#pragma unroll
            for (int ai = 0; ai < 2; ++ai) {
                f32x4 tb[4][2];
#pragma unroll
                for (int m = 0; m < 4; ++m) { const float2* p = cs + (size_t)(ai * 128 + m * 16) * rstr; tb[m][0] = *(const GA1 f32x4*)p; tb[m][1] = *(const GA1 f32x4*)(p + 2); }
#pragma unroll
                for (int m = 0; m < 4; ++m) { const int row = row0 + ai * 128 + m * 16; const float rs = rsv[ai][m];
#pragma unroll
                    for (int bj = 0; bj < 2; ++bj) { f32x4 v0 = acc[ai][bj][m][0] * rs, v1 = acc[ai][bj][m][1] * rs; rope8_apply(v0, v1, tb[m][0], tb[m][1]);
                        *(GA1 u32x4*)(base + (size_t)row * ld + colt + bj * 128 + c8) = pack8(v0, v1); } }
            }
        } else if (kind == 0) {
#pragma unroll
            for (int ai = 0; ai < 2; ++ai)
#pragma unroll
                for (int m = 0; m < 4; ++m) { const int row = row0 + ai * 128 + m * 16; const float rs = rsv[ai][m];
#pragma unroll
                    for (int bj = 0; bj < 2; ++bj) *(GA1 u32x4*)(base + (size_t)row * ld + colt + bj * 128 + c8) = pack8(acc[ai][bj][m][0] * rs, acc[ai][bj][m][1] * rs); }
        } else if (kind == 4) {
            if (wc < 2) {
                const float2* cs = cs64 + (size_t)row0 * 32 + (c8 >> 3) * 4;
#pragma unroll
                for (int ai = 0; ai < 2; ++ai) {
                    f32x4 tb[4][2];
#pragma unroll
                    for (int m = 0; m < 4; ++m) { const float2* p = cs + (size_t)(ai * 128 + m * 16) * 32; tb[m][0] = *(const GA1 f32x4*)p; tb[m][1] = *(const GA1 f32x4*)(p + 2); }
#pragma unroll
                    for (int m = 0; m < 4; ++m) { const int row = row0 + ai * 128 + m * 16; const float rs = rsv[ai][m];
                        f32x4 v0 = acc[ai][0][m][0] * rs, v1 = acc[ai][0][m][1] * rs; rope8_apply(v0, v1, tb[m][0], tb[m][1]); const u32x4 w = pack8(v0, v1);
#pragma unroll
                        for (int h = 0; h < 8; ++h) *(GA1 u32x4*)(KM + (size_t)row * 1536 + h * 192 + 128 + c8) = w; }
                }
            }
        } else {
            f32x4 bv[2][2];
#pragma unroll
            for (int bj = 0; bj < 2; ++bj) { bv[bj][0] = *(const GA1 f32x4*)(bg + colt + bj * 128 + c8); bv[bj][1] = *(const GA1 f32x4*)(bg + colt + bj * 128 + c8 + 4); }
#pragma unroll
            for (int ai = 0; ai < 2; ++ai)
#pragma unroll
                for (int m = 0; m < 4; ++m) { const int row = row0 + ai * 128 + m * 16; const float rs = rsv[ai][m];
#pragma unroll
                    for (int bj = 0; bj < 2; ++bj) { f32x4 v0 = acc[ai][bj][m][0] * rs + bv[bj][0], v1 = acc[ai][bj][m][1] * rs + bv[bj][1];
#pragma unroll
                        for (int j = 0; j < 4; ++j) { v0[j] = fmaxf(fast_sigmoid(v0[j]), 1e-20f); v1[j] = fmaxf(fast_sigmoid(v1[j]), 1e-20f); }
                        *(GA1 u32x4*)(base + (size_t)row * ld + colt + bj * 128 + c8) = pack8(v0, v1); } }
        }
    }
};
struct EpiGate {
    static constexpr bool PERM = true, CHAIN = false;
    bf16_t* GATE; const float* bg; const rss_t* rss; LA3 unsigned char* ldsb; int tag0;
    __device__ __forceinline__ void operator()(f32x4 (&acc)[2][2][4][2], const Unit& u, int wr, int wc, int fr, int fq) const {
        const int row0 = u.pm * 256 + wr * 64 + fr, col0 = u.pn * 256 + wc * 32 + 8 * fq;
        float rsv[2][4]; rstd_cached(rss, u.pm, tag0 + u.pm, ldsb, wr, wc, fr, fq, rsv);
        f32x4 bv[2][2];
#pragma unroll
        for (int bj = 0; bj < 2; ++bj) { bv[bj][0] = *(const GA1 f32x4*)(bg + col0 + bj * 128); bv[bj][1] = *(const GA1 f32x4*)(bg + col0 + bj * 128 + 4); }
#pragma unroll
        for (int ai = 0; ai < 2; ++ai)
#pragma unroll
            for (int m = 0; m < 4; ++m) { const int row = row0 + ai * 128 + m * 16; const float rs = rsv[ai][m];
#pragma unroll
                for (int bj = 0; bj < 2; ++bj) { f32x4 v0 = acc[ai][bj][m][0] * rs + bv[bj][0], v1 = acc[ai][bj][m][1] * rs + bv[bj][1];
#pragma unroll
                    for (int j = 0; j < 4; ++j) { v0[j] = fmaxf(fast_sigmoid(v0[j]), 1e-20f); v1[j] = fmaxf(fast_sigmoid(v1[j]), 1e-20f); }
                    *(GA1 u32x4*)(GATE + (size_t)row * 6144 + col0 + bj * 128) = pack8(v0, v1); } }
    }
};
struct EpiMlaUp {
    static constexpr bool PERM = true, CHAIN = false;
    bf16_t *QM, *KM, *VM; const float2* cs64; const rss_t* rssm;
    __device__ __forceinline__ void operator()(f32x4 (&acc)[2][2][4][2], const Unit& u, int wr, int wc, int fr, int fq) const {
        const int c8 = wc * 32 + 8 * fq;
        if (u.pm < 32) {
            const int row0 = u.pm * 256 + wr * 64 + fr;
            float rsv[2][4]; f32x2e pr[2][4];
#pragma unroll
            for (int ai = 0; ai < 2; ++ai)
#pragma unroll
                for (int m = 0; m < 4; ++m) pr[ai][m] = *(const GA1 f32x2e*)(rssm + (size_t)(row0 + ai * 128 + m * 16) * 2);
#pragma unroll
            for (int ai = 0; ai < 2; ++ai)
#pragma unroll
                for (int m = 0; m < 4; ++m) rsv[ai][m] = rsqrtf((pr[ai][m][0] + pr[ai][m][1]) * (1.f / 512.f) + 1e-6f);
#pragma unroll
            for (int bj = 0; bj < 2; ++bj) { const int col = u.pn * 256 + bj * 128 + c8, p = col % 192; const bool rp = p >= 128; const int a = rp ? ((p - 128) >> 3) : 0;
#pragma unroll
                for (int ai = 0; ai < 2; ++ai) {
                    f32x4 tb[4][2];
#pragma unroll
                    for (int m = 0; m < 4; ++m) { const float2* cs = cs64 + (size_t)(row0 + ai * 128 + m * 16) * 32 + a * 4; tb[m][0] = *(const GA1 f32x4*)cs; tb[m][1] = *(const GA1 f32x4*)(cs + 2); }
#pragma unroll
                    for (int m = 0; m < 4; ++m) { const int row = row0 + ai * 128 + m * 16; const float rs = rsv[ai][m]; f32x4 v0 = acc[ai][bj][m][0] * rs, v1 = acc[ai][bj][m][1] * rs;
                        if (rp) rope8_apply(v0, v1, tb[m][0], tb[m][1]);
                        *(GA1 u32x4*)(QM + (size_t)row * 1536 + col) = pack8(v0, v1); } } }
        } else {
            const int row0 = (u.pm - 32) * 256 + wr * 64 + fr, h = u.pn - 6;
            float rsv[2][4]; f32x2e pr[2][4];
#pragma unroll
            for (int ai = 0; ai < 2; ++ai)
#pragma unroll
                for (int m = 0; m < 4; ++m) pr[ai][m] = *(const GA1 f32x2e*)(rssm + (size_t)(S + row0 + ai * 128 + m * 16) * 2);
#pragma unroll
            for (int ai = 0; ai < 2; ++ai)
#pragma unroll
                for (int m = 0; m < 4; ++m) rsv[ai][m] = rsqrtf((pr[ai][m][0] + pr[ai][m][1]) * (1.f / 512.f) + 1e-6f);
#pragma unroll
            for (int ai = 0; ai < 2; ++ai)
#pragma unroll
                for (int m = 0; m < 4; ++m) { const int row = row0 + ai * 128 + m * 16; const float rs = rsv[ai][m];
                    *(GA1 u32x4*)(KM + (size_t)row * 1536 + h * 192 + c8) = pack8(acc[ai][0][m][0] * rs, acc[ai][0][m][1] * rs);
                    *(GA1 u32x4*)(VM + (size_t)row * 1024 + h * 128 + c8) = pack8(acc[ai][1][m][0] * rs, acc[ai][1][m][1] * rs); }
        }
    }
};
struct EpiBranch {
    static constexpr bool PERM = true, CHAIN = true;
    const bf16_t* GATE; bf16_t* MG;
    __device__ __forceinline__ bool keep(const Unit& u) const { return (u.pm >> 5) < 2; }
    __device__ __forceinline__ void operator()(f32x4 (&acc)[2][2][4][2], const Unit& u, int wr, int wc, int fr, int fq) const {
        const int n = u.pm >> 5, row0 = (u.pm & 31) * 256 + wr * 64 + fr, col0 = (u.pn - 8 * n) * 256 + wc * 32 + 8 * fq;
        const GA1 u32x4* gp = (const GA1 u32x4*)(GATE + (size_t)row0 * 6144 + n * 2048 + col0);
        if (n < 2) {
#pragma unroll
            for (int ai = 0; ai < 2; ++ai) {
                u32x4 a[4][2], b[4][2];
#pragma unroll
                for (int m = 0; m < 4; ++m)
#pragma unroll
                    for (int bj = 0; bj < 2; ++bj) { const GA1 u32x4* p = gp + (size_t)(ai * 128 + m * 16) * 768 + bj * 16; a[m][bj] = p[0]; b[m][bj] = p[256]; }
#pragma unroll
                for (int m = 0; m < 4; ++m)
#pragma unroll
                    for (int bj = 0; bj < 2; ++bj) { f32x4 g0, g1, h0, h1; unpack8(a[m][bj], g0, g1); unpack8(b[m][bj], h0, h1);
#pragma unroll
                        for (int j = 0; j < 4; ++j) { acc[ai][bj][m][0][j] *= g0[j] * __builtin_amdgcn_rcpf(h0[j]); acc[ai][bj][m][1][j] *= g1[j] * __builtin_amdgcn_rcpf(h1[j]); } }
            }
        } else {
            GA1 u32x4* op = (GA1 u32x4*)(MG + (size_t)row0 * D + col0);
#pragma unroll
            for (int ai = 0; ai < 2; ++ai) {
                u32x4 a[4][2];
#pragma unroll
                for (int m = 0; m < 4; ++m)
#pragma unroll
                    for (int bj = 0; bj < 2; ++bj) a[m][bj] = gp[(size_t)(ai * 128 + m * 16) * 768 + bj * 16];
#pragma unroll
                for (int m = 0; m < 4; ++m)
#pragma unroll
                    for (int bj = 0; bj < 2; ++bj) { f32x4 g0, g1; unpack8(a[m][bj], g0, g1); op[(size_t)(ai * 128 + m * 16) * 256 + bj * 16] = pack8(acc[ai][bj][m][0] * g0, acc[ai][bj][m][1] * g1); }
            }
        }
    }
};

struct MlaOrder {
    int G, c;
    __device__ bool next(int i, Unit& u) const { const int L = i * G + c; if (L < 192) { u.pm = L & 31; u.pn = L >> 5; return true; } if (L < 448) { const int l2 = L - 192; u.pm = 32 + (l2 & 31); u.pn = 6 + (l2 >> 5); return true; } return false; }
    __device__ __forceinline__ void a_ready(const Unit&) const {}
    __device__ __forceinline__ void done(const Unit&) const {}
};
struct BranchOrder {
    pg8::StaticOrder so;
    __device__ bool next(int i, Unit& u) const { const int t = i / 3, n = i - 3 * t; if (!so.map(t * so.G + so.c, u)) return false; u.pm += 32 * n; u.pn += 8 * n; return true; }
    __device__ __forceinline__ void a_ready(const Unit&) const {}
    __device__ __forceinline__ void done(const Unit&) const {}
};
struct KvxOrder {
    int G, c;
    __device__ bool next(int i, Unit& u) const { const int L = i * G + c; if (L >= 16) return false; u.pm = L >> 2; u.pn = L; return true; }
    __device__ __forceinline__ void a_ready(const Unit&) const {}
    __device__ __forceinline__ void done(const Unit&) const {}
};
}
namespace at {
typedef unsigned short bf16;
using bf16x8 = __attribute__((ext_vector_type(8))) short;
using s16x4  = __attribute__((ext_vector_type(4))) short;
using f32x16 = __attribute__((ext_vector_type(16))) float;
using u32x4  = __attribute__((ext_vector_type(4))) unsigned;
typedef const __attribute__((address_space(1))) bf16x8* gp8;
constexpr int KVBLK = 64, SHM_V = KVBLK * 128 * 2;
constexpr float THR = 8.f;
#define AT_SBAR() __builtin_amdgcn_sched_barrier(0)
#ifndef AT_GRP
#define AT_GRP 0
#endif
#ifndef AT_PRIO
#define AT_PRIO 0
#endif
#ifndef AT_QPIPE
#define AT_QPIPE 0
#endif
#ifndef AT_VPIPE
#define AT_VPIPE 1
#endif
__device__ __forceinline__ int crow(int r, int hi) { return (r & 3) + 8 * (r >> 2) + 4 * hi; }
__device__ __forceinline__ unsigned cvtpk(float lo, float hi) { unsigned r; asm volatile("v_cvt_pk_bf16_f32 %0, %1, %2" : "=v"(r) : "v"(lo), "v"(hi)); return r; }

template <bool WIN>
__device__ __forceinline__ void partialSM(f32x16& p0, f32x16& p1, float& m_reg, float& mn, float& alpha, float C, float thr_raw, int krel, int hi) {
  if (WIN) {
#pragma unroll
    for (int r = 0; r < 16; ++r) { const int d0 = krel + crow(r, hi), d1 = d0 + 32;
      if (d0 > 128 || d0 < -128) p0[r] = -1e30f; if (d1 > 128 || d1 < -128) p1[r] = -1e30f; }
  }
  float pmax = p0[0];
#pragma unroll
  for (int r = 1; r < 16; ++r) pmax = fmaxf(pmax, p0[r]);
#pragma unroll
  for (int r = 0; r < 16; ++r) pmax = fmaxf(pmax, p1[r]);
  { auto rr = __builtin_amdgcn_permlane32_swap(__float_as_uint(pmax), __float_as_uint(pmax), false, false);
    pmax = fmaxf(__uint_as_float(rr[0]), __uint_as_float(rr[1])); }
  if (__builtin_expect(__all(pmax - m_reg <= thr_raw), 1)) { mn = m_reg; alpha = 1.f; }
  else { mn = fmaxf(m_reg, pmax); alpha = __builtin_amdgcn_exp2f((m_reg - mn) * C); m_reg = mn; }
  const float mnC = -mn * C;
#pragma unroll
  for (int r = 0; r < 16; ++r) p0[r] = fmaf(p0[r], C, mnC);
#pragma unroll
  for (int r = 0; r < 16; ++r) p1[r] = fmaf(p1[r], C, mnC);
#pragma unroll
  for (int r = 0; r < 16; ++r) p0[r] = __builtin_amdgcn_exp2f(p0[r]);
}
__device__ __forceinline__ void finishSM(f32x16& p0, f32x16& p1, float alpha, float& l_reg, bf16x8& pa0, bf16x8& pa1, bf16x8& pa2, bf16x8& pa3) {
#pragma unroll
  for (int r = 0; r < 16; ++r) p1[r] = __builtin_amdgcn_exp2f(p1[r]);
  float ps = 0;
#pragma unroll
  for (int r = 0; r < 16; ++r) ps += p0[r];
#pragma unroll
  for (int r = 0; r < 16; ++r) ps += p1[r];
  { auto rr = __builtin_amdgcn_permlane32_swap(__float_as_uint(ps), __float_as_uint(ps), false, false);
    ps = __uint_as_float(rr[0]) + __uint_as_float(rr[1]); }
  l_reg = l_reg * alpha + ps;
#define AT_PK4(P, BASE, OUT) do { unsigned a0 = cvtpk(P[BASE + 0], P[BASE + 1]), a1 = cvtpk(P[BASE + 2], P[BASE + 3]);   \
    unsigned b0 = cvtpk(P[BASE + 4], P[BASE + 5]), b1 = cvtpk(P[BASE + 6], P[BASE + 7]);                              \
    auto r0 = __builtin_amdgcn_permlane32_swap(a0, b0, false, false); auto r1 = __builtin_amdgcn_permlane32_swap(a1, b1, false, false); \
    u32x4 w = {r0[0], r1[0], r0[1], r1[1]}; OUT = *reinterpret_cast<bf16x8*>(&w); } while (0)
  AT_PK4(p0, 0, pa0); AT_PK4(p0, 8, pa1); AT_PK4(p1, 0, pa2); AT_PK4(p1, 8, pa3);
#undef AT_PK4
}
template <int DQK> __device__ __forceinline__ int kswz_x(int row) { return DQK == 128 ? (row & 15) : ((row >> 1) & 7); }
template <int DQK> __device__ __forceinline__ int kswz(int row, int colB) { return row * (DQK * 2) + (colB ^ (kswz_x<DQK>(row) << 4)); }
template <int DQK, int QL, int GRP>
__device__ __forceinline__ void qkt(f32x16& p0, f32x16& p1, int ks  , const int (&kb)[8], const bf16x8* qr, int qa, int r32, int hi) {
  typedef const __attribute__((address_space(3))) bf16x8* lp;
  p0 = f32x16{}; p1 = f32x16{};
  if (QL > 0) asm volatile("" : "+v"(qa));
#if AT_QPIPE
  const int ka0 = DQK == 128 ? kb[0] : kb[0];
  bf16x8 b0 = *(lp)(uintptr_t)(unsigned)(ks + ka0), b1 = *(lp)(uintptr_t)(unsigned)(ks + ka0 + 32 * DQK * 2);
#pragma unroll
  for (int d0 = 0; d0 < DQK / 16; ++d0) {
    bf16x8 n0 = b0, n1 = b1;
    if (d0 + 1 < DQK / 16) { const int g = (d0 + 1) >> 2, e = (d0 + 1) & 3; const int ka = DQK == 128 ? kb[e + 4 * g] : kb[e] + g * 128;
      n0 = *(lp)(uintptr_t)(unsigned)(ks + ka); n1 = *(lp)(uintptr_t)(unsigned)(ks + ka + 32 * DQK * 2); }
    bf16x8 q;
    if (d0 < DQK / 16 - QL) q = qr[d0]; else q = *(lp)(uintptr_t)(unsigned)(qa + (d0 - (DQK / 16 - QL)) * 1024);
    AT_SBAR();
    if (AT_PRIO) __builtin_amdgcn_s_setprio(1);
    p0 = __builtin_amdgcn_mfma_f32_32x32x16_bf16(b0, q, p0, 0, 0, 0);
    p1 = __builtin_amdgcn_mfma_f32_32x32x16_bf16(b1, q, p1, 0, 0, 0);
    if (AT_PRIO) __builtin_amdgcn_s_setprio(0);
    AT_SBAR();
    b0 = n0; b1 = n1; }
#else
#pragma unroll
  for (int d0 = 0; d0 < DQK / 16; ++d0) { const int g = d0 >> 2, e = d0 & 3;
    const int ka = DQK == 128 ? kb[e + 4 * g] : kb[e] + g * 128;
    const bf16x8 b0 = *(lp)(uintptr_t)(unsigned)(ks + ka);
    const bf16x8 b1 = *(lp)(uintptr_t)(unsigned)(ks + ka + 32 * DQK * 2);
    bf16x8 q;
    if (d0 < DQK / 16 - QL) q = qr[d0]; else q = *(lp)(uintptr_t)(unsigned)(qa + (d0 - (DQK / 16 - QL)) * 1024);
    p0 = __builtin_amdgcn_mfma_f32_32x32x16_bf16(b0, q, p0, 0, 0, 0);
    p1 = __builtin_amdgcn_mfma_f32_32x32x16_bf16(b1, q, p1, 0, 0, 0);
    if (GRP > 0 && (d0 % (GRP > 0 ? GRP : 1)) == (GRP > 0 ? GRP : 1) - 1) AT_SBAR(); }
#endif
}
__device__ __forceinline__ int v_st(int k, int c) { const int kk = (k & ~0xC) | ((k & 4) << 1) | ((k & 8) >> 1); return ((kk >> 3) * 4 + (c >> 5)) * 512 + ((kk & 7) * 32 + (c & 31)) * 2; }
__device__ __forceinline__ int v_rd_base(int lane) { return ((lane & 3) << 3) | (((lane >> 2) & 3) << 6) | (((lane >> 4) & 1) << 5) | (((lane >> 5) & 1) << 8); }
constexpr int v_rd_off(int d0, int ks, int half) { return d0 * 512 + ks * 4096 + half * 2048; }
template <int OFF> __device__ __forceinline__ s16x4 tr_read(int vb) {
  s16x4 r; asm volatile("ds_read_b64_tr_b16 %0, %1 offset:%2" : "=&v"(r) : "v"(vb), "i"(OFF) : "memory"); return r;
}
struct VFrag { s16x4 l0, h0, l1, h1, l2, h2, l3, h3; };
template <int D0> __device__ __forceinline__ void pv_load(VFrag& f, int vb) {
  f.l0 = tr_read<v_rd_off(D0, 0, 0)>(vb); f.h0 = tr_read<v_rd_off(D0, 0, 1)>(vb); f.l1 = tr_read<v_rd_off(D0, 1, 0)>(vb); f.h1 = tr_read<v_rd_off(D0, 1, 1)>(vb);
  f.l2 = tr_read<v_rd_off(D0, 2, 0)>(vb); f.h2 = tr_read<v_rd_off(D0, 2, 1)>(vb); f.l3 = tr_read<v_rd_off(D0, 3, 0)>(vb); f.h3 = tr_read<v_rd_off(D0, 3, 1)>(vb);
}
#define AT_PK(L, H) (bf16x8){L[0], L[1], L[2], L[3], H[0], H[1], H[2], H[3]}
__device__ __forceinline__ void pv_mma(f32x16& od, const VFrag& f, bf16x8 pa0, bf16x8 pa1, bf16x8 pa2, bf16x8 pa3) {
  if (AT_PRIO) __builtin_amdgcn_s_setprio(1);
  od = __builtin_amdgcn_mfma_f32_32x32x16_bf16(pa0, AT_PK(f.l0, f.h0), od, 0, 0, 0);
  od = __builtin_amdgcn_mfma_f32_32x32x16_bf16(pa1, AT_PK(f.l1, f.h1), od, 0, 0, 0);
  od = __builtin_amdgcn_mfma_f32_32x32x16_bf16(pa2, AT_PK(f.l2, f.h2), od, 0, 0, 0);
  od = __builtin_amdgcn_mfma_f32_32x32x16_bf16(pa3, AT_PK(f.l3, f.h3), od, 0, 0, 0);
  if (AT_PRIO) __builtin_amdgcn_s_setprio(0);
}
template <int D0> __device__ __forceinline__ void pv_one(f32x16& od, int vb, bf16x8 pa0, bf16x8 pa1, bf16x8 pa2, bf16x8 pa3) {
  VFrag f; pv_load<D0>(f, vb);
  asm volatile("s_waitcnt lgkmcnt(0)" ::: "memory"); AT_SBAR();
  pv_mma(od, f, pa0, pa1, pa2, pa3);
}
__device__ __forceinline__ void pv_d0(f32x16* o, int vb, bf16x8 pa0, bf16x8 pa1, bf16x8 pa2, bf16x8 pa3) {
#if AT_VPIPE == 2
  VFrag fa, fb, fc;
  pv_load<0>(fa, vb); pv_load<1>(fb, vb); pv_load<2>(fc, vb);
  asm volatile("s_waitcnt lgkmcnt(15)" ::: "memory"); AT_SBAR();
  pv_mma(o[0], fa, pa0, pa1, pa2, pa3); AT_SBAR();
  pv_load<3>(fa, vb);
  asm volatile("s_waitcnt lgkmcnt(15)" ::: "memory"); asm volatile("s_waitcnt lgkmcnt(15)" ::: "memory"); AT_SBAR();
  pv_mma(o[1], fb, pa0, pa1, pa2, pa3); AT_SBAR();
  asm volatile("s_waitcnt lgkmcnt(8)" ::: "memory"); AT_SBAR();
  pv_mma(o[2], fc, pa0, pa1, pa2, pa3); AT_SBAR();
  asm volatile("s_waitcnt lgkmcnt(0)" ::: "memory"); AT_SBAR();
  pv_mma(o[3], fa, pa0, pa1, pa2, pa3);
#elif AT_VPIPE
  VFrag fa, fb;
  pv_load<0>(fa, vb); pv_load<1>(fb, vb);
  asm volatile("s_waitcnt lgkmcnt(8)" ::: "memory"); AT_SBAR();
  pv_mma(o[0], fa, pa0, pa1, pa2, pa3); AT_SBAR();
  pv_load<2>(fa, vb);
  asm volatile("s_waitcnt lgkmcnt(8)" ::: "memory"); AT_SBAR();
  pv_mma(o[1], fb, pa0, pa1, pa2, pa3); AT_SBAR();
  pv_load<3>(fb, vb);
  asm volatile("s_waitcnt lgkmcnt(8)" ::: "memory"); AT_SBAR();
  pv_mma(o[2], fa, pa0, pa1, pa2, pa3); AT_SBAR();
  asm volatile("s_waitcnt lgkmcnt(0)" ::: "memory"); AT_SBAR();
  pv_mma(o[3], fb, pa0, pa1, pa2, pa3);
#else
  pv_one<0>(o[0], vb, pa0, pa1, pa2, pa3); pv_one<1>(o[1], vb, pa0, pa1, pa2, pa3); pv_one<2>(o[2], vb, pa0, pa1, pa2, pa3); pv_one<3>(o[3], vb, pa0, pa1, pa2, pa3);
#endif
}
#undef AT_PK

template <int DQK, bool WIN>
__device__ __forceinline__ void attn_core1(const bf16* __restrict__ Qb, int ldq, const bf16* __restrict__ Kh, int ldk, const bf16* __restrict__ Vh, int ldv,
                                           int NT, float C, float thr_raw, float m_init, float l_init, int qrel0, char* lds, f32x16 (&o)[4], float (&rli)[16]) {
  constexpr int SHM_K = KVBLK * DQK * 2, CPR = DQK / 8, NKC = DQK / 64;
  int tid = threadIdx.x; asm volatile("" : "+v"(tid));
  const int wid = tid >> 6, lane = tid & 63, r32 = lane & 31, hi = lane >> 5;
  char* V_lds = lds; char* K_lds = lds + 2 * SHM_V;
  float* ws = (float*)(lds + 2 * SHM_V + 2 * SHM_K) + wid * 64; float* li_l = ws; float* al_l = ws + 32;
  float m_reg = m_init, l_reg = l_init; bf16x8 qr[DQK / 16];
#pragma unroll
  for (int d = 0; d < 4; ++d) o[d] = f32x16{};
  const bf16* Qw = Qb + (long)(wid * 32 + r32) * ldq + hi * 8;
#pragma unroll
  for (int d0 = 0; d0 < DQK / 16; ++d0) qr[d0] = *(gp8)(Qw + d0 * 16);
  const int qme = qrel0 + wid * 32 + r32;
  const int sr = tid >> 4, sc = (tid & 15) * 8, vst0 = v_st(sr, sc), vst1 = v_st(32 + sr, sc);
  const unsigned vgo0 = (unsigned)(sr * ldv + sc) * 2u, vgo1 = vgo0 + 64u * (unsigned)ldv;
  unsigned kgo[NKC]; int klo[NKC];
#pragma unroll
  for (int i = 0; i < NKC; ++i) { const int id = tid + 512 * i, row = id / CPR, ch = id % CPR; kgo[i] = (unsigned)(row * ldk + ch * 8) * 2u; klo[i] = kswz<DQK>(row, ch * 16); }
  const int vb0 = (int)(uintptr_t)V_lds + v_rd_base(lane);
  const int ksa = (int)(uintptr_t)K_lds; int kb[8];
#pragma unroll
  for (int e = 0; e < 8; ++e) kb[e] = (DQK == 128 || e < 4) ? kswz<DQK>(r32, ((((e & 3) << 1) | hi) + 8 * (e >> 2)) << 4) : 0;
  bf16x8 vs0, vs1, ks[NKC];
#define A1_LOAD(k0) do { const char* vb_ = (const char*)Vh + (size_t)(k0) * (size_t)ldv * 2; const char* kb_ = (const char*)Kh + (size_t)(k0) * (size_t)ldk * 2; \
    vs0 = *(gp8)(vb_ + vgo0); vs1 = *(gp8)(vb_ + vgo1); \
    _Pragma("unroll") for (int _c = 0; _c < NKC; ++_c) ks[_c] = *(gp8)(kb_ + kgo[_c]); } while (0)
#define A1_WRITE(b) do { *(bf16x8*)(V_lds + (b) * SHM_V + vst0) = vs0; *(bf16x8*)(V_lds + (b) * SHM_V + vst1) = vs1; \
    _Pragma("unroll") for (int _c = 0; _c < NKC; ++_c) *(bf16x8*)(K_lds + (b) * SHM_K + klo[_c]) = ks[_c]; } while (0)
  __syncthreads();
  A1_LOAD(0); A1_WRITE(0);
  if (NT > 1) A1_LOAD(KVBLK);
  __syncthreads();
  for (int j = 0; j < NT; ++j) {
    const int b = j & 1;
    f32x16 p0, p1; float mn, al; bf16x8 pa0, pa1, pa2, pa3;
    qkt<DQK, 0, AT_GRP>(p0, p1, ksa + b * SHM_K, kb, qr, 0, r32, hi);
    partialSM<WIN>(p0, p1, m_reg, mn, al, C, thr_raw, j * KVBLK - qme, hi);
    if (__any(al < 1.f)) { if (hi == 0) al_l[r32] = al; asm volatile("s_waitcnt lgkmcnt(0)" ::: "memory");
#pragma unroll
      for (int d = 0; d < 4; ++d)
#pragma unroll
        for (int r = 0; r < 16; ++r) o[d][r] *= al_l[crow(r, hi)]; }
    finishSM(p0, p1, al, l_reg, pa0, pa1, pa2, pa3);
    if (j + 1 < NT) { A1_WRITE(b ^ 1); if (j + 2 < NT) A1_LOAD((j + 2) * KVBLK); }
    AT_SBAR();
    pv_d0(o, vb0 + b * SHM_V, pa0, pa1, pa2, pa3);
    __syncthreads();
  }
  if (hi == 0) li_l[r32] = l_reg; asm volatile("s_waitcnt lgkmcnt(0)" ::: "memory");
#pragma unroll
  for (int r = 0; r < 16; ++r) rli[r] = __builtin_amdgcn_rcpf(li_l[crow(r, hi)]);
#undef A1_LOAD
#undef A1_WRITE
}
__device__ __forceinline__ void store_o(bf16* Ob, int ldo, const f32x16 (&o)[4], const float (&rli)[16]) {
  int tid = threadIdx.x; asm volatile("" : "+v"(tid));
  const int wid = tid >> 6, lane = tid & 63, r32 = lane & 31, hi = lane >> 5;
  bf16* Ow = Ob + (long)(wid * 32) * ldo + r32;
#pragma unroll
  for (int r = 0; r < 16; ++r) { const int orow = crow(r, hi);
#pragma unroll
    for (int d0 = 0; d0 < 4; ++d0) ((__attribute__((address_space(1))) bf16*)Ow)[(long)orow * ldo + d0 * 32] = (bf16)(cvtpk(o[d0][r] * rli[r], 0.f) & 0xffffu); }
}
}
namespace mk {
#define GAS __attribute__((address_space(1)))
#define LAS __attribute__((address_space(3)))
constexpr size_t MiB = 1u << 20;
constexpr size_t al256(size_t x) { return (x + 255) & ~(size_t)255; }
constexpr size_t WS_CTL = 0, CTL_ZERO_BYTES = 1 * MiB;
constexpr size_t WS_PART = WS_CTL + CTL_ZERO_BYTES;
constexpr size_t WS_PARTM = WS_PART + (size_t)20 * S * 8 * 4;
constexpr size_t WS_CS64 = WS_PARTM + (size_t)4 * 2 * S * 2 * 4;
constexpr size_t WS_CS128 = WS_CS64 + (size_t)S * 32 * 8;
constexpr size_t WS_H = WS_CS128 + (size_t)S * 64 * 8;
constexpr size_t WS_AN = WS_H + (size_t)S * D * 4;
constexpr size_t WS_HID = WS_AN + (size_t)S * D * 2;
constexpr size_t WS_QD = WS_HID + (size_t)S * DFF * 2;
constexpr size_t WS_KD = WS_QD + (size_t)S * 1024 * 2, WS_VD = WS_KD + (size_t)S * 1024 * 2;
constexpr size_t WS_CQR = WS_VD + (size_t)S * 1024 * 2, WS_CKVR = WS_CQR + (size_t)S * 512 * 2;
constexpr size_t WS_ACQ = WS_CKVR + (size_t)S * 512 * 2;
constexpr size_t WS_QG = WS_ACQ + (size_t)2 * S * 512 * 2, WS_KG = WS_QG + (size_t)S * 1024 * 2, WS_VG = WS_KG + (size_t)S * 256 * 2;
constexpr size_t WS_QM = WS_VG + (size_t)S * 256 * 2, WS_KM = WS_QM + (size_t)S * 1536 * 2, WS_VM = WS_KM + (size_t)S * 1536 * 2;
constexpr size_t WS_GATE = WS_VM + (size_t)S * 1024 * 2;
constexpr size_t WS_OB = WS_GATE + (size_t)S * 6144 * 2;
constexpr size_t WS_MG = WS_OB + (size_t)3 * S * 1024 * 2;
constexpr size_t WS_ATMP = WS_MG + (size_t)S * D * 2;
constexpr size_t WS_QX = WS_ATMP + (size_t)256 * 64 * 512 * 4, WS_OX = WS_QX + (size_t)S * 512 * 2;
constexpr size_t WS_MEMN = WS_OX + (size_t)S * 512 * 2;
constexpr size_t WS_KVX = WS_MEMN + (size_t)4 * 256 * D * 2;
constexpr size_t WS_WXKV = WS_KVX + (size_t)4 * 256 * 1024 * 2;
constexpr size_t WS_LW = WS_WXKV + (size_t)4 * 1024 * D * 2;
constexpr size_t LW_GU1 = 0, LW_DN1 = LW_GU1 + (size_t)2 * DFF * D, LW_IN = LW_DN1 + (size_t)D * DFF, LW_UQKV = LW_IN + (size_t)NIN * D, LW_BR = LW_UQKV + (size_t)(1536 + 2048) * 512,
                 LW_WO = LW_BR + (size_t)3 * D * 1024, LW_XQ = LW_WO + (size_t)D * D, LW_XO = LW_XQ + (size_t)512 * D, LW_GU2 = LW_XO + (size_t)D * 512, LW_DN2 = LW_GU2 + (size_t)2 * DFF * D,
                 LW_ELEMS = LW_DN2 + (size_t)D * DFF;
constexpr size_t WS_END = WS_LW + 4 * LW_ELEMS * 2;
constexpr int CW_BAR = 4096;
constexpr int RING_BYTES = 131072, MISC_OFF = RING_BYTES + 320, LDS_BYTES = 147456;
constexpr int NWAVES = 8;

typedef unsigned v4u __attribute__((ext_vector_type(4)));
#define LDS_WAIT() asm volatile("s_waitcnt lgkmcnt(0)" ::: "memory")
__device__ __forceinline__ unsigned f2bf(float f) { unsigned u = __builtin_bit_cast(unsigned, f); return (u + 0x7fffu + ((u >> 16) & 1u)) >> 16; }
__device__ __forceinline__ unsigned pk2(float lo, float hi) { return f2bf(lo) | (f2bf(hi) << 16); }
__device__ __forceinline__ float wave_sum(float v) {
#pragma unroll
    for (int o = 1; o < 64; o <<= 1) v += __shfl_xor(v, o);
    return v;
}

#define XB_TMO      128
#define XB_XCNT(j)  (256  + 64 * (j))
#define XB_XSUB(j)  (1280 + 64 * (j))
#define XB_XGEN(j)  (2304 + 64 * (j))
#define XB_TOP      3328
#define XB_TOPGEN   3392
#define XCD_BAR_WORDS 3456
#define XB_SPIN_CAP (1u << 18)
__device__ __forceinline__ unsigned xb_ld(unsigned* p)              { return __hip_atomic_load(p, __ATOMIC_RELAXED, __HIP_MEMORY_SCOPE_AGENT); }
__device__ __forceinline__ unsigned xb_add(unsigned* p, unsigned v) { return __hip_atomic_fetch_add(p, v, __ATOMIC_RELAXED, __HIP_MEMORY_SCOPE_AGENT); }
__device__ __forceinline__ unsigned xb_xcc_id() { return (unsigned)__builtin_amdgcn_s_getreg((3 << 11) | 20) & 0xFu; }
#define XB_SPIN(cond, bar) do { unsigned _sp = 0; while (cond) { __builtin_amdgcn_s_sleep(1); \
    if ((++_sp & 255u) == 0u) { if (xb_ld(&(bar)[XB_TMO])) break; if (_sp > XB_SPIN_CAP) { atomicAdd(&(bar)[XB_TMO], 1u); break; } } } } while (0)
struct XcdBarrier { unsigned* bar; unsigned x; volatile LAS unsigned* st; };
__device__ __forceinline__ XcdBarrier xcd_barrier_post(unsigned* bar, volatile LAS unsigned* st) {
    XcdBarrier b; b.bar = bar; b.x = xb_xcc_id(); b.st = st;
    if (threadIdx.x == 0) (void)xb_add(&bar[XB_XCNT(b.x)], 1u);
    return b;
}
__device__ __forceinline__ void xcd_barrier_complete(unsigned* bar, unsigned x, unsigned& nloc, unsigned& nx) {
    const unsigned G = gridDim.x * gridDim.y * gridDim.z;
    unsigned sum, cnt, mine, sp = 0u;
    for (;;) {
        sum = 0u; cnt = 0u; mine = 0u;
#pragma unroll
        for (unsigned j = 0; j < 16; ++j) { const unsigned c = xb_ld(&bar[XB_XCNT(j)]); sum += c; cnt += (c > 0u) ? 1u : 0u; mine = (j == x) ? c : mine; }
        if (sum == G) break;
        __builtin_amdgcn_s_sleep(1);
        if ((++sp & 255u) == 0u) { if (xb_ld(&bar[XB_TMO])) break; if (sp > XB_SPIN_CAP) { atomicAdd(&bar[XB_TMO], 1u); break; } }
    }
    nloc = mine > 0u ? mine : 1u; nx = cnt > 0u ? cnt : 1u;
}
__device__ __forceinline__ void xcd_barrier(const XcdBarrier& b) {
    asm volatile("s_waitcnt vmcnt(0)" ::: "memory");
    __syncthreads();
    if (threadIdx.x == 0) {
        unsigned* bar = b.bar; asm volatile("" : "+s"(bar));
        __builtin_amdgcn_s_waitcnt(0);
        unsigned nloc = b.st[0], nx = b.st[1];
        if (nloc == 0u) { xcd_barrier_complete(bar, b.x, nloc, nx); b.st[0] = nloc; b.st[1] = nx; }
        const unsigned old = xb_add(&bar[XB_XSUB(b.x)], 1u);
        const unsigned gen = old / nloc;
        if (old + 1u == (gen + 1u) * nloc) {
            __builtin_amdgcn_fence(__ATOMIC_RELEASE, "agent");
            asm volatile("s_waitcnt vmcnt(0)" ::: "memory");
            const unsigned og = xb_add(&bar[XB_TOP], 1u);
            const unsigned tg = og / nx;
            if (og + 1u == (tg + 1u) * nx) xb_add(&bar[XB_TOPGEN], 1u);
            else XB_SPIN(xb_ld(&bar[XB_TOPGEN]) == tg, bar);
            __builtin_amdgcn_fence(__ATOMIC_ACQUIRE, "agent");
            xb_add(&bar[XB_XGEN(b.x)], 1u);
            asm volatile("s_waitcnt vmcnt(0)" ::: "memory");
        } else {
            XB_SPIN(xb_ld(&bar[XB_XGEN(b.x)]) == gen, bar);
            __builtin_amdgcn_fence(__ATOMIC_ACQUIRE, "agent");
            asm volatile("s_waitcnt vmcnt(0)" ::: "memory");
        }
    }
    __syncthreads();
}

struct Args { const void* in[28]; float* out; unsigned char* ws; int ph_lo, ph_hi; };

__device__ __forceinline__ int perm64(int p) { const int a = p >> 3, j = p & 7; return j < 4 ? 4 * a + j : 32 + 4 * a + (j - 4); }
__device__ __forceinline__ int perm128(int p) { const int a = p >> 3, j = p & 7; return j < 4 ? 4 * a + j : 64 + 4 * a + (j - 4); }
__device__ __forceinline__ int srccol(int kind, int n) {
    if (kind == 0) return n;
    if (kind == 1) { const int pn = n >> 8, j = n & 255; return j < 128 ? pn * 128 + j : DFF + pn * 128 + (j - 128); }
    if (kind == 2) {
        if (n < 2048) return (n & ~63) + perm64(n & 63);
        if (n < 4096) return n;
        if (n < 5376) { const int m = n - 4096; return 4160 + (m & ~127) + perm128(m & 127); }
        if (n < 5632) return 5440 + (n - 5376);
        const int j = n - 5632; return j < 64 ? 4096 + perm64(j) : -1;
    }
    { const int h = n / 192, p = n - 192 * h; return p < 128 ? n : h * 192 + 128 + perm64(p - 128); }
}
__device__ __forceinline__ void cvt_matrix(const float* W, int ldw, int K, int Nd, bf16_t* WT, int kind, const float* gain, LAS float* scr, int gw, int NGW, int lane, int f0 = 0, int f1 = 16) {
    const int nblk = Nd / 32, nitems = (K / 64) * nblk, items = (int)((long)nitems * f1 / 16), item0 = (int)((long)nitems * f0 / 16);
    const int l8 = lane & 7, r8 = lane >> 3;
    f32x4 v[8]; float gv[8];
    int it = item0 + gw;
#define CVT_LOAD(item) do { const int kb_ = (item) / nblk, nb_ = (item) - kb_ * nblk; const int sc_ = srccol(kind, 32 * nb_ + 4 * l8); \
        const float* wp_ = W + (size_t)(64 * kb_ + r8) * ldw + (sc_ >= 0 ? sc_ : 0); \
        _Pragma("unroll") for (int i = 0; i < 8; ++i) v[i] = __builtin_nontemporal_load((const GAS f32x4*)(wp_ + (size_t)(8 * i) * ldw)); \
        if (gain) { _Pragma("unroll") for (int i = 0; i < 8; ++i) gv[i] = ((const GAS float*)gain)[64 * kb_ + 8 * i + r8]; } else { _Pragma("unroll") for (int i = 0; i < 8; ++i) gv[i] = 1.f; } \
        if (sc_ < 0) { _Pragma("unroll") for (int i = 0; i < 8; ++i) gv[i] = 0.f; } } while (0)
    if (it < items) CVT_LOAD(it);
    while (it < items) {
        const int kb = it / nblk, nb = it - kb * nblk, k0 = 64 * kb, n0 = 32 * nb;
#pragma unroll
        for (int i = 0; i < 8; ++i) { const int kk = 8 * i + r8; const f32x4 x = v[i] * gv[i];
            LAS float* d = scr + kk * 33 + 4 * l8; d[0] = x[0]; d[1] = x[1]; d[2] = x[2]; d[3] = x[3]; }
        const int nit = it + NGW;
        if (nit < items) CVT_LOAD(nit);
        LDS_WAIT(); asm volatile("" ::: "memory");
#pragma unroll
        for (int j = 0; j < 4; ++j) { const int n = r8 + 8 * j; const LAS float* s = scr + (8 * l8) * 33 + n;
            v4u o; o.x = pg8::cvt_pk_bf16(s[0 * 33], s[1 * 33]); o.y = pg8::cvt_pk_bf16(s[2 * 33], s[3 * 33]); o.z = pg8::cvt_pk_bf16(s[4 * 33], s[5 * 33]); o.w = pg8::cvt_pk_bf16(s[6 * 33], s[7 * 33]);
            *(GAS v4u*)(WT + (size_t)(n0 + n) * K + k0 + 8 * l8) = o; }
        LDS_WAIT(); asm volatile("" ::: "memory");
        it = nit;
    }
#undef CVT_LOAD
}
__device__ __forceinline__ void norm_row_bf16(const float* xrow, const float* g, bf16_t* orow, int lane) {
    const f32x4* xr = (const f32x4*)xrow + lane; const f32x4* gr = (const f32x4*)g + lane;
    f32x4 v[8]; float s = 0.f;
#pragma unroll
    for (int j = 0; j < 8; ++j) { v[j] = xr[64 * j]; s += (v[j][0] * v[j][0] + v[j][1] * v[j][1]) + (v[j][2] * v[j][2] + v[j][3] * v[j][3]); }
    const float r = rsqrtf(wave_sum(s) * (1.f / D) + 1e-6f);
    unsigned long long* o8 = (unsigned long long*)orow + lane;
#pragma unroll
    for (int j = 0; j < 8; ++j) { const f32x4 gg = gr[64 * j]; o8[64 * j] = (unsigned long long)pk2(v[j][0] * r * gg[0], v[j][1] * r * gg[1]) | ((unsigned long long)pk2(v[j][2] * r * gg[2], v[j][3] * r * gg[3]) << 32); }
}
constexpr float C_DIFF = 0.125f * LOG2E, C_MLA = 0.07216878364870323f * LOG2E, C_128 = 0.08838834764831845f * LOG2E;
__device__ __forceinline__ void diff_unit(const bf16_t* QD, const bf16_t* KD, const bf16_t* VD, float* atmp, bf16_t* OB0, const float* subln, float lam, float one_m_li, int h, int qb, char* lds) {
    int tid = threadIdx.x; asm volatile("" : "+v"(tid));
    const int lane = tid & 63, r32 = lane & 31;
    at::f32x16 o[4]; float rli[16];
    f32x4* tp = (f32x4*)(atmp + ((size_t)blockIdx.x * 512 + tid) * 64);
    for (int c = 0; c < 2; ++c) {
        at::attn_core1<64, false>(QD + (size_t)qb * 256 * 1024 + (2 * h + c) * 64, 1024, KD + (2 * h + c) * 64, 1024, VD + h * 128, 1024, S / 64, C_DIFF, at::THR / 0.125f, -1e30f, 0.f, 0, lds, o, rli);
        if (c == 0) {
#pragma unroll
            for (int d0 = 0; d0 < 4; ++d0)
#pragma unroll
                for (int r4 = 0; r4 < 4; ++r4) tp[d0 * 4 + r4] = (f32x4){o[d0][4 * r4] * rli[4 * r4], o[d0][4 * r4 + 1] * rli[4 * r4 + 1], o[d0][4 * r4 + 2] * rli[4 * r4 + 2], o[d0][4 * r4 + 3] * rli[4 * r4 + 3]};
        }
    }
    float ss[16];
#pragma unroll
    for (int r = 0; r < 16; ++r) ss[r] = 0.f;
#pragma unroll
    for (int d0 = 0; d0 < 4; ++d0) {
#pragma unroll
        for (int r4 = 0; r4 < 4; ++r4) { const f32x4 t = tp[d0 * 4 + r4];
#pragma unroll
            for (int j = 0; j < 4; ++j) { const int r = 4 * r4 + j; const float v = t[j] - lam * (o[d0][r] * rli[r]); o[d0][r] = v; ss[r] += v * v; } }
        asm volatile("" ::: "memory"); }
#pragma unroll
    for (int r = 0; r < 16; ++r) { float s = ss[r]; s += __shfl_xor(s, 1); s += __shfl_xor(s, 2); s += __shfl_xor(s, 4); s += __shfl_xor(s, 8); s += __shfl_xor(s, 16);
        rli[r] = rsqrtf(s * (1.f / 128.f) + 1e-5f) * one_m_li; }
#pragma unroll
    for (int d0 = 0; d0 < 4; ++d0) { const float g = subln[d0 * 32 + r32];
#pragma unroll
        for (int r = 0; r < 16; ++r) o[d0][r] *= g; }
    at::store_o(OB0 + (size_t)qb * 256 * 1024 + h * 128, 1024, o, rli);
}
__device__ __forceinline__ void mla_unit(const bf16_t* QM, const bf16_t* KM, const bf16_t* VM, bf16_t* OB1, int h, int qb, char* lds) {
    at::f32x16 o[4]; float rli[16];
    at::attn_core1<192, false>(QM + (size_t)qb * 256 * 1536 + h * 192, 1536, KM + h * 192, 1536, VM + h * 128, 1024, S / 64, C_MLA, at::THR / 0.07216878364870323f, -1e30f, 0.f, 0, lds, o, rli);
    at::store_o(OB1 + (size_t)qb * 256 * 1024 + h * 128, 1024, o, rli);
}
__device__ __forceinline__ void gqa_unit(const bf16_t* QG, const bf16_t* KG, const bf16_t* VG, bf16_t* OB2, const float* sink, int h, int qb, char* lds) {
    at::f32x16 o[4]; float rli[16];
    int k0 = qb * 256 - 128; if (k0 < 0) k0 = 0; int k1 = qb * 256 + 384; if (k1 > S) k1 = S;
    const int kvh = h >> 2;
    at::attn_core1<128, true>(QG + (size_t)qb * 256 * 1024 + h * 128, 1024, KG + (size_t)k0 * 256 + kvh * 128, 256, VG + (size_t)k0 * 256 + kvh * 128, 256, (k1 - k0) / 64, C_128,
                             at::THR / 0.08838834764831845f, sink[h] / 0.08838834764831845f, 1.f, qb * 256 - k0, lds, o, rli);
    at::store_o(OB2 + (size_t)qb * 256 * 1024 + h * 128, 1024, o, rli);
}
__device__ __forceinline__ void xattn_unit(const bf16_t* QX, const bf16_t* KVX, bf16_t* OX, int h, int qb, char* lds) {
    at::f32x16 o[4]; float rli[16];
    at::attn_core1<128, false>(QX + (size_t)qb * 256 * 512 + h * 128, 512, KVX + h * 128, 1024, KVX + 512 + h * 128, 1024, MEMLEN / 64, C_128, at::THR / 0.08838834764831845f, -1e30f, 0.f, 0, lds, o, rli);
    at::store_o(OX + (size_t)qb * 256 * 512 + h * 128, 512, o, rli);
}

constexpr int PH_PER_LAYER = 12, N_PHASES = 2 + DEPTH * PH_PER_LAYER + 1;

__device__ __forceinline__ unsigned char* ldptr(volatile LAS unsigned* PT, int i) {
    const unsigned lo = PT[2 * i], hi = PT[2 * i + 1];
    return (unsigned char*)(((unsigned long long)(unsigned)__builtin_amdgcn_readfirstlane((int)hi) << 32) | (unsigned)__builtin_amdgcn_readfirstlane((int)lo));
}
#define PIN(i) ((const float*)ldptr(PT, (i)))
#define WSP(T, off) ((T*)(ws + (off)))
#define PHASE_BEGIN() int tid = threadIdx.x; asm volatile("" : "+v"(tid)); const int lane = tid & 63, wave = __builtin_amdgcn_readfirstlane(tid >> 6), gw = bx * NWAVES + wave; \
    unsigned char* ws = ldptr(PT, 29); (void)lane; (void)gw; (void)ws

__device__ __forceinline__ void cvt_layer_part(volatile LAS unsigned* PT, unsigned char* ws, int l, int part, LAS float* scr, int gw, int NGW, int lane) {
    bf16_t* lw = WSP(bf16_t, WS_LW) + (size_t)l * LW_ELEMS;
    if (part == 0) cvt_matrix(PIN(4) + (size_t)l * D * 2 * DFF, 2 * DFF, D, 2 * DFF, lw + LW_GU1, 1, PIN(3) + (size_t)l * D, scr, gw, NGW, lane);
    if (part == 1) cvt_matrix(PIN(25) + (size_t)l * D * 2 * DFF, 2 * DFF, D, 2 * DFF, lw + LW_GU2, 1, PIN(24) + (size_t)l * D, scr, gw, NGW, lane);
    if (part == 2) {
        cvt_matrix(PIN(12) + (size_t)l * 512 * 1536, 1536, 512, 1536, lw + LW_UQKV, 3, PIN(10) + (size_t)l * 512, scr, gw, NGW, lane);
        cvt_matrix(PIN(13) + (size_t)l * 512 * 2048, 2048, 512, 2048, lw + LW_UQKV + (size_t)1536 * 512, 0, PIN(11) + (size_t)l * 512, scr, gw, NGW, lane);
        cvt_matrix(PIN(21) + (size_t)l * D * 512, 512, D, 512, lw + LW_XQ, 0, PIN(19) + (size_t)l * D, scr, gw, NGW, lane);
        cvt_matrix(PIN(23) + (size_t)l * 512 * D, D, 512, D, lw + LW_XO, 0, nullptr, scr, gw, NGW, lane);
        cvt_matrix(PIN(18) + (size_t)l * D * D, D, D, D, lw + LW_WO, 0, nullptr, scr, gw, NGW, lane);
        for (int n = 0; n < 3; ++n) cvt_matrix(PIN(15) + ((size_t)l * 3 + n) * 1024 * D, D, 1024, D, lw + LW_BR + (size_t)n * D * 1024, 0, nullptr, scr, gw, NGW, lane);
        cvt_matrix(PIN(5) + (size_t)l * DFF * D, D, DFF, D, lw + LW_DN1, 0, nullptr, scr, gw, NGW, lane);
    }
}
constexpr int NCVTD = 27;
__device__ __forceinline__ void cvt_desc_geom(int t, int& l, int& ty, int& f0, int& f1) {
    f0 = 0; f1 = 16;
    if (t < 14) { l = 0; ty = t; }
    else if (t < 23) { const int q = (t - 14) / 3, r = (t - 14) - 3 * q; l = 1 + q; ty = r == 0 ? 8 : r == 1 ? 9 : 13; }
    else { l = t - 23; ty = 14; }
}
__device__ __forceinline__ void cvt_desc_kn(int ty, int& K, int& Nd) {
    K = D; Nd = D;
    if (ty <= 1) Nd = 2 * DFF; else if (ty == 2) { K = 512; Nd = 1536; } else if (ty == 3) { K = 512; Nd = 2048; } else if (ty == 4) Nd = 512; else if (ty == 5) K = 512;
    else if (ty == 7 || ty == 13) K = DFF; else if (ty == 8) Nd = 5888; else if (ty == 9) Nd = 3 * D; else if (ty >= 10 && ty <= 12) K = 1024; else if (ty == 14) Nd = 1024;
}
__device__ __forceinline__ int cvt_desc_cnt(int t, int& item0) {
    int l, ty, f0, f1, K, Nd; cvt_desc_geom(t, l, ty, f0, f1); cvt_desc_kn(ty, K, Nd);
    const int nitems = (K / 64) * (Nd / 32); item0 = (int)((long)nitems * f0 / 16); return (int)((long)nitems * f1 / 16) - item0;
}
__device__ __forceinline__ unsigned long long ldptr_v(volatile LAS unsigned* PT, int i) { return ((unsigned long long)PT[2 * i + 1] << 32) | PT[2 * i]; }
__device__ __forceinline__ void cvt_desc_fill(int t, volatile LAS unsigned* PT, volatile LAS unsigned* DT) {
    int start = 0, dummy;
    for (int u = 0; u < t && u < NCVTD; ++u) start += cvt_desc_cnt(u, dummy);
    if (t == NCVTD) { DT[t * 12 + 11] = (unsigned)start; return; }
    int l, ty, f0, f1, K, Nd, item0; cvt_desc_geom(t, l, ty, f0, f1); cvt_desc_kn(ty, K, Nd); (void)cvt_desc_cnt(t, item0);
    int pw = 0, pg = -1, kind = 0, ldw = Nd; size_t wo = 0, go = (size_t)l * D, dst = 0;
    switch (ty) {
        case 0: pw = 4; wo = (size_t)l * D * 2 * DFF; pg = 3; kind = 1; dst = LW_GU1; break;
        case 1: pw = 25; wo = (size_t)l * D * 2 * DFF; pg = 24; kind = 1; dst = LW_GU2; break;
        case 2: pw = 12; wo = (size_t)l * 512 * 1536; pg = 10; go = (size_t)l * 512; kind = 3; dst = LW_UQKV; break;
        case 3: pw = 13; wo = (size_t)l * 512 * 2048; pg = 11; go = (size_t)l * 512; dst = LW_UQKV + (size_t)1536 * 512; break;
        case 4: pw = 21; wo = (size_t)l * D * 512; pg = 19; dst = LW_XQ; break;
        case 5: pw = 23; wo = (size_t)l * 512 * D; dst = LW_XO; break;
        case 6: pw = 18; wo = (size_t)l * D * D; dst = LW_WO; break;
        case 7: pw = 5; wo = (size_t)l * DFF * D; dst = LW_DN1; break;
        case 8: pw = 7; wo = (size_t)l * D * DIN; ldw = DIN; pg = 6; kind = 2; dst = LW_IN; break;
        case 9: pw = 16; wo = (size_t)l * D * 3 * D; pg = 6; dst = LW_IN + (size_t)5888 * D; break;
        case 10: case 11: case 12: pw = 15; wo = ((size_t)l * 3 + (ty - 10)) * 1024 * D; dst = LW_BR + (size_t)(ty - 10) * D * 1024; break;
        case 13: pw = 26; wo = (size_t)l * DFF * D; dst = LW_DN2; break;
        default: pw = 22; wo = (size_t)l * D * 1024; break;
    }
    const unsigned long long wsb = ldptr_v(PT, 29);
    const unsigned long long W = ldptr_v(PT, pw) + 4ull * wo, G_ = pg >= 0 ? ldptr_v(PT, pg) + 4ull * go : 0ull;
    const unsigned long long WT = ty == 14 ? wsb + WS_WXKV + 2ull * ((size_t)l * 1024 * D) : wsb + WS_LW + 2ull * ((size_t)l * LW_ELEMS + dst);
    volatile LAS unsigned* d = DT + t * 12;
    d[0] = (unsigned)W; d[1] = (unsigned)(W >> 32); d[2] = (unsigned)WT; d[3] = (unsigned)(WT >> 32); d[4] = (unsigned)G_; d[5] = (unsigned)(G_ >> 32);
    d[6] = (unsigned)ldw; d[7] = (unsigned)K; d[8] = (unsigned)(Nd / 32); d[9] = (unsigned)kind; d[10] = (unsigned)item0; d[11] = (unsigned)start;
}
template <int MODE = 0> __device__ __forceinline__ void cvt_flat(volatile LAS unsigned* DT, LAS float* scr, int gw, int NGW, int lane) {
#define DW(m_, j_) __builtin_amdgcn_readfirstlane((int)DT[(m_) * 12 + (j_)])
#define DP(m_, j_) (((unsigned long long)(unsigned)DW(m_, (j_) + 1) << 32) | (unsigned)DW(m_, j_))
    const int total = DW(NCVTD, 11);
    const int l8 = lane & 7, r8 = lane >> 3;
    f32x4 v[8]; float gv[8];
    int it = gw, m = 0;
    bf16_t* WTn = nullptr; int Kn = 0, k0n = 0, n0n = 0;
#define FLAT_LOAD(item) do { while ((item) >= DW(m + 1, 11)) ++m; \
        const int loc_ = (item) - DW(m, 11) + DW(m, 10), nblk_ = DW(m, 8), kind_ = DW(m, 9), ldw_ = DW(m, 6); \
        const int kb_ = loc_ / nblk_, nb_ = loc_ - kb_ * nblk_; const int sc_ = srccol(kind_, 32 * nb_ + 4 * l8); \
        const float* wp_ = (const float*)DP(m, 0) + (size_t)(64 * kb_ + r8) * ldw_ + (sc_ >= 0 ? sc_ : 0); \
        _Pragma("unroll") for (int i = 0; i < 8; ++i) { if (MODE == 2) { v[i] = (f32x4){0.f, 0.f, 0.f, 0.f}; asm volatile("" : "+v"(v[i]) : "v"(wp_)); } else v[i] = __builtin_nontemporal_load((const GAS f32x4*)(wp_ + (size_t)(8 * i) * ldw_)); } \
        const float* g_ = (const float*)DP(m, 4); \
        if (g_) { _Pragma("unroll") for (int i = 0; i < 8; ++i) gv[i] = ((const GAS float*)g_)[64 * kb_ + 8 * i + r8]; } else { _Pragma("unroll") for (int i = 0; i < 8; ++i) gv[i] = 1.f; } \
        if (sc_ < 0) { _Pragma("unroll") for (int i = 0; i < 8; ++i) gv[i] = 0.f; } \
        WTn = (bf16_t*)DP(m, 2); Kn = DW(m, 7); k0n = 64 * kb_; n0n = 32 * nb_; } while (0)
    if (it < total) FLAT_LOAD(it);
    while (it < total) {
        bf16_t* WT = WTn; const int K = Kn, k0 = k0n, n0 = n0n;
#pragma unroll
        for (int i = 0; i < 8; ++i) { const int kk = 8 * i + r8; const f32x4 x = v[i] * gv[i];
            LAS float* d = scr + kk * 33 + 4 * l8; d[0] = x[0]; d[1] = x[1]; d[2] = x[2]; d[3] = x[3]; }
        const int nit = it + NGW;
        if (nit < total) FLAT_LOAD(nit);
        LDS_WAIT(); asm volatile("" ::: "memory");
#pragma unroll
        for (int j = 0; j < 4; ++j) { const int n = r8 + 8 * j; const LAS float* s = scr + (8 * l8) * 33 + n;
            v4u o; o.x = pg8::cvt_pk_bf16(s[0 * 33], s[1 * 33]); o.y = pg8::cvt_pk_bf16(s[2 * 33], s[3 * 33]); o.z = pg8::cvt_pk_bf16(s[4 * 33], s[5 * 33]); o.w = pg8::cvt_pk_bf16(s[6 * 33], s[7 * 33]);
            if (MODE == 1) asm volatile("" :: "v"(o), "v"(WT + (size_t)(n0 + n) * K + k0 + 8 * l8)); else *(GAS v4u*)(WT + (size_t)(n0 + n) * K + k0 + 8 * l8) = o; }
        LDS_WAIT(); asm volatile("" ::: "memory");
        it = nit;
    }
#undef FLAT_LOAD
#undef DP
#undef DW
}
constexpr int CVT_WG = 16;
__device__ __forceinline__ bool in_rng(int k, int lo, int hi) { asm volatile("" : "+s"(k)); return lo <= k && k < hi; }
__global__ void __launch_bounds__(NWAVES * 64, 2) mega(Args args) {
    extern __shared__ __attribute__((aligned(16))) unsigned char lds_raw[];
    LAS unsigned char* lds = (LAS unsigned char*)lds_raw;
    volatile LAS unsigned* MISC = (volatile LAS unsigned*)(lds + MISC_OFF);
    volatile LAS unsigned* PT = (volatile LAS unsigned*)(lds + MISC_OFF + 256);
    const int G = gridDim.x, bx = blockIdx.x, NGW = G * NWAVES;
    for (int u = threadIdx.x; u < (LDS_BYTES - RING_BYTES) / 4; u += NWAVES * 64) ((LAS unsigned*)(lds + RING_BYTES))[u] = 0u;
    __syncthreads();
    if (threadIdx.x == 0) {
#define PT_SET(i, p) do { const unsigned long long v_ = (unsigned long long)(p); PT[2 * (i)] = (unsigned)v_; PT[2 * (i) + 1] = (unsigned)(v_ >> 32); } while (0)
        PT_SET(0, args.in[0]); PT_SET(1, args.in[1]); PT_SET(2, args.in[2]); PT_SET(3, args.in[3]); PT_SET(4, args.in[4]); PT_SET(5, args.in[5]); PT_SET(6, args.in[6]);
        PT_SET(7, args.in[7]); PT_SET(8, args.in[8]); PT_SET(9, args.in[9]); PT_SET(10, args.in[10]); PT_SET(11, args.in[11]); PT_SET(12, args.in[12]); PT_SET(13, args.in[13]);
        PT_SET(14, args.in[14]); PT_SET(15, args.in[15]); PT_SET(16, args.in[16]); PT_SET(17, args.in[17]); PT_SET(18, args.in[18]); PT_SET(19, args.in[19]); PT_SET(20, args.in[20]);
        PT_SET(21, args.in[21]); PT_SET(22, args.in[22]); PT_SET(23, args.in[23]); PT_SET(24, args.in[24]); PT_SET(25, args.in[25]); PT_SET(26, args.in[26]); PT_SET(27, args.in[27]);
        PT_SET(28, args.out); PT_SET(29, args.ws);
#undef PT_SET
    }
    __syncthreads();
#if MK_PER_PHASE
#define GRID_BAR() do { } while (0)
#else
    XcdBarrier bar = xcd_barrier_post((unsigned*)(args.ws + WS_CTL) + CW_BAR, MISC + 8);
#if MK_STAMP >= 0
    int nbar = 0; unsigned long long st0 = __builtin_amdgcn_s_memrealtime(), st1 = st0;
#define GRID_BAR() do { xcd_barrier(bar); if (nbar == MK_STAMP - 1) st0 = __builtin_amdgcn_s_memrealtime(); if (nbar == MK_STAMP) st1 = __builtin_amdgcn_s_memrealtime(); ++nbar; } while (0)
#else
#define GRID_BAR() xcd_barrier(bar)
#endif
#endif
    const int lo = args.ph_lo, hi = args.ph_hi;
#define IN(k) in_rng((k), lo, hi)
#define PH_ON(j) (MK_ONLY < 0 || MK_ONLY == (j))
#define BOTH(k) (IN(k) && IN((k) + 1))

    if (PH_ON(0) && IN(0)) {
        PHASE_BEGIN();
        LAS float* scr = (LAS float*)(lds + wave * 16384);
        bf16_t* WXKV = WSP(bf16_t, WS_WXKV); bf16_t* MEMN = WSP(bf16_t, WS_MEMN);
        { volatile LAS unsigned* DT = (volatile LAS unsigned*)(lds + RSS_LDS_OFF);
          if (tid <= NCVTD) cvt_desc_fill(tid, PT, DT);
          __syncthreads();
          if (MK_DUP == 101) cvt_flat<1>(DT, scr, gw, NGW, lane);
          if (MK_DUP == 102) cvt_flat<2>(DT, scr, gw, NGW, lane);
          for (int rep = 0; rep < (MK_DUP == 100 ? 2 : 1); ++rep) cvt_flat<0>(DT, scr, gw, NGW, lane);
          __syncthreads(); }
        for (int l = 0; l < DEPTH; ++l)
            for (int m = gw; m < MEMLEN; m += NGW) norm_row_bf16(PIN(1) + (size_t)m * D, PIN(20) + (size_t)l * D, MEMN + ((size_t)l * MEMLEN + m) * D, lane);
        { float2* CS64 = WSP(float2, WS_CS64); float2* CS128 = WSP(float2, WS_CS128); const int* pos = (const int*)PIN(2);
          for (int idx = bx * 512 + tid; idx < S * 96; idx += G * 512) {
            const int s = idx / 96, j = idx - 96 * s; const int dim = j < 32 ? 64 : 128, i = j < 32 ? j : j - 32;
            const float inv = powf(10000.0f, -((float)(2 * i) / (float)dim)); const float ang = (float)pos[s] * inv;
            const float2 v = make_float2(cosf(ang), sinf(ang));
            if (j < 32) CS64[s * 32 + i] = v; else CS128[s * 64 + i] = v; } }
        { const float* x = PIN(0); bf16_t* AN = WSP(bf16_t, WS_AN); _Float16* H16 = WSP(_Float16, WS_H); rss_t* RSS0 = (rss_t*)(ws + WS_PART);
          for (int m = gw; m < S; m += NGW) {
            const GAS f32x4* xr = (const GAS f32x4*)(x + (size_t)m * D) + lane; GAS unsigned long long* o8 = (GAS unsigned long long*)(AN + (size_t)m * D) + lane; float s = 0.f;
            typedef _Float16 h16x4 __attribute__((ext_vector_type(4))); GAS h16x4* h8 = (GAS h16x4*)(H16 + (size_t)m * D) + lane;
            f32x4 xv[8];
#pragma unroll
            for (int j = 0; j < 8; ++j) xv[j] = xr[64 * j];
#pragma unroll
            for (int j = 0; j < 8; ++j) { const f32x4 v = xv[j]; s += (v[0] * v[0] + v[1] * v[1]) + (v[2] * v[2] + v[3] * v[3]);
                o8[64 * j] = (unsigned long long)pg8::cvt_pk_bf16(v[0], v[1]) | ((unsigned long long)pg8::cvt_pk_bf16(v[2], v[3]) << 32); h8[64 * j] = __builtin_convertvector(v, h16x4); }
            s = wave_sum(s); if (lane < 8) RSS0[(size_t)m * 8 + lane] = lane == 0 ? s : 0.f; } }
        if (BOTH(0)) GRID_BAR();
    }
    for (int l = 0; l < DEPTH; ++l) {
        const int pb = 2 + l * PH_PER_LAYER;
        const float lambda_init = 0.8f - 0.6f * expf(-0.3f * (float)l);
#define NREP(j) ((MK_DUP == (j) && l == 0) ? 2 : 1)
#define LWP(off) (WSP(bf16_t, WS_LW) + (size_t)l * LW_ELEMS + (off))
#define RSSP(k) ((rss_t*)(ws + WS_PART) + (size_t)(4 * l + (k)) * S * 8)
#define RSSMP() ((rss_t*)(ws + WS_PARTM) + (size_t)l * 2 * S * 2)
        for (int rep = 0; rep < NREP(0); ++rep) if (PH_ON(2 + 0) && IN(pb + 0)) {
            PHASE_BEGIN();
            const int gg = (l + 1 < DEPTH && rep == 0) ? G - CVT_WG : G;
            if (bx >= gg) cvt_layer_part(PT, ws, l + 1, 0, (LAS float*)(lds + wave * 16384), (bx - gg) * NWAVES + wave, CVT_WG * NWAVES, lane);
            else {
            pg8::Gemm g{WSP(bf16_t, WS_AN), LWP(LW_GU1), S, 2 * DFF, D}; pg8::StaticOrder O; O.init(S, 2 * DFF, gg, bx); EpiSwiglu E{WSP(bf16_t, WS_HID), RSSP(0), lds, 64 * (4 * l + 0) + 1};
            pg8::gemm_phase<EpiSwiglu, pg8::StaticOrder>(lds, g, O, E);
            }
            if (BOTH(pb + 0)) GRID_BAR();
        }
        for (int rep = 0; rep < NREP(1); ++rep) if (PH_ON(2 + 1) && IN(pb + 1)) {
            PHASE_BEGIN();
            pg8::Gemm g{WSP(bf16_t, WS_HID), LWP(LW_DN1), S, D, DFF}; pg8::StaticOrder O; O.init(S, D, G, bx); EpiResid E{WSP(_Float16, WS_H), WSP(bf16_t, WS_AN), rep ? 0.f : 0.5f, rep == 0, RSSP(1), lds};
            pg8::gemm_phase<EpiResid, pg8::StaticOrder>(lds, g, O, E);
            if (BOTH(pb + 1)) GRID_BAR();
        }
        for (int rep = 0; rep < NREP(2); ++rep) if (PH_ON(2 + 2) && IN(pb + 2)) {
            PHASE_BEGIN();
#if MK_SPLIT_IN
            pg8::Gemm g{WSP(bf16_t, WS_AN), LWP(LW_IN), S, 5888, D}; pg8::StaticOrder O; O.init(S, 5888, G, bx);
#else
            pg8::Gemm g{WSP(bf16_t, WS_AN), LWP(LW_IN), S, NIN, D}; pg8::StaticOrder O; O.init(S, NIN, G, bx);
#endif
            EpiIn E{WSP(bf16_t, WS_QD), WSP(bf16_t, WS_KD), WSP(bf16_t, WS_VD), WSP(bf16_t, WS_CQR), WSP(bf16_t, WS_CKVR), WSP(bf16_t, WS_QG), WSP(bf16_t, WS_KG), WSP(bf16_t, WS_VG), WSP(bf16_t, WS_KM),
                    WSP(bf16_t, WS_GATE), WSP(float2, WS_CS64), WSP(float2, WS_CS128), PIN(17) + (size_t)l * 3 * D, RSSP(1), rep ? (rss_t*)nullptr : RSSMP(), lds, 64 * (4 * l + 1) + 1};
            pg8::gemm_phase<EpiIn, pg8::StaticOrder>(lds, g, O, E);
#if MK_SPLIT_IN
            { pg8::Gemm g2{WSP(bf16_t, WS_AN), LWP(LW_IN) + (size_t)5888 * D, S, 3 * D, D}; pg8::StaticOrder O2; O2.init(S, 3 * D, G, bx); EpiGate E2{WSP(bf16_t, WS_GATE), PIN(17) + (size_t)l * 3 * D, RSSP(1), lds, 64 * (4 * l + 1) + 1};
              pg8::gemm_phase<EpiGate, pg8::StaticOrder>(lds, g2, O2, E2); }
#endif
            if (BOTH(pb + 2)) GRID_BAR();
        }
        for (int rep = 0; rep < NREP(3); ++rep) if (PH_ON(2 + 3) && IN(pb + 3)) {
            PHASE_BEGIN();
            pg8::Gemm g{WSP(bf16_t, WS_CQR), LWP(LW_UQKV), 2 * S, 1536 + 2048, 512}; MlaOrder O{G, bx}; EpiMlaUp E{WSP(bf16_t, WS_QM), WSP(bf16_t, WS_KM), WSP(bf16_t, WS_VM), WSP(float2, WS_CS64), RSSMP()};
            pg8::gemm_phase<EpiMlaUp, MlaOrder>(lds, g, O, E);
            if (BOTH(pb + 3)) GRID_BAR();
        }
        for (int rep = 0; rep < NREP(4); ++rep) if (PH_ON(2 + 4) && IN(pb + 4)) {
            { PHASE_BEGIN();
              const float* lp = PIN(8) + (size_t)l * 256;
              const float lam = expf(wave_sum(lp[lane] * lp[64 + lane])) - expf(wave_sum(lp[128 + lane] * lp[192 + lane])) + lambda_init;
              for (int r2 = 0; r2 < NREP(60); ++r2) for (int L = bx; L < 256; L += G) diff_unit(WSP(bf16_t, WS_QD), WSP(bf16_t, WS_KD), WSP(bf16_t, WS_VD), WSP(float, WS_ATMP), WSP(bf16_t, WS_OB), PIN(9) + (size_t)l * 128, lam, 1.f - lambda_init, L & 7, L >> 3, (char*)lds_raw); }
            { PHASE_BEGIN();
              for (int r2 = 0; r2 < NREP(61); ++r2) for (int L = bx; L < 256; L += G) mla_unit(WSP(bf16_t, WS_QM), WSP(bf16_t, WS_KM), WSP(bf16_t, WS_VM), WSP(bf16_t, WS_OB) + (size_t)S * 1024, L & 7, L >> 3, (char*)lds_raw); }
            { PHASE_BEGIN();
              for (int r2 = 0; r2 < NREP(62); ++r2) for (int L = bx; L < 256; L += G) gqa_unit(WSP(bf16_t, WS_QG), WSP(bf16_t, WS_KG), WSP(bf16_t, WS_VG), WSP(bf16_t, WS_OB) + (size_t)2 * S * 1024, PIN(14) + (size_t)l * 8, L & 7, L >> 3, (char*)lds_raw); }
            __syncthreads();
            if (BOTH(pb + 4)) GRID_BAR();
        }
        for (int rep = 0; rep < NREP(5); ++rep) if (PH_ON(2 + 5) && IN(pb + 5)) {
            PHASE_BEGIN();
            pg8::Gemm g{WSP(bf16_t, WS_OB), LWP(LW_BR), 3 * S, 3 * D, 1024}; BranchOrder O; O.so.init(S, D, G, bx); EpiBranch E{WSP(bf16_t, WS_GATE), WSP(bf16_t, WS_MG)};
            pg8::gemm_phase<EpiBranch, BranchOrder>(lds, g, O, E);
            if (BOTH(pb + 5)) GRID_BAR();
        }
        for (int rep = 0; rep < NREP(6); ++rep) if (PH_ON(2 + 6) && IN(pb + 6)) {
            PHASE_BEGIN();
            pg8::Gemm g{WSP(bf16_t, WS_MG), LWP(LW_WO), S, D, D}; pg8::StaticOrder O; O.init(S, D, G, bx); EpiResid E{WSP(_Float16, WS_H), WSP(bf16_t, WS_AN), rep ? 0.f : 1.f, rep == 0, RSSP(2), lds};
            pg8::gemm_phase<EpiResid, pg8::StaticOrder>(lds, g, O, E);
            if (BOTH(pb + 6)) GRID_BAR();
        }
        for (int rep = 0; rep < NREP(7); ++rep) if (PH_ON(2 + 7) && IN(pb + 7)) {
            PHASE_BEGIN();
            if (l == 0 && bx >= 64 && bx < 80) {
                pg8::Gemm g{WSP(bf16_t, WS_MEMN), WSP(bf16_t, WS_WXKV), 4 * MEMLEN, 4 * 1024, D}; KvxOrder O{16, bx - 64}; EpiPlain E{WSP(bf16_t, WS_KVX), 1024, 4, nullptr, lds, 0};
                pg8::gemm_phase<EpiPlain, KvxOrder>(lds, g, O, E);
            } else if (bx >= 80) {
                if (l + 1 < DEPTH && rep == 0) cvt_layer_part(PT, ws, l + 1, 2, (LAS float*)(lds + wave * 16384), (bx - 80) * NWAVES + wave, (G - 80) * NWAVES, lane);
            } else {
            pg8::Gemm g{WSP(bf16_t, WS_AN), LWP(LW_XQ), S, 512, D}; pg8::StaticOrder O; O.init(S, 512, G, bx); EpiPlain E{WSP(bf16_t, WS_QX), 512, 0, RSSP(2), lds, 64 * (4 * l + 2) + 1};
            pg8::gemm_phase<EpiPlain, pg8::StaticOrder>(lds, g, O, E);
            }
            if (BOTH(pb + 7)) GRID_BAR();
        }
        for (int rep = 0; rep < NREP(8); ++rep) if (PH_ON(2 + 8) && IN(pb + 8)) {
            PHASE_BEGIN();
            for (int L = bx; L < 128; L += G) xattn_unit(WSP(bf16_t, WS_QX), WSP(bf16_t, WS_KVX) + (size_t)l * MEMLEN * 1024, WSP(bf16_t, WS_OX), L & 3, L >> 2, (char*)lds_raw);
            __syncthreads();
            if (BOTH(pb + 8)) GRID_BAR();
        }
        for (int rep = 0; rep < NREP(9); ++rep) if (PH_ON(2 + 9) && IN(pb + 9)) {
            PHASE_BEGIN();
            pg8::Gemm g{WSP(bf16_t, WS_OX), LWP(LW_XO), S, D, 512}; pg8::StaticOrder O; O.init(S, D, G, bx); EpiResid E{WSP(_Float16, WS_H), WSP(bf16_t, WS_AN), rep ? 0.f : 1.f, rep == 0, RSSP(3), lds};
            pg8::gemm_phase<EpiResid, pg8::StaticOrder>(lds, g, O, E);
            if (BOTH(pb + 9)) GRID_BAR();
        }
        for (int rep = 0; rep < NREP(10); ++rep) if (PH_ON(2 + 10) && IN(pb + 10)) {
            PHASE_BEGIN();
            const int gg = (l + 1 < DEPTH && rep == 0) ? G - CVT_WG : G;
            if (bx >= gg) cvt_layer_part(PT, ws, l + 1, 1, (LAS float*)(lds + wave * 16384), (bx - gg) * NWAVES + wave, CVT_WG * NWAVES, lane);
            else {
            pg8::Gemm g{WSP(bf16_t, WS_AN), LWP(LW_GU2), S, 2 * DFF, D}; pg8::StaticOrder O; O.init(S, 2 * DFF, gg, bx); EpiSwiglu E{WSP(bf16_t, WS_HID), RSSP(3), lds, 64 * (4 * l + 3) + 1};
            pg8::gemm_phase<EpiSwiglu, pg8::StaticOrder>(lds, g, O, E);
            }
            if (BOTH(pb + 10)) GRID_BAR();
        }
        for (int rep = 0; rep < NREP(11); ++rep) if (PH_ON(2 + 11) && IN(pb + 11)) {
            PHASE_BEGIN();
            pg8::Gemm g{WSP(bf16_t, WS_HID), LWP(LW_DN2), S, D, DFF}; pg8::StaticOrder O; O.init(S, D, G, bx); EpiResid E{WSP(_Float16, WS_H), WSP(bf16_t, WS_AN), rep ? 0.f : 0.5f, rep == 0, RSSP(4), lds};
            pg8::gemm_phase<EpiResid, pg8::StaticOrder>(lds, g, O, E);
            if (BOTH(pb + 11)) GRID_BAR();
        }
#undef LWP
#undef RSSP
#undef RSSMP
    }
    if (PH_ON(14) && IN(2 + DEPTH * PH_PER_LAYER)) {
        PHASE_BEGIN();
        const _Float16* H16 = WSP(_Float16, WS_H); const float* fg = PIN(27); float* out = (float*)ldptr(PT, 28);
        f32x4 fgv[4][2];
#pragma unroll
        for (int j = 0; j < 4; ++j)
#pragma unroll
            for (int e = 0; e < 2; ++e) fgv[j][e] = *(const GAS f32x4*)(fg + (64 * j + lane) * 8 + 4 * e);
        for (int m = gw; m < S; m += NGW) {
            const GAS h16x8* ar = (const GAS h16x8*)(H16 + (size_t)m * D) + lane; f32x8e v[4]; float s = 0.f;
#pragma unroll
            for (int j = 0; j < 4; ++j) { v[j] = __builtin_convertvector(ar[64 * j], f32x8e);
#pragma unroll
                for (int e = 0; e < 8; ++e) s += v[j][e] * v[j][e]; }
            const float r = rsqrtf(wave_sum(s) * (1.f / D) + 1e-6f);
#pragma unroll
            for (int j = 0; j < 4; ++j)
#pragma unroll
                for (int e = 0; e < 2; ++e) { const int c = (64 * j + lane) * 8 + 4 * e; const f32x4 g = fgv[j][e];
                    const f32x4 vv = {v[j][4 * e], v[j][4 * e + 1], v[j][4 * e + 2], v[j][4 * e + 3]}; *(GAS f32x4*)(out + (size_t)m * D + c) = vv * r * g; } }
    }
#if !MK_PER_PHASE && MK_STAMP >= 0
    if (bx == 0) { const unsigned long long te = __builtin_amdgcn_s_memrealtime(), wait = (st1 - st0) * 16ull; while (__builtin_amdgcn_s_memrealtime() - te < wait) __builtin_amdgcn_s_sleep(8); }
#endif
#undef IN
#undef BOTH
}
}

extern "C" void kernel_launch(void* const* d_in, const int* in_sizes, int n_in, void* d_out, int out_size, void* d_ws, size_t ws_size, hipStream_t stream) {
    using namespace mk;
    static int grid = 0;
    if (grid == 0) {
        if (n_in != 28 || out_size != S * D || ws_size < WS_END) { fprintf(stderr, "kernel_launch: unexpected n_in %d out %d ws %zu (need %zu)\n", n_in, out_size, ws_size, (size_t)WS_END); grid = -1; return; }
        int dev = 0, cus = 0, per_cu = 0;
        if (hipGetDevice(&dev) != hipSuccess || hipDeviceGetAttribute(&cus, hipDeviceAttributeMultiprocessorCount, dev) != hipSuccess) { grid = -1; return; }
        if (hipFuncSetAttribute((const void*)mega, hipFuncAttributeMaxDynamicSharedMemorySize, LDS_BYTES) != hipSuccess) { fprintf(stderr, "kernel_launch: hipFuncSetAttribute failed\n"); grid = -1; return; }
        if (hipOccupancyMaxActiveBlocksPerMultiprocessor(&per_cu, (const void*)mega, NWAVES * 64, LDS_BYTES) != hipSuccess || per_cu < 1) { fprintf(stderr, "kernel_launch: occupancy query says %d\n", per_cu); }
        (void)hipGetLastError();
        grid = cus;
    }
    if (grid < 0) return;
    (void)hipMemsetAsync((char*)d_ws + WS_CTL, 0, CTL_ZERO_BYTES, stream);
    Args a{};
    for (int i = 0; i < 28; ++i) a.in[i] = d_in[i];
    a.out = (float*)d_out; a.ws = (unsigned char*)d_ws;
#if MK_PER_PHASE
    for (int p = 0; p < N_PHASES; ++p) { a.ph_lo = p; a.ph_hi = p + 1; hipLaunchKernelGGL(mega, dim3(grid), dim3(NWAVES * 64), LDS_BYTES, stream, a); }
#else
    a.ph_lo = 0; a.ph_hi = N_PHASES; hipLaunchKernelGGL(mega, dim3(grid), dim3(NWAVES * 64), LDS_BYTES, stream, a);
#endif
    const hipError_t le = hipPeekAtLastError();
    if (le != hipSuccess) fprintf(stderr, "kernel_launch: launch failed: %s\n", hipGetErrorName(le));
}
```

```cpp
#include <hip/hip_runtime.h>
#include <cstdio>
#include <cmath>
#include <cstdint>
#ifndef MK_PER_PHASE
#define MK_PER_PHASE 0
#endif
#ifndef MK_ONLY
#define MK_ONLY -1
#endif
#ifndef MK_DUP
#define MK_DUP -1
#endif
#ifndef MK_STAMP
#define MK_STAMP -1
#endif
#ifndef MK_SPLIT_IN
#define MK_SPLIT_IN 1
#endif
namespace pg8 {
#define PG8_LAS __attribute__((address_space(3)))
typedef unsigned short bf16_t;
typedef short bf16x8 __attribute__((ext_vector_type(8)));
typedef float f32x4 __attribute__((ext_vector_type(4)));
typedef unsigned u32x4 __attribute__((ext_vector_type(4)));
constexpr int BM = 256, BK = 64, HALF = 128, HTB = HALF * BK * 2, STAGE_BYTES = 8 * HTB, NXCD = 8, WGM = 8;

__host__ __device__ __forceinline__ int lds_byte(int r, int c) { const int st = (r >> 4) * 2 + (c >> 5), rr = r & 15, cc = c & 31, ob = rr * 64 + cc * 2; return st * 1024 + (ob ^ (((ob >> 9) & 1) << 5)); }
__host__ __device__ __forceinline__ void stage_rc(int b, int& R, int& C) { const int st = b / 1024, sb = b % 1024, swz = sb ^ (((sb >> 9) & 1) << 5); R = (st >> 1) * 16 + swz / 64; C = (st & 1) * 32 + (swz % 64) / 2; }
__host__ __device__ __forceinline__ int perm32(int rho) { const int n = rho >> 4, i = rho & 15; return 8 * (i >> 2) + 4 * n + (i & 3); }

struct Unit { int pm, pn; };
struct Gemm { const bf16_t* A; const bf16_t* Bt; int M, N, K; };

struct StaticOrder {
    int nM, nN, nwg, G, c;
    __host__ __device__ void init(int M, int N, int G_, int c_) { nM = M / BM; nN = N / BM; nwg = nM * nN; G = G_; c = c_; }
    __host__ __device__ bool map(int L, Unit& u) const {
        if (L >= nwg) return false;
        int wgid = (int)L; { const int q = nwg / NXCD, r = nwg % NXCD, xcd = wgid % NXCD, off = wgid / NXCD; wgid = (xcd < r ? xcd * (q + 1) : r * (q + 1) + (xcd - r) * q) + off; }
        const int nig = WGM * nN, gid = wgid / nig, fm = gid * WGM, gsz = (nM - fm) < WGM ? (nM - fm) : WGM;
        u.pm = fm + ((wgid % nig) % gsz); u.pn = (wgid % nig) / gsz; return true;
    }
    __host__ __device__ bool next(int i, Unit& u) const { return map(i * G + c, u); }
    __device__ __forceinline__ void a_ready(const Unit&) const {}
    __device__ __forceinline__ void done(const Unit&) const {}
};

__device__ __forceinline__ unsigned cvt_pk_bf16(float lo, float hi) { unsigned r; asm volatile("v_cvt_pk_bf16_f32 %0, %1, %2" : "=v"(r) : "v"(lo), "v"(hi)); return r; }
__device__ __forceinline__ u32x4 pack8(const f32x4 v0, const f32x4 v1) { u32x4 w; w.x = cvt_pk_bf16(v0[0], v0[1]); w.y = cvt_pk_bf16(v0[2], v0[3]); w.z = cvt_pk_bf16(v1[0], v1[1]); w.w = cvt_pk_bf16(v1[2], v1[3]); return w; }
__device__ __forceinline__ void unpack8(const u32x4 w, f32x4& v0, f32x4& v1) {
    v0[0] = __uint_as_float(w.x << 16); v0[1] = __uint_as_float(w.x & 0xffff0000u); v0[2] = __uint_as_float(w.y << 16); v0[3] = __uint_as_float(w.y & 0xffff0000u);
    v1[0] = __uint_as_float(w.z << 16); v1[1] = __uint_as_float(w.z & 0xffff0000u); v1[2] = __uint_as_float(w.w << 16); v1[3] = __uint_as_float(w.w & 0xffff0000u); }

template <class Epi, class Sched, bool ALIGN_EPI = true, bool SP2 = true>
__device__ __forceinline__ void gemm_phase(PG8_LAS unsigned char* lds, const Gemm g, const Sched& S, const Epi& E) {
    int tid = threadIdx.x; asm volatile("" : "+v"(tid));
    const int wid = __builtin_amdgcn_readfirstlane(tid >> 6), lane = tid & 63, wr = wid >> 2, wc = wid & 3, fr = lane & 15, fq = lane >> 4;
    const int K = g.K, nt = K / BK;
    unsigned voffA[2], voffB[2];
#pragma unroll
    for (int i = 0; i < 2; ++i) { int R, C; stage_rc(tid * 16 + i * 8192, R, C); const int Rb = Epi::PERM ? ((R & ~31) + perm32(R & 31)) : R;
        voffA[i] = (unsigned)(R * K + C) * 2u; voffB[i] = (unsigned)(Rb * K + C) * 2u; }
    const size_t kstep = (size_t)(BK * 2);
    const size_t hstep = (size_t)HALF * K * 2;
    const size_t tstep = 2 * hstep;
    const unsigned ldsw = (unsigned)wid * 1024u;
    const int aoff = lds_byte(wr * 64 + fr, fq * 8), boff = lds_byte(wc * 32 + fr, fq * 8);
#define PG8_SA(b, h) (((b) * 2 + (h)) * HTB)
#define PG8_SB(b, h) ((4 + (b) * 2 + (h)) * HTB)
#define PG8_STAGE(bufoff, gbase, voff) do { _Pragma("unroll") for (int _i = 0; _i < 2; ++_i) \
        __builtin_amdgcn_global_load_lds((const unsigned*)((const char*)(gbase) + (voff)[_i]), (PG8_LAS unsigned*)(lds + (bufoff) + ldsw + _i * 8192), 16, 0, 0); } while (0)
#define PG8_LDA(dst, b, h) do { _Pragma("unroll") for (int m = 0; m < 4; ++m) _Pragma("unroll") for (int k = 0; k < 2; ++k) dst[m][k] = *(const PG8_LAS bf16x8*)(lds + PG8_SA(b, h) + aoff + m * 2048 + k * 1024); } while (0)
#define PG8_LDB(dst, b, h) do { _Pragma("unroll") for (int n = 0; n < 2; ++n) _Pragma("unroll") for (int k = 0; k < 2; ++k) dst[n][k] = *(const PG8_LAS bf16x8*)(lds + PG8_SB(b, h) + boff + n * 2048 + k * 1024); } while (0)
#define PG8_MMA(ai, bj, At, Bt) do { __builtin_amdgcn_s_setprio(1); _Pragma("unroll") for (int m = 0; m < 4; ++m) _Pragma("unroll") for (int n = 0; n < 2; ++n) _Pragma("unroll") for (int k = 0; k < 2; ++k) \
        acc[ai][bj][m][n] = __builtin_amdgcn_mfma_f32_16x16x32_bf16(Bt[n][k], At[m][k], acc[ai][bj][m][n], 0, 0, 0); __builtin_amdgcn_s_setprio(0); } while (0)
#define PG8_WAIT_V(n) asm volatile("s_waitcnt vmcnt(" #n ")" ::: "memory")
#define PG8_WAIT_L(n) asm volatile("s_waitcnt lgkmcnt(" #n ")" ::: "memory")
#define PG8_BAR __builtin_amdgcn_s_barrier()
#define PG8_SCHED __builtin_amdgcn_sched_barrier(0)
    Unit cur, nxt; int ui = 0;
    if (!S.next(0, cur)) return;
    f32x4 acc[2][2][4][2];
#pragma unroll
    for (int a = 0; a < 2; ++a)
#pragma unroll
        for (int b = 0; b < 2; ++b)
#pragma unroll
            for (int m = 0; m < 4; ++m)
#pragma unroll
                for (int n = 0; n < 2; ++n) acc[a][b][m][n] = (f32x4){0.f, 0.f, 0.f, 0.f};
    bf16x8 At[4][2], B0[2][2], B1[2][2];
    const char* cA = (const char*)g.A + (size_t)cur.pm * tstep; const char* cB = (const char*)g.Bt + (size_t)cur.pn * tstep;
    S.a_ready(cur);
    if constexpr (SP2) {
        PG8_STAGE(PG8_SB(0, 0), cB, voffB); PG8_STAGE(PG8_SB(0, 1), cB + hstep, voffB); PG8_STAGE(PG8_SA(0, 0), cA, voffA); PG8_STAGE(PG8_SA(0, 1), cA + hstep, voffA);
        if (wr == 1) PG8_BAR;
        PG8_WAIT_V(2); PG8_BAR;
        PG8_STAGE(PG8_SB(1, 0), cB + kstep, voffB); PG8_STAGE(PG8_SA(1, 0), cA + kstep, voffA); PG8_STAGE(PG8_SB(1, 1), cB + hstep + kstep, voffB);
        PG8_WAIT_V(6); PG8_BAR;
    } else {
        PG8_STAGE(PG8_SB(0, 0), cB, voffB); PG8_STAGE(PG8_SA(0, 0), cA, voffA); PG8_STAGE(PG8_SB(0, 1), cB + hstep, voffB); PG8_STAGE(PG8_SA(0, 1), cA + hstep, voffA);
        if (wr == 1) PG8_BAR;
        PG8_WAIT_V(4); PG8_BAR;
        PG8_STAGE(PG8_SB(1, 0), cB + kstep, voffB); PG8_STAGE(PG8_SA(1, 0), cA + kstep, voffA); PG8_STAGE(PG8_SB(1, 1), cB + hstep + kstep, voffB);
        PG8_WAIT_V(6); PG8_BAR;
    }
    for (;;) {
        const bool has_next = S.next(ui + 1, nxt);
        const char* nA = has_next ? (const char*)g.A + (size_t)nxt.pm * tstep : cA; const char* nB = has_next ? (const char*)g.Bt + (size_t)nxt.pn * tstep : cB;
        for (int t = 0; t < nt; t += 2) {
            const bool last = (t == nt - 2);
            const char* a1 = cA + (size_t)(t + 1) * kstep;
            const char* a2 = last ? nA : cA + (size_t)(t + 2) * kstep; const char* b2 = last ? nB : cB + (size_t)(t + 2) * kstep;
            const char* a3 = a2 + kstep; const char* b3 = b2 + kstep;
            if (last && has_next) S.a_ready(nxt);
            if constexpr (SP2) {
            PG8_LDB(B0, 0, 0); PG8_LDB(B1, 0, 1); PG8_SCHED; PG8_LDA(At, 0, 0); PG8_STAGE(PG8_SA(1, 1), a1 + hstep, voffA);
            PG8_WAIT_V(8); PG8_WAIT_L(0); PG8_BAR; PG8_MMA(0, 0, At, B0); PG8_MMA(0, 1, At, B1); PG8_BAR; PG8_SCHED;
            PG8_LDA(At, 0, 1); PG8_STAGE(PG8_SB(0, 0), b2, voffB); PG8_STAGE(PG8_SB(0, 1), b2 + hstep, voffB); PG8_STAGE(PG8_SA(0, 0), a2, voffA);
            PG8_WAIT_V(8); PG8_WAIT_L(0); PG8_BAR; PG8_MMA(1, 0, At, B0); PG8_MMA(1, 1, At, B1); PG8_BAR; PG8_SCHED;
            PG8_LDB(B0, 1, 0); PG8_LDB(B1, 1, 1); PG8_SCHED; PG8_LDA(At, 1, 0); PG8_STAGE(PG8_SA(0, 1), a2 + hstep, voffA);
            PG8_WAIT_V(8); PG8_WAIT_L(0); PG8_BAR; PG8_MMA(0, 0, At, B0); PG8_MMA(0, 1, At, B1); PG8_BAR; PG8_SCHED;
            PG8_LDA(At, 1, 1); PG8_STAGE(PG8_SB(1, 0), b3, voffB); PG8_STAGE(PG8_SB(1, 1), b3 + hstep, voffB); PG8_STAGE(PG8_SA(1, 0), a3, voffA);
            PG8_WAIT_V(8); PG8_WAIT_L(0); PG8_BAR; PG8_MMA(1, 0, At, B0); PG8_MMA(1, 1, At, B1); PG8_BAR; PG8_SCHED;
            } else {
            PG8_LDB(B0, 0, 0); PG8_SCHED; PG8_LDA(At, 0, 0); PG8_STAGE(PG8_SA(1, 1), a1 + hstep, voffA);
            PG8_WAIT_L(8); PG8_BAR; PG8_WAIT_L(0); PG8_MMA(0, 0, At, B0); PG8_BAR; PG8_SCHED;
            PG8_LDB(B1, 0, 1); PG8_STAGE(PG8_SB(0, 0), b2, voffB);
            PG8_BAR; PG8_WAIT_L(0); PG8_MMA(0, 1, At, B1); PG8_BAR;
            PG8_LDA(At, 0, 1); PG8_STAGE(PG8_SA(0, 0), a2, voffA);
            PG8_BAR; PG8_WAIT_L(0); PG8_MMA(1, 0, At, B0); PG8_BAR; PG8_SCHED;
            PG8_STAGE(PG8_SB(0, 1), b2 + hstep, voffB);
            PG8_WAIT_V(6); PG8_BAR; PG8_MMA(1, 1, At, B1); PG8_BAR;
            PG8_LDB(B0, 1, 0); PG8_SCHED; PG8_LDA(At, 1, 0); PG8_STAGE(PG8_SA(0, 1), a2 + hstep, voffA);
            PG8_WAIT_L(8); PG8_BAR; PG8_WAIT_L(0); PG8_MMA(0, 0, At, B0); PG8_BAR; PG8_SCHED;
            PG8_LDB(B1, 1, 1); PG8_STAGE(PG8_SB(1, 0), b3, voffB);
            PG8_BAR; PG8_WAIT_L(0); PG8_MMA(0, 1, At, B1); PG8_BAR;
            PG8_LDA(At, 1, 1); PG8_STAGE(PG8_SA(1, 0), a3, voffA);
            PG8_BAR; PG8_WAIT_L(0); PG8_MMA(1, 0, At, B0); PG8_BAR; PG8_SCHED;
            PG8_STAGE(PG8_SB(1, 1), b3 + hstep, voffB);
            PG8_WAIT_V(6); PG8_BAR; PG8_MMA(1, 1, At, B1); PG8_BAR;
            }
        }
        if constexpr (ALIGN_EPI) { if (wr == 0) PG8_BAR; }
        E(acc, cur, wr, wc, fr, fq); S.done(cur);
        if (!has_next) break;
        bool keep = false;
        if constexpr (Epi::CHAIN) keep = E.keep(cur);
        if (!keep) {
#pragma unroll
        for (int a = 0; a < 2; ++a)
#pragma unroll
            for (int b = 0; b < 2; ++b)
#pragma unroll
                for (int m = 0; m < 4; ++m)
#pragma unroll
                    for (int n = 0; n < 2; ++n) acc[a][b][m][n] = (f32x4){0.f, 0.f, 0.f, 0.f};
        }
        cur = nxt; cA = nA; cB = nB; ++ui;
        if constexpr (ALIGN_EPI) { if (wr == 1) PG8_BAR; }
    }
    PG8_WAIT_V(0);
    if constexpr (!ALIGN_EPI) { if (wr == 0) PG8_BAR; }
    PG8_BAR;
#undef PG8_SA
#undef PG8_SB
#undef PG8_STAGE
#undef PG8_LDA
#undef PG8_LDB
#undef PG8_MMA
#undef PG8_WAIT_V
#undef PG8_WAIT_L
#undef PG8_BAR
#undef PG8_SCHED
}
}
namespace mk {
using pg8::bf16_t; using pg8::f32x4; using pg8::u32x4; using pg8::Unit; using pg8::pack8; using pg8::unpack8;
constexpr int S = 8192, D = 2048, DEPTH = 4, DFF = 5632, DIN = 5696, MEMLEN = 256;
constexpr int NIN = 12032;
constexpr float LOG2E = 1.4426950408889634f;
constexpr float QS_DIFF = 0.125f * LOG2E, QS_MLA = 0.07216878364870323f * LOG2E, QS_128 = 0.08838834764831845f * LOG2E;

#define GA1 __attribute__((address_space(1)))
#define LA3 __attribute__((address_space(3)))
typedef float rss_t;
constexpr int RSS_LDS_OFF = 131072 + 1024;
__device__ __forceinline__ float rss_rstd(const rss_t* p  , float inv_n) {
    const f32x4 a = *(const GA1 f32x4*)p, b = *(const GA1 f32x4*)(p + 4);
    return rsqrtf((((a[0] + a[1]) + (a[2] + a[3])) + ((b[0] + b[1]) + (b[2] + b[3]))) * inv_n + 1e-6f);
}
typedef float f32x2e __attribute__((ext_vector_type(2)));
__device__ __forceinline__ float rss_rstd2(const rss_t* p  , float inv_n) { const f32x2e a = *(const GA1 f32x2e*)p; return rsqrtf((a[0] + a[1]) * inv_n + 1e-6f); }
__device__ __forceinline__ void rss_reduce_store(const float (&ssv)[2][4], int wr, int wc, int fr, int fq, LA3 unsigned char* ldsbase, rss_t* out, int stride) {
    LA3 float* P = (LA3 float*)(ldsbase + RSS_LDS_OFF);
    if (fq == 0) {
#pragma unroll
        for (int ai = 0; ai < 2; ++ai)
#pragma unroll
            for (int m = 0; m < 4; ++m) P[(ai * 128 + wr * 64 + m * 16 + fr) * 4 + wc] = ssv[ai][m]; }
    asm volatile("s_waitcnt lgkmcnt(0)" ::: "memory"); __builtin_amdgcn_s_barrier(); asm volatile("" ::: "memory");
    const int t = (wr * 4 + wc) * 64 + fq * 16 + fr;
    if (t < 256) { const LA3 f32x4* pr = (const LA3 f32x4*)(P + t * 4); const f32x4 v = *pr; ((GA1 rss_t*)out)[(size_t)t * stride] = (v[0] + v[1]) + (v[2] + v[3]); }
}
__device__ __forceinline__ void rstd_cached(const rss_t* rss  , int pm, int tag, LA3 unsigned char* ldsb, int wr, int wc, int fr, int fq, float (&rsv)[2][4]) {
    LA3 float* T = (LA3 float*)(ldsb + RSS_LDS_OFF + 4096); volatile LA3 int* TAG = (volatile LA3 int*)(ldsb + RSS_LDS_OFF + 4096 + 1024);
    const int t = (wr * 4 + wc) * 64 + fq * 16 + fr;
    if (__builtin_amdgcn_readfirstlane(*TAG) != tag) {
        if (t < 256) T[t] = rss_rstd(rss + (size_t)(pm * 256 + t) * 8, 1.f / D);
        asm volatile("s_waitcnt lgkmcnt(0)" ::: "memory"); __builtin_amdgcn_s_barrier(); asm volatile("" ::: "memory");
        if (t == 0) *TAG = tag;
    }
#pragma unroll
    for (int ai = 0; ai < 2; ++ai)
#pragma unroll
        for (int m = 0; m < 4; ++m) rsv[ai][m] = T[ai * 128 + wr * 64 + m * 16 + fr];
}
__device__ __forceinline__ float fast_sigmoid(float x) { return __builtin_amdgcn_rcpf(1.f + __builtin_amdgcn_exp2f(-x * LOG2E)); }


struct EpiSwiglu {
    static constexpr bool PERM = true, CHAIN = false;
    bf16_t* HID; const rss_t* rss; LA3 unsigned char* ldsb; int tag0;
    __device__ __forceinline__ void operator()(f32x4 (&acc)[2][2][4][2], const Unit& u, int wr, int wc, int fr, int fq) const {
        const int row0 = u.pm * 256 + wr * 64 + fr, col = u.pn * 128 + wc * 32 + 8 * fq;
        float rsv[2][4]; rstd_cached(rss, u.pm, tag0 + u.pm, ldsb, wr, wc, fr, fq, rsv);
#pragma unroll
        for (int ai = 0; ai < 2; ++ai)
#pragma unroll
            for (int m = 0; m < 4; ++m) {
                const float rs = rsv[ai][m];
                f32x4 h0, h1;
#pragma unroll
                for (int j = 0; j < 4; ++j) { const float g0 = acc[ai][0][m][0][j] * rs, g1 = acc[ai][0][m][1][j] * rs;
                    h0[j] = g0 * fast_sigmoid(g0) * (acc[ai][1][m][0][j] * rs); h1[j] = g1 * fast_sigmoid(g1) * (acc[ai][1][m][1][j] * rs); }
                *(GA1 u32x4*)(HID + (size_t)(row0 + ai * 128 + m * 16) * DFF + col) = pack8(h0, h1);
            }
    }
};
typedef _Float16 h16x8 __attribute__((ext_vector_type(8)));
typedef float f32x8e __attribute__((ext_vector_type(8)));
struct EpiResid {
    static constexpr bool PERM = true, CHAIN = false;
    _Float16* h16; bf16_t* an; float alpha; bool stats; rss_t* rss; LA3 unsigned char* ldsb;
    __device__ __forceinline__ void operator()(f32x4 (&acc)[2][2][4][2], const Unit& u, int wr, int wc, int fr, int fq) const {
        const int row0 = u.pm * 256 + wr * 64 + fr, col0 = u.pn * 256 + wc * 32 + 8 * fq;
        float ssv[2][4];
#pragma unroll
        for (int ai = 0; ai < 2; ++ai) {
            h16x8 hb[4][2];
#pragma unroll
            for (int m = 0; m < 4; ++m)
#pragma unroll
                for (int bj = 0; bj < 2; ++bj) hb[m][bj] = *(const GA1 h16x8*)(h16 + (size_t)(row0 + ai * 128 + m * 16) * D + col0 + bj * 128);
#pragma unroll
            for (int m = 0; m < 4; ++m) { const int row = row0 + ai * 128 + m * 16; float ss = 0.f;
#pragma unroll
                for (int bj = 0; bj < 2; ++bj) { const f32x8e hf = __builtin_convertvector(hb[m][bj], f32x8e);
                    f32x4 h0 = {hf[0], hf[1], hf[2], hf[3]}, h1 = {hf[4], hf[5], hf[6], hf[7]};
                    h0 = h0 + acc[ai][bj][m][0] * alpha; h1 = h1 + acc[ai][bj][m][1] * alpha;
                    ss += (h0[0] * h0[0] + h0[1] * h0[1]) + (h0[2] * h0[2] + h0[3] * h0[3]) + (h1[0] * h1[0] + h1[1] * h1[1]) + (h1[2] * h1[2] + h1[3] * h1[3]);
                    const f32x8e hn = {h0[0], h0[1], h0[2], h0[3], h1[0], h1[1], h1[2], h1[3]};
                    *(GA1 h16x8*)(h16 + (size_t)row * D + col0 + bj * 128) = __builtin_convertvector(hn, h16x8);
                    *(GA1 u32x4*)(an + (size_t)row * D + col0 + bj * 128) = pack8(h0, h1); }
                ss += __shfl_xor(ss, 16); ss += __shfl_xor(ss, 32); ssv[ai][m] = ss; }
        }
        if (stats) rss_reduce_store(ssv, wr, wc, fr, fq, ldsb, rss + (size_t)u.pm * 256 * 8 + u.pn, 8);
    }
};
struct EpiPlain {
    static constexpr bool PERM = true, CHAIN = false;
    bf16_t* O; int ldc; int npp; const rss_t* rss; LA3 unsigned char* ldsb; int tag0; float osc = 1.f;
    __device__ __forceinline__ void operator()(f32x4 (&acc)[2][2][4][2], const Unit& u, int wr, int wc, int fr, int fq) const {
        const int row0 = u.pm * 256 + wr * 64 + fr, col0 = (u.pn - u.pm * npp) * 256 + wc * 32 + 8 * fq;
        float rsv[2][4];
        if (rss) rstd_cached(rss, u.pm, tag0 + u.pm, ldsb, wr, wc, fr, fq, rsv);
        else {
#pragma unroll
            for (int ai = 0; ai < 2; ++ai)
#pragma unroll
                for (int m = 0; m < 4; ++m) rsv[ai][m] = 1.f; }
#pragma unroll
        for (int ai = 0; ai < 2; ++ai)
#pragma unroll
            for (int m = 0; m < 4; ++m) { const int row = row0 + ai * 128 + m * 16; bf16_t* rp = O + (size_t)row * ldc + col0;
                const float rs = rsv[ai][m] * osc;
#pragma unroll
                for (int bj = 0; bj < 2; ++bj) *(GA1 u32x4*)(rp + bj * 128) = pack8(acc[ai][bj][m][0] * rs, acc[ai][bj][m][1] * rs); }
    }
};
__device__ __forceinline__ void rope8_apply(f32x4& v0, f32x4& v1, const f32x4 t0, const f32x4 t1) {
    const f32x4 c = {t0[0], t0[2], t1[0], t1[2]}, s = {t0[1], t0[3], t1[1], t1[3]};
    const f32x4 y1 = v0 * c - v1 * s, y2 = v1 * c + v0 * s; v0 = y1; v1 = y2;
}
__device__ __forceinline__ void rope8(f32x4& v0, f32x4& v1, const float2* cs) { rope8_apply(v0, v1, *(const GA1 f32x4*)cs, *(const GA1 f32x4*)(cs + 2)); }
struct EpiIn {
    static constexpr bool PERM = true, CHAIN = false;
    bf16_t *QD, *KD, *VD, *CQR, *CKVR, *QG, *KG, *VG, *KM, *GATE; const float2 *cs64, *cs128; const float* bg; const rss_t* rss; rss_t* rssm; LA3 unsigned char* ldsb; int tag0;
    __device__ __forceinline__ void operator()(f32x4 (&acc)[2][2][4][2], const Unit& u, int wr, int wc, int fr, int fq) const {
        const int pn = u.pn, row0 = u.pm * 256 + wr * 64 + fr, c8 = wc * 32 + 8 * fq;
        int kind, ld, colt; bf16_t* base;
        if (pn < 4)        { kind = 1; base = QD;   ld = 1024; colt = 256 * pn; }
        else if (pn < 8)   { kind = 1; base = KD;   ld = 1024; colt = 256 * (pn - 4); }
        else if (pn < 12)  { kind = 0; base = VD;   ld = 1024; colt = 256 * (pn - 8); }
        else if (pn < 14)  { kind = 0; base = CQR;  ld = 512;  colt = 256 * (pn - 12); }
        else if (pn < 16)  { kind = 0; base = CKVR; ld = 512;  colt = 256 * (pn - 14); }
        else if (pn < 20)  { kind = 2; base = QG;   ld = 1024; colt = 256 * (pn - 16); }
        else if (pn == 20) { kind = 2; base = KG;   ld = 256;  colt = 0; }
        else if (pn == 21) { kind = 0; base = VG;   ld = 256;  colt = 0; }
        else if (pn == 22) { kind = 4; base = KM;   ld = 1536; colt = 0; }
        else               { kind = 3; base = GATE; ld = 6144; colt = 256 * (pn - 23); }
        float rsv[2][4]; rstd_cached(rss, u.pm, tag0 + u.pm, ldsb, wr, wc, fr, fq, rsv);
        if (pn >= 12 && pn < 16) {
            float ssv[2][4];
#pragma unroll
            for (int ai = 0; ai < 2; ++ai)
#pragma unroll
                for (int m = 0; m < 4; ++m) { const int row = row0 + ai * 128 + m * 16; const float rs = rsv[ai][m]; float ss = 0.f;
#pragma unroll
                    for (int bj = 0; bj < 2; ++bj) { const f32x4 v0 = acc[ai][bj][m][0] * rs, v1 = acc[ai][bj][m][1] * rs;
                        ss += (v0[0] * v0[0] + v0[1] * v0[1]) + (v0[2] * v0[2] + v0[3] * v0[3]) + (v1[0] * v1[0] + v1[1] * v1[1]) + (v1[2] * v1[2] + v1[3] * v1[3]);
                        *(GA1 u32x4*)(base + (size_t)row * ld + colt + bj * 128 + c8) = pack8(v0, v1); }
                    ss += __shfl_xor(ss, 16); ss += __shfl_xor(ss, 32); ssv[ai][m] = ss; }
            if (rssm) rss_reduce_store(ssv, wr, wc, fr, fq, ldsb, rssm + ((size_t)(pn >= 14 ? S : 0) + (size_t)u.pm * 256) * 2 + (pn & 1), 2);
            return;
        }
        if (kind == 1 || kind == 2) {
            const float2* cs = (kind == 1 ? cs64 + (size_t)row0 * 32 : cs128 + (size_t)row0 * 64) + (((colt + c8) & (kind == 1 ? 63 : 127)) >> 3) * 4;
            const int rstr = kind == 1 ? 32 : 64;
            const float qs = pn < 4 ? QS_DIFF : (pn >= 16 && pn < 20) ? QS_128 : 1.f;
#pragma unroll
            for (int ai = 0; ai < 2; ++ai) {
                f32x4 tb[4][2];
#pragma unroll
                for (int m = 0; m < 4; ++m) { const float2* p = cs + (size_t)(ai * 128 + m * 16) * rstr; tb[m][0] = *(const GA1 f32x4*)p; tb[m][1] = *(const GA1 f32x4*)(p + 2); }
#pragma unroll
                for (int m = 0; m < 4; ++m) { const int row = row0 + ai * 128 + m * 16; const float rs = rsv[ai][m] * qs;
#pragma unroll
                    for (int bj = 0; bj < 2; ++bj) { f32x4 v0 = acc[ai][bj][m][0] * rs, v1 = acc[ai][bj][m][1] * rs; rope8_apply(v0, v1, tb[m][0], tb[m][1]);
                        *(GA1 u32x4*)(base + (size_t)row * ld + colt + bj * 128 + c8) = pack8(v0, v1); } }
            }
        } else if (kind == 0) {
#pragma unroll
            for (int ai = 0; ai < 2; ++ai)
#pragma unroll
                for (int m = 0; m < 4; ++m) { const int row = row0 + ai * 128 + m * 16; const float rs = rsv[ai][m];
#pragma unroll
                    for (int bj = 0; bj < 2; ++bj) *(GA1 u32x4*)(base + (size_t)row * ld + colt + bj * 128 + c8) = pack8(acc[ai][bj][m][0] * rs, acc[ai][bj][m][1] * rs); }
        } else if (kind == 4) {
            if (wc < 2) {
                const float2* cs = cs64 + (size_t)row0 * 32 + (c8 >> 3) * 4;
#pragma unroll
                for (int ai = 0; ai < 2; ++ai) {
                    f32x4 tb[4][2];
#pragma unroll
                    for (int m = 0; m < 4; ++m) { const float2* p = cs + (size_t)(ai * 128 + m * 16) * 32; tb[m][0] = *(const GA1 f32x4*)p; tb[m][1] = *(const GA1 f32x4*)(p + 2); }
#pragma unroll
                    for (int m = 0; m < 4; ++m) { const int row = row0 + ai * 128 + m * 16; const float rs = rsv[ai][m];
                        f32x4 v0 = acc[ai][0][m][0] * rs, v1 = acc[ai][0][m][1] * rs; rope8_apply(v0, v1, tb[m][0], tb[m][1]); const u32x4 w = pack8(v0, v1);
#pragma unroll
                        for (int h = 0; h < 8; ++h) *(GA1 u32x4*)(KM + (size_t)row * 1536 + h * 192 + 128 + c8) = w; }
                }
            }
        } else {
            f32x4 bv[2][2];
#pragma unroll
            for (int bj = 0; bj < 2; ++bj) { bv[bj][0] = *(const GA1 f32x4*)(bg + colt + bj * 128 + c8); bv[bj][1] = *(const GA1 f32x4*)(bg + colt + bj * 128 + c8 + 4); }
#pragma unroll
            for (int ai = 0; ai < 2; ++ai)
#pragma unroll
                for (int m = 0; m < 4; ++m) { const int row = row0 + ai * 128 + m * 16; const float rs = rsv[ai][m];
#pragma unroll
                    for (int bj = 0; bj < 2; ++bj) { f32x4 v0 = acc[ai][bj][m][0] * rs + bv[bj][0], v1 = acc[ai][bj][m][1] * rs + bv[bj][1];
#pragma unroll
                        for (int j = 0; j < 4; ++j) { v0[j] = fmaxf(fast_sigmoid(v0[j]), 1e-20f); v1[j] = fmaxf(fast_sigmoid(v1[j]), 1e-20f); }
                        *(GA1 u32x4*)(base + (size_t)row * ld + colt + bj * 128 + c8) = pack8(v0, v1); } }
        }
    }
};
struct EpiGate {
    static constexpr bool PERM = true, CHAIN = false;
    bf16_t* GATE; const float* bg; const rss_t* rss; LA3 unsigned char* ldsb; int tag0;
    __device__ __forceinline__ void operator()(f32x4 (&acc)[2][2][4][2], const Unit& u, int wr, int wc, int fr, int fq) const {
        const int row0 = u.pm * 256 + wr * 64 + fr, col0 = u.pn * 256 + wc * 32 + 8 * fq;
        float rsv[2][4]; rstd_cached(rss, u.pm, tag0 + u.pm, ldsb, wr, wc, fr, fq, rsv);
        f32x4 bv[2][2];
#pragma unroll
        for (int bj = 0; bj < 2; ++bj) { bv[bj][0] = *(const GA1 f32x4*)(bg + col0 + bj * 128); bv[bj][1] = *(const GA1 f32x4*)(bg + col0 + bj * 128 + 4); }
#pragma unroll
        for (int ai = 0; ai < 2; ++ai)
#pragma unroll
            for (int m = 0; m < 4; ++m) { const int row = row0 + ai * 128 + m * 16; const float rs = rsv[ai][m];
#pragma unroll
                for (int bj = 0; bj < 2; ++bj) { f32x4 v0 = acc[ai][bj][m][0] * rs + bv[bj][0], v1 = acc[ai][bj][m][1] * rs + bv[bj][1];
#pragma unroll
                    for (int j = 0; j < 4; ++j) { v0[j] = fmaxf(fast_sigmoid(v0[j]), 1e-20f); v1[j] = fmaxf(fast_sigmoid(v1[j]), 1e-20f); }
                    *(GA1 u32x4*)(GATE + (size_t)row * 6144 + col0 + bj * 128) = pack8(v0, v1); } }
    }
};
struct EpiMlaUp {
    static constexpr bool PERM = true, CHAIN = false;
    bf16_t *QM, *KM, *VM; const float2* cs64; const rss_t* rssm;
    __device__ __forceinline__ void operator()(f32x4 (&acc)[2][2][4][2], const Unit& u, int wr, int wc, int fr, int fq) const {
        const int c8 = wc * 32 + 8 * fq;
        if (u.pm < 32) {
            const int row0 = u.pm * 256 + wr * 64 + fr;
            float rsv[2][4]; f32x2e pr[2][4];
#pragma unroll
            for (int ai = 0; ai < 2; ++ai)
#pragma unroll
                for (int m = 0; m < 4; ++m) pr[ai][m] = *(const GA1 f32x2e*)(rssm + (size_t)(row0 + ai * 128 + m * 16) * 2);
#pragma unroll
            for (int ai = 0; ai < 2; ++ai)
#pragma unroll
                for (int m = 0; m < 4; ++m) rsv[ai][m] = rsqrtf((pr[ai][m][0] + pr[ai][m][1]) * (1.f / 512.f) + 1e-6f);
#pragma unroll
            for (int bj = 0; bj < 2; ++bj) { const int col = u.pn * 256 + bj * 128 + c8, p = col % 192; const bool rp = p >= 128; const int a = rp ? ((p - 128) >> 3) : 0;
#pragma unroll
                for (int ai = 0; ai < 2; ++ai) {
                    f32x4 tb[4][2];
#pragma unroll
                    for (int m = 0; m < 4; ++m) { const float2* cs = cs64 + (size_t)(row0 + ai * 128 + m * 16) * 32 + a * 4; tb[m][0] = *(const GA1 f32x4*)cs; tb[m][1] = *(const GA1 f32x4*)(cs + 2); }
#pragma unroll
                    for (int m = 0; m < 4; ++m) { const int row = row0 + ai * 128 + m * 16; const float rs = rsv[ai][m] * QS_MLA; f32x4 v0 = acc[ai][bj][m][0] * rs, v1 = acc[ai][bj][m][1] * rs;
                        if (rp) rope8_apply(v0, v1, tb[m][0], tb[m][1]);
                        *(GA1 u32x4*)(QM + (size_t)row * 1536 + col) = pack8(v0, v1); } } }
        } else {
            const int row0 = (u.pm - 32) * 256 + wr * 64 + fr, h = u.pn - 6;
            float rsv[2][4]; f32x2e pr[2][4];
#pragma unroll
            for (int ai = 0; ai < 2; ++ai)
#pragma unroll
                for (int m = 0; m < 4; ++m) pr[ai][m] = *(const GA1 f32x2e*)(rssm + (size_t)(S + row0 + ai * 128 + m * 16) * 2);
#pragma unroll
            for (int ai = 0; ai < 2; ++ai)
#pragma unroll
                for (int m = 0; m < 4; ++m) rsv[ai][m] = rsqrtf((pr[ai][m][0] + pr[ai][m][1]) * (1.f / 512.f) + 1e-6f);
#pragma unroll
            for (int ai = 0; ai < 2; ++ai)
#pragma unroll
                for (int m = 0; m < 4; ++m) { const int row = row0 + ai * 128 + m * 16; const float rs = rsv[ai][m];
                    *(GA1 u32x4*)(KM + (size_t)row * 1536 + h * 192 + c8) = pack8(acc[ai][0][m][0] * rs, acc[ai][0][m][1] * rs);
                    *(GA1 u32x4*)(VM + (size_t)row * 1024 + h * 128 + c8) = pack8(acc[ai][1][m][0] * rs, acc[ai][1][m][1] * rs); }
        }
    }
};
struct EpiBranch {
    static constexpr bool PERM = true, CHAIN = true;
    const bf16_t* GATE; bf16_t* MG;
    __device__ __forceinline__ bool keep(const Unit& u) const { return (u.pm >> 5) < 2; }
    __device__ __forceinline__ void operator()(f32x4 (&acc)[2][2][4][2], const Unit& u, int wr, int wc, int fr, int fq) const {
        const int n = u.pm >> 5, row0 = (u.pm & 31) * 256 + wr * 64 + fr, col0 = (u.pn - 8 * n) * 256 + wc * 32 + 8 * fq;
        const GA1 u32x4* gp = (const GA1 u32x4*)(GATE + (size_t)row0 * 6144 + n * 2048 + col0);
        if (n < 2) {
#pragma unroll
            for (int ai = 0; ai < 2; ++ai) {
                u32x4 a[4][2], b[4][2];
#pragma unroll
                for (int m = 0; m < 4; ++m)
#pragma unroll
                    for (int bj = 0; bj < 2; ++bj) { const GA1 u32x4* p = gp + (size_t)(ai * 128 + m * 16) * 768 + bj * 16; a[m][bj] = p[0]; b[m][bj] = p[256]; }
#pragma unroll
                for (int m = 0; m < 4; ++m)
#pragma unroll
                    for (int bj = 0; bj < 2; ++bj) { f32x4 g0, g1, h0, h1; unpack8(a[m][bj], g0, g1); unpack8(b[m][bj], h0, h1);
#pragma unroll
                        for (int j = 0; j < 4; ++j) { acc[ai][bj][m][0][j] *= g0[j] * __builtin_amdgcn_rcpf(h0[j]); acc[ai][bj][m][1][j] *= g1[j] * __builtin_amdgcn_rcpf(h1[j]); } }
            }
        } else {
            GA1 u32x4* op = (GA1 u32x4*)(MG + (size_t)row0 * D + col0);
#pragma unroll
            for (int ai = 0; ai < 2; ++ai) {
                u32x4 a[4][2];
#pragma unroll
                for (int m = 0; m < 4; ++m)
#pragma unroll
                    for (int bj = 0; bj < 2; ++bj) a[m][bj] = gp[(size_t)(ai * 128 + m * 16) * 768 + bj * 16];
#pragma unroll
                for (int m = 0; m < 4; ++m)
#pragma unroll
                    for (int bj = 0; bj < 2; ++bj) { f32x4 g0, g1; unpack8(a[m][bj], g0, g1); op[(size_t)(ai * 128 + m * 16) * 256 + bj * 16] = pack8(acc[ai][bj][m][0] * g0, acc[ai][bj][m][1] * g1); }
            }
        }
    }
};

struct MlaOrder {
    int G, c;
    __device__ bool next(int i, Unit& u) const { const int L = i * G + c; if (L < 192) { u.pm = L & 31; u.pn = L >> 5; return true; } if (L < 448) { const int l2 = L - 192; u.pm = 32 + (l2 & 31); u.pn = 6 + (l2 >> 5); return true; } return false; }
    __device__ __forceinline__ void a_ready(const Unit&) const {}
    __device__ __forceinline__ void done(const Unit&) const {}
};
struct BranchOrder {
    pg8::StaticOrder so;
    __device__ bool next(int i, Unit& u) const { const int t = i / 3, n = i - 3 * t; if (!so.map(t * so.G + so.c, u)) return false; u.pm += 32 * n; u.pn += 8 * n; return true; }
    __device__ __forceinline__ void a_ready(const Unit&) const {}
    __device__ __forceinline__ void done(const Unit&) const {}
};
struct KvxOrder {
    int G, c;
    __device__ bool next(int i, Unit& u) const { const int L = i * G + c; if (L >= 16) return false; u.pm = L >> 2; u.pn = L; return true; }
    __device__ __forceinline__ void a_ready(const Unit&) const {}
    __device__ __forceinline__ void done(const Unit&) const {}
};
}
namespace at {
typedef unsigned short bf16;
using bf16x8 = __attribute__((ext_vector_type(8))) short;
using s16x4  = __attribute__((ext_vector_type(4))) short;
using f32x16 = __attribute__((ext_vector_type(16))) float;
using u32x4  = __attribute__((ext_vector_type(4))) unsigned;
typedef const __attribute__((address_space(1))) bf16x8* gp8;
constexpr int KVBLK = 64, SHM_V = KVBLK * 128 * 2;
constexpr float THR = 8.f;
#define AT_SBAR() __builtin_amdgcn_sched_barrier(0)
#ifndef AT_GRP
#define AT_GRP 0
#endif
#ifndef AT_PRIO
#define AT_PRIO 0
#endif
#ifndef AT_QPIPE
#define AT_QPIPE 0
#endif
#ifndef AT_VPIPE
#define AT_VPIPE 1
#endif
__device__ __forceinline__ int crow(int r, int hi) { return (r & 3) + 8 * (r >> 2) + 4 * hi; }
__device__ __forceinline__ unsigned cvtpk(float lo, float hi) { unsigned r; asm volatile("v_cvt_pk_bf16_f32 %0, %1, %2" : "=v"(r) : "v"(lo), "v"(hi)); return r; }

template <bool WIN>
__device__ __forceinline__ void partialSM(f32x16& p0, f32x16& p1, float& m_reg, float& msh, f32x16& negm, float& alpha, float thr, int krel, int hi) {
  if (WIN) {
#pragma unroll
    for (int r = 0; r < 16; ++r) { const int d0 = krel + crow(r, hi), d1 = d0 + 32;
      if (d0 > 128 || d0 < -128) p0[r] = -1e30f; if (d1 > 128 || d1 < -128) p1[r] = -1e30f; }
  }
  float pmax = p0[0];
#pragma unroll
  for (int r = 1; r < 16; ++r) pmax = fmaxf(pmax, p0[r]);
#pragma unroll
  for (int r = 0; r < 16; ++r) pmax = fmaxf(pmax, p1[r]);
  { auto rr = __builtin_amdgcn_permlane32_swap(__float_as_uint(pmax), __float_as_uint(pmax), false, false);
    pmax = fmaxf(__uint_as_float(rr[0]), __uint_as_float(rr[1])); }
  const float pt = pmax + msh;
  if (__builtin_expect(__all(pt - m_reg <= thr), 1)) alpha = 1.f;
  else { const float mn = fmaxf(m_reg, pt); alpha = __builtin_amdgcn_exp2f(m_reg - mn); m_reg = mn; const float d = mn - msh; msh = mn;
#pragma unroll
    for (int r = 0; r < 16; ++r) { p0[r] -= d; p1[r] -= d; negm[r] = -mn; } }
#pragma unroll
  for (int r = 0; r < 16; ++r) p0[r] = __builtin_amdgcn_exp2f(p0[r]);
}
__device__ __forceinline__ void finishSM(f32x16& p0, f32x16& p1, float alpha, float& l_reg, bf16x8& pa0, bf16x8& pa1, bf16x8& pa2, bf16x8& pa3) {
#pragma unroll
  for (int r = 0; r < 16; ++r) p1[r] = __builtin_amdgcn_exp2f(p1[r]);
  float ps = 0;
#pragma unroll
  for (int r = 0; r < 16; ++r) ps += p0[r];
#pragma unroll
  for (int r = 0; r < 16; ++r) ps += p1[r];
  { auto rr = __builtin_amdgcn_permlane32_swap(__float_as_uint(ps), __float_as_uint(ps), false, false);
    ps = __uint_as_float(rr[0]) + __uint_as_float(rr[1]); }
  l_reg = l_reg * alpha + ps;
#define AT_PK4(P, BASE, OUT) do { unsigned a0 = cvtpk(P[BASE + 0], P[BASE + 1]), a1 = cvtpk(P[BASE + 2], P[BASE + 3]);   \
    unsigned b0 = cvtpk(P[BASE + 4], P[BASE + 5]), b1 = cvtpk(P[BASE + 6], P[BASE + 7]);                              \
    auto r0 = __builtin_amdgcn_permlane32_swap(a0, b0, false, false); auto r1 = __builtin_amdgcn_permlane32_swap(a1, b1, false, false); \
    u32x4 w = {r0[0], r1[0], r0[1], r1[1]}; OUT = *reinterpret_cast<bf16x8*>(&w); } while (0)
  AT_PK4(p0, 0, pa0); AT_PK4(p0, 8, pa1); AT_PK4(p1, 0, pa2); AT_PK4(p1, 8, pa3);
#undef AT_PK4
}
template <int DQK> __device__ __forceinline__ int kswz_x(int row) { return DQK == 128 ? (row & 15) : ((row >> 1) & 7); }
template <int DQK> __device__ __forceinline__ int kswz(int row, int colB) { return row * (DQK * 2) + (colB ^ (kswz_x<DQK>(row) << 4)); }
template <int DQK, int QL, int GRP>
__device__ __forceinline__ void qkt(f32x16& p0, f32x16& p1, const f32x16& ini  , int ks  , const int (&kb)[8], const bf16x8* qr, int qa, int r32, int hi) {
  typedef const __attribute__((address_space(3))) bf16x8* lp;
  p0 = ini; p1 = ini;
  if (QL > 0) asm volatile("" : "+v"(qa));
#if AT_QPIPE
  const int ka0 = DQK == 128 ? kb[0] : kb[0];
  bf16x8 b0 = *(lp)(uintptr_t)(unsigned)(ks + ka0), b1 = *(lp)(uintptr_t)(unsigned)(ks + ka0 + 32 * DQK * 2);
#pragma unroll
  for (int d0 = 0; d0 < DQK / 16; ++d0) {
    bf16x8 n0 = b0, n1 = b1;
    if (d0 + 1 < DQK / 16) { const int g = (d0 + 1) >> 2, e = (d0 + 1) & 3; const int ka = DQK == 128 ? kb[e + 4 * g] : kb[e] + g * 128;
      n0 = *(lp)(uintptr_t)(unsigned)(ks + ka); n1 = *(lp)(uintptr_t)(unsigned)(ks + ka + 32 * DQK * 2); }
    bf16x8 q;
    if (d0 < DQK / 16 - QL) q = qr[d0]; else q = *(lp)(uintptr_t)(unsigned)(qa + (d0 - (DQK / 16 - QL)) * 1024);
    AT_SBAR();
    if (AT_PRIO) __builtin_amdgcn_s_setprio(1);
    p0 = __builtin_amdgcn_mfma_f32_32x32x16_bf16(b0, q, p0, 0, 0, 0);
    p1 = __builtin_amdgcn_mfma_f32_32x32x16_bf16(b1, q, p1, 0, 0, 0);
    if (AT_PRIO) __builtin_amdgcn_s_setprio(0);
    AT_SBAR();
    b0 = n0; b1 = n1; }
#else
#pragma unroll
  for (int d0 = 0; d0 < DQK / 16; ++d0) { const int g = d0 >> 2, e = d0 & 3;
    const int ka = DQK == 128 ? kb[e + 4 * g] : kb[e] + g * 128;
    const bf16x8 b0 = *(lp)(uintptr_t)(unsigned)(ks + ka);
    const bf16x8 b1 = *(lp)(uintptr_t)(unsigned)(ks + ka + 32 * DQK * 2);
    bf16x8 q;
    if (d0 < DQK / 16 - QL) q = qr[d0]; else q = *(lp)(uintptr_t)(unsigned)(qa + (d0 - (DQK / 16 - QL)) * 1024);
    p0 = __builtin_amdgcn_mfma_f32_32x32x16_bf16(b0, q, p0, 0, 0, 0);
    p1 = __builtin_amdgcn_mfma_f32_32x32x16_bf16(b1, q, p1, 0, 0, 0);
    if (GRP > 0 && (d0 % (GRP > 0 ? GRP : 1)) == (GRP > 0 ? GRP : 1) - 1) AT_SBAR(); }
#endif
}
__device__ __forceinline__ int v_st(int k, int c) { const int kk = (k & ~0xC) | ((k & 4) << 1) | ((k & 8) >> 1); return ((kk >> 3) * 4 + (c >> 5)) * 512 + ((kk & 7) * 32 + (c & 31)) * 2; }
__device__ __forceinline__ int v_rd_base(int lane) { return ((lane & 3) << 3) | (((lane >> 2) & 3) << 6) | (((lane >> 4) & 1) << 5) | (((lane >> 5) & 1) << 8); }
constexpr int v_rd_off(int d0, int ks, int half) { return d0 * 512 + ks * 4096 + half * 2048; }
template <int OFF> __device__ __forceinline__ s16x4 tr_read(int vb) {
  s16x4 r; asm volatile("ds_read_b64_tr_b16 %0, %1 offset:%2" : "=&v"(r) : "v"(vb), "i"(OFF) : "memory"); return r;
}
struct VFrag { s16x4 l0, h0, l1, h1, l2, h2, l3, h3; };
template <int D0> __device__ __forceinline__ void pv_load(VFrag& f, int vb) {
  f.l0 = tr_read<v_rd_off(D0, 0, 0)>(vb); f.h0 = tr_read<v_rd_off(D0, 0, 1)>(vb); f.l1 = tr_read<v_rd_off(D0, 1, 0)>(vb); f.h1 = tr_read<v_rd_off(D0, 1, 1)>(vb);
  f.l2 = tr_read<v_rd_off(D0, 2, 0)>(vb); f.h2 = tr_read<v_rd_off(D0, 2, 1)>(vb); f.l3 = tr_read<v_rd_off(D0, 3, 0)>(vb); f.h3 = tr_read<v_rd_off(D0, 3, 1)>(vb);
}
#define AT_PK(L, H) (bf16x8){L[0], L[1], L[2], L[3], H[0], H[1], H[2], H[3]}
__device__ __forceinline__ void pv_mma(f32x16& od, const VFrag& f, bf16x8 pa0, bf16x8 pa1, bf16x8 pa2, bf16x8 pa3) {
  if (AT_PRIO) __builtin_amdgcn_s_setprio(1);
  od = __builtin_amdgcn_mfma_f32_32x32x16_bf16(pa0, AT_PK(f.l0, f.h0), od, 0, 0, 0);
  od = __builtin_amdgcn_mfma_f32_32x32x16_bf16(pa1, AT_PK(f.l1, f.h1), od, 0, 0, 0);
  od = __builtin_amdgcn_mfma_f32_32x32x16_bf16(pa2, AT_PK(f.l2, f.h2), od, 0, 0, 0);
  od = __builtin_amdgcn_mfma_f32_32x32x16_bf16(pa3, AT_PK(f.l3, f.h3), od, 0, 0, 0);
  if (AT_PRIO) __builtin_amdgcn_s_setprio(0);
}
template <int D0> __device__ __forceinline__ void pv_one(f32x16& od, int vb, bf16x8 pa0, bf16x8 pa1, bf16x8 pa2, bf16x8 pa3) {
  VFrag f; pv_load<D0>(f, vb);
  asm volatile("s_waitcnt lgkmcnt(0)" ::: "memory"); AT_SBAR();
  pv_mma(od, f, pa0, pa1, pa2, pa3);
}
__device__ __forceinline__ void pv_d0(f32x16* o, int vb, bf16x8 pa0, bf16x8 pa1, bf16x8 pa2, bf16x8 pa3) {
#if AT_VPIPE == 2
  VFrag fa, fb, fc;
  pv_load<0>(fa, vb); pv_load<1>(fb, vb); pv_load<2>(fc, vb);
  asm volatile("s_waitcnt lgkmcnt(15)" ::: "memory"); AT_SBAR();
  pv_mma(o[0], fa, pa0, pa1, pa2, pa3); AT_SBAR();
  pv_load<3>(fa, vb);
  asm volatile("s_waitcnt lgkmcnt(15)" ::: "memory"); asm volatile("s_waitcnt lgkmcnt(15)" ::: "memory"); AT_SBAR();
  pv_mma(o[1], fb, pa0, pa1, pa2, pa3); AT_SBAR();
  asm volatile("s_waitcnt lgkmcnt(8)" ::: "memory"); AT_SBAR();
  pv_mma(o[2], fc, pa0, pa1, pa2, pa3); AT_SBAR();
  asm volatile("s_waitcnt lgkmcnt(0)" ::: "memory"); AT_SBAR();
  pv_mma(o[3], fa, pa0, pa1, pa2, pa3);
#elif AT_VPIPE
  VFrag fa, fb;
  pv_load<0>(fa, vb); pv_load<1>(fb, vb);
  asm volatile("s_waitcnt lgkmcnt(8)" ::: "memory"); AT_SBAR();
  pv_mma(o[0], fa, pa0, pa1, pa2, pa3); AT_SBAR();
  pv_load<2>(fa, vb);
  asm volatile("s_waitcnt lgkmcnt(8)" ::: "memory"); AT_SBAR();
  pv_mma(o[1], fb, pa0, pa1, pa2, pa3); AT_SBAR();
  pv_load<3>(fb, vb);
  asm volatile("s_waitcnt lgkmcnt(8)" ::: "memory"); AT_SBAR();
  pv_mma(o[2], fa, pa0, pa1, pa2, pa3); AT_SBAR();
  asm volatile("s_waitcnt lgkmcnt(0)" ::: "memory"); AT_SBAR();
  pv_mma(o[3], fb, pa0, pa1, pa2, pa3);
#else
  pv_one<0>(o[0], vb, pa0, pa1, pa2, pa3); pv_one<1>(o[1], vb, pa0, pa1, pa2, pa3); pv_one<2>(o[2], vb, pa0, pa1, pa2, pa3); pv_one<3>(o[3], vb, pa0, pa1, pa2, pa3);
#endif
}
#undef AT_PK

template <int DQK, bool WIN>
__device__ __forceinline__ void attn_core1(const bf16* __restrict__ Qb, int ldq, const bf16* __restrict__ Kh, int ldk, const bf16* __restrict__ Vh, int ldv,
                                           int NT, float thr, float m_init, float l_init, int qrel0, char* lds, f32x16 (&o)[4], float (&rli)[16]) {
  constexpr int SHM_K = KVBLK * DQK * 2, CPR = DQK / 8, NKC = DQK / 64;
  int tid = threadIdx.x; asm volatile("" : "+v"(tid));
  const int wid = tid >> 6, lane = tid & 63, r32 = lane & 31, hi = lane >> 5;
  char* V_lds = lds; char* K_lds = lds + 2 * SHM_V;
  float* ws = (float*)(lds + 2 * SHM_V + 2 * SHM_K) + wid * 64; float* li_l = ws; float* al_l = ws + 32;
  float m_reg = m_init, l_reg = l_init, msh = m_init > -1e29f ? m_init : 0.f; bf16x8 qr[DQK / 16];
  f32x16 negm;
#pragma unroll
  for (int r = 0; r < 16; ++r) negm[r] = -msh;
#pragma unroll
  for (int d = 0; d < 4; ++d) o[d] = f32x16{};
  const bf16* Qw = Qb + (long)(wid * 32 + r32) * ldq + hi * 8;
#pragma unroll
  for (int d0 = 0; d0 < DQK / 16; ++d0) qr[d0] = *(gp8)(Qw + d0 * 16);
  const int qme = qrel0 + wid * 32 + r32;
  const int sr = tid >> 4, sc = (tid & 15) * 8, vst0 = v_st(sr, sc), vst1 = v_st(32 + sr, sc);
  const unsigned vgo0 = (unsigned)(sr * ldv + sc) * 2u, vgo1 = vgo0 + 64u * (unsigned)ldv;
  unsigned kgo[NKC]; int klo[NKC];
#pragma unroll
  for (int i = 0; i < NKC; ++i) { const int id = tid + 512 * i, row = id / CPR, ch = id % CPR; kgo[i] = (unsigned)(row * ldk + ch * 8) * 2u; klo[i] = kswz<DQK>(row, ch * 16); }
  const int vb0 = (int)(uintptr_t)V_lds + v_rd_base(lane);
  const int ksa = (int)(uintptr_t)K_lds; int kb[8];
#pragma unroll
  for (int e = 0; e < 8; ++e) kb[e] = (DQK == 128 || e < 4) ? kswz<DQK>(r32, ((((e & 3) << 1) | hi) + 8 * (e >> 2)) << 4) : 0;
  bf16x8 vs0, vs1, ks[NKC];
#define A1_LOAD(k0) do { const char* vb_ = (const char*)Vh + (size_t)(k0) * (size_t)ldv * 2; const char* kb_ = (const char*)Kh + (size_t)(k0) * (size_t)ldk * 2; \
    vs0 = *(gp8)(vb_ + vgo0); vs1 = *(gp8)(vb_ + vgo1); \
    _Pragma("unroll") for (int _c = 0; _c < NKC; ++_c) ks[_c] = *(gp8)(kb_ + kgo[_c]); } while (0)
#define A1_WRITE(b) do { *(bf16x8*)(V_lds + (b) * SHM_V + vst0) = vs0; *(bf16x8*)(V_lds + (b) * SHM_V + vst1) = vs1; \
    _Pragma("unroll") for (int _c = 0; _c < NKC; ++_c) *(bf16x8*)(K_lds + (b) * SHM_K + klo[_c]) = ks[_c]; } while (0)
  __syncthreads();
  A1_LOAD(0); A1_WRITE(0);
  if (NT > 1) A1_LOAD(KVBLK);
  __syncthreads();
  for (int j = 0; j < NT; ++j) {
    const int b = j & 1;
    f32x16 p0, p1; float al; bf16x8 pa0, pa1, pa2, pa3;
    qkt<DQK, 0, AT_GRP>(p0, p1, negm, ksa + b * SHM_K, kb, qr, 0, r32, hi);
    partialSM<WIN>(p0, p1, m_reg, msh, negm, al, thr, j * KVBLK - qme, hi);
    if (__any(al < 1.f)) { if (hi == 0) al_l[r32] = al; asm volatile("s_waitcnt lgkmcnt(0)" ::: "memory");
#pragma unroll
      for (int d = 0; d < 4; ++d)
#pragma unroll
        for (int r = 0; r < 16; ++r) o[d][r] *= al_l[crow(r, hi)]; }
    finishSM(p0, p1, al, l_reg, pa0, pa1, pa2, pa3);
    if (j + 1 < NT) { A1_WRITE(b ^ 1); if (j + 2 < NT) A1_LOAD((j + 2) * KVBLK); }
    AT_SBAR();
    pv_d0(o, vb0 + b * SHM_V, pa0, pa1, pa2, pa3);
    __syncthreads();
  }
  if (hi == 0) li_l[r32] = l_reg; asm volatile("s_waitcnt lgkmcnt(0)" ::: "memory");
#pragma unroll
  for (int r = 0; r < 16; ++r) rli[r] = __builtin_amdgcn_rcpf(li_l[crow(r, hi)]);
#undef A1_LOAD
#undef A1_WRITE
}
__device__ __forceinline__ void store_o(bf16* Ob, int ldo, const f32x16 (&o)[4], const float (&rli)[16]) {
  int tid = threadIdx.x; asm volatile("" : "+v"(tid));
  const int wid = tid >> 6, lane = tid & 63, r32 = lane & 31, hi = lane >> 5;
  bf16* Ow = Ob + (long)(wid * 32) * ldo + r32;
#pragma unroll
  for (int r = 0; r < 16; ++r) { const int orow = crow(r, hi);
#pragma unroll
    for (int d0 = 0; d0 < 4; ++d0) ((__attribute__((address_space(1))) bf16*)Ow)[(long)orow * ldo + d0 * 32] = (bf16)(cvtpk(o[d0][r] * rli[r], 0.f) & 0xffffu); }
}
}
namespace mk {
#define GAS __attribute__((address_space(1)))
#define LAS __attribute__((address_space(3)))
constexpr size_t MiB = 1u << 20;
constexpr size_t al256(size_t x) { return (x + 255) & ~(size_t)255; }
constexpr size_t WS_CTL = 0, CTL_ZERO_BYTES = 1 * MiB;
constexpr size_t WS_PART = WS_CTL + CTL_ZERO_BYTES;
constexpr size_t WS_PARTM = WS_PART + (size_t)20 * S * 8 * 4;
constexpr size_t WS_CS64 = WS_PARTM + (size_t)4 * 2 * S * 2 * 4;
constexpr size_t WS_CS128 = WS_CS64 + (size_t)S * 32 * 8;
constexpr size_t WS_H = WS_CS128 + (size_t)S * 64 * 8;
constexpr size_t WS_AN = WS_H + (size_t)S * D * 4;
constexpr size_t WS_HID = WS_AN + (size_t)S * D * 2;
constexpr size_t WS_QD = WS_HID + (size_t)S * DFF * 2;
constexpr size_t WS_KD = WS_QD + (size_t)S * 1024 * 2, WS_VD = WS_KD + (size_t)S * 1024 * 2;
constexpr size_t WS_CQR = WS_VD + (size_t)S * 1024 * 2, WS_CKVR = WS_CQR + (size_t)S * 512 * 2;
constexpr size_t WS_ACQ = WS_CKVR + (size_t)S * 512 * 2;
constexpr size_t WS_QG = WS_ACQ + (size_t)2 * S * 512 * 2, WS_KG = WS_QG + (size_t)S * 1024 * 2, WS_VG = WS_KG + (size_t)S * 256 * 2;
constexpr size_t WS_QM = WS_VG + (size_t)S * 256 * 2, WS_KM = WS_QM + (size_t)S * 1536 * 2, WS_VM = WS_KM + (size_t)S * 1536 * 2;
constexpr size_t WS_GATE = WS_VM + (size_t)S * 1024 * 2;
constexpr size_t WS_OB = WS_GATE + (size_t)S * 6144 * 2;
constexpr size_t WS_MG = WS_OB + (size_t)3 * S * 1024 * 2;
constexpr size_t WS_ATMP = WS_MG + (size_t)S * D * 2;
constexpr size_t WS_QX = WS_ATMP + (size_t)256 * 64 * 512 * 4, WS_OX = WS_QX + (size_t)S * 512 * 2;
constexpr size_t WS_MEMN = WS_OX + (size_t)S * 512 * 2;
constexpr size_t WS_KVX = WS_MEMN + (size_t)4 * 256 * D * 2;
constexpr size_t WS_WXKV = WS_KVX + (size_t)4 * 256 * 1024 * 2;
constexpr size_t WS_LW = WS_WXKV + (size_t)4 * 1024 * D * 2;
constexpr size_t LW_GU1 = 0, LW_DN1 = LW_GU1 + (size_t)2 * DFF * D, LW_IN = LW_DN1 + (size_t)D * DFF, LW_UQKV = LW_IN + (size_t)NIN * D, LW_BR = LW_UQKV + (size_t)(1536 + 2048) * 512,
                 LW_WO = LW_BR + (size_t)3 * D * 1024, LW_XQ = LW_WO + (size_t)D * D, LW_XO = LW_XQ + (size_t)512 * D, LW_GU2 = LW_XO + (size_t)D * 512, LW_DN2 = LW_GU2 + (size_t)2 * DFF * D,
                 LW_ELEMS = LW_DN2 + (size_t)D * DFF;
constexpr size_t WS_END = WS_LW + 4 * LW_ELEMS * 2;
constexpr int CW_BAR = 4096;
constexpr int RING_BYTES = 131072, MISC_OFF = RING_BYTES + 320, LDS_BYTES = 147456;
constexpr int NWAVES = 8;

typedef unsigned v4u __attribute__((ext_vector_type(4)));
#define LDS_WAIT() asm volatile("s_waitcnt lgkmcnt(0)" ::: "memory")
__device__ __forceinline__ unsigned f2bf(float f) { unsigned u = __builtin_bit_cast(unsigned, f); return (u + 0x7fffu + ((u >> 16) & 1u)) >> 16; }
__device__ __forceinline__ unsigned pk2(float lo, float hi) { return f2bf(lo) | (f2bf(hi) << 16); }
__device__ __forceinline__ float wave_sum(float v) {
#pragma unroll
    for (int o = 1; o < 64; o <<= 1) v += __shfl_xor(v, o);
    return v;
}

#define XB_TMO      128
#define XB_XCNT(j)  (256  + 64 * (j))
#define XB_XSUB(j)  (1280 + 64 * (j))
#define XB_XGEN(j)  (2304 + 64 * (j))
#define XB_TOP      3328
#define XB_TOPGEN   3392
#define XCD_BAR_WORDS 3456
#define XB_SPIN_CAP (1u << 18)
__device__ __forceinline__ unsigned xb_ld(unsigned* p)              { return __hip_atomic_load(p, __ATOMIC_RELAXED, __HIP_MEMORY_SCOPE_AGENT); }
__device__ __forceinline__ unsigned xb_add(unsigned* p, unsigned v) { return __hip_atomic_fetch_add(p, v, __ATOMIC_RELAXED, __HIP_MEMORY_SCOPE_AGENT); }
__device__ __forceinline__ unsigned xb_xcc_id() { return (unsigned)__builtin_amdgcn_s_getreg((3 << 11) | 20) & 0xFu; }
#define XB_SPIN(cond, bar) do { unsigned _sp = 0; while (cond) { __builtin_amdgcn_s_sleep(1); \
    if ((++_sp & 255u) == 0u) { if (xb_ld(&(bar)[XB_TMO])) break; if (_sp > XB_SPIN_CAP) { atomicAdd(&(bar)[XB_TMO], 1u); break; } } } } while (0)
struct XcdBarrier { unsigned* bar; unsigned x; volatile LAS unsigned* st; };
__device__ __forceinline__ XcdBarrier xcd_barrier_post(unsigned* bar, volatile LAS unsigned* st) {
    XcdBarrier b; b.bar = bar; b.x = xb_xcc_id(); b.st = st;
    if (threadIdx.x == 0) (void)xb_add(&bar[XB_XCNT(b.x)], 1u);
    return b;
}
__device__ __forceinline__ void xcd_barrier_complete(unsigned* bar, unsigned x, unsigned& nloc, unsigned& nx) {
    const unsigned G = gridDim.x * gridDim.y * gridDim.z;
    unsigned sum, cnt, mine, sp = 0u;
    for (;;) {
        sum = 0u; cnt = 0u; mine = 0u;
#pragma unroll
        for (unsigned j = 0; j < 16; ++j) { const unsigned c = xb_ld(&bar[XB_XCNT(j)]); sum += c; cnt += (c > 0u) ? 1u : 0u; mine = (j == x) ? c : mine; }
        if (sum == G) break;
        __builtin_amdgcn_s_sleep(1);
        if ((++sp & 255u) == 0u) { if (xb_ld(&bar[XB_TMO])) break; if (sp > XB_SPIN_CAP) { atomicAdd(&bar[XB_TMO], 1u); break; } }
    }
    nloc = mine > 0u ? mine : 1u; nx = cnt > 0u ? cnt : 1u;
}
__device__ __forceinline__ void xcd_barrier(const XcdBarrier& b) {
    asm volatile("s_waitcnt vmcnt(0)" ::: "memory");
    __syncthreads();
    if (threadIdx.x == 0) {
        unsigned* bar = b.bar; asm volatile("" : "+s"(bar));
        __builtin_amdgcn_s_waitcnt(0);
        unsigned nloc = b.st[0], nx = b.st[1];
        if (nloc == 0u) { xcd_barrier_complete(bar, b.x, nloc, nx); b.st[0] = nloc; b.st[1] = nx; }
        const unsigned old = xb_add(&bar[XB_XSUB(b.x)], 1u);
        const unsigned gen = old / nloc;
        if (old + 1u == (gen + 1u) * nloc) {
            __builtin_amdgcn_fence(__ATOMIC_RELEASE, "agent");
            asm volatile("s_waitcnt vmcnt(0)" ::: "memory");
            const unsigned og = xb_add(&bar[XB_TOP], 1u);
            const unsigned tg = og / nx;
            if (og + 1u == (tg + 1u) * nx) xb_add(&bar[XB_TOPGEN], 1u);
            else XB_SPIN(xb_ld(&bar[XB_TOPGEN]) == tg, bar);
            __builtin_amdgcn_fence(__ATOMIC_ACQUIRE, "agent");
            xb_add(&bar[XB_XGEN(b.x)], 1u);
            asm volatile("s_waitcnt vmcnt(0)" ::: "memory");
        } else {
            XB_SPIN(xb_ld(&bar[XB_XGEN(b.x)]) == gen, bar);
            __builtin_amdgcn_fence(__ATOMIC_ACQUIRE, "agent");
            asm volatile("s_waitcnt vmcnt(0)" ::: "memory");
        }
    }
    __syncthreads();
}

struct Args { const void* in[28]; float* out; unsigned char* ws; int ph_lo, ph_hi; };

__device__ __forceinline__ int perm64(int p) { const int a = p >> 3, j = p & 7; return j < 4 ? 4 * a + j : 32 + 4 * a + (j - 4); }
__device__ __forceinline__ int perm128(int p) { const int a = p >> 3, j = p & 7; return j < 4 ? 4 * a + j : 64 + 4 * a + (j - 4); }
__device__ __forceinline__ int srccol(int kind, int n) {
    if (kind == 0) return n;
    if (kind == 1) { const int pn = n >> 8, j = n & 255; return j < 128 ? pn * 128 + j : DFF + pn * 128 + (j - 128); }
    if (kind == 2) {
        if (n < 2048) return (n & ~63) + perm64(n & 63);
        if (n < 4096) return n;
        if (n < 5376) { const int m = n - 4096; return 4160 + (m & ~127) + perm128(m & 127); }
        if (n < 5632) return 5440 + (n - 5376);
        const int j = n - 5632; return j < 64 ? 4096 + perm64(j) : -1;
    }
    { const int h = n / 192, p = n - 192 * h; return p < 128 ? n : h * 192 + 128 + perm64(p - 128); }
}
__device__ __forceinline__ void cvt_matrix(const float* W, int ldw, int K, int Nd, bf16_t* WT, int kind, const float* gain, LAS float* scr, int gw, int NGW, int lane, int f0 = 0, int f1 = 16) {
    const int nblk = Nd / 32, nitems = (K / 64) * nblk, items = (int)((long)nitems * f1 / 16), item0 = (int)((long)nitems * f0 / 16);
    const int l8 = lane & 7, r8 = lane >> 3;
    f32x4 v[8]; float gv[8];
    int it = item0 + gw;
#define CVT_LOAD(item) do { const int kb_ = (item) / nblk, nb_ = (item) - kb_ * nblk; const int sc_ = srccol(kind, 32 * nb_ + 4 * l8); \
        const float* wp_ = W + (size_t)(64 * kb_ + r8) * ldw + (sc_ >= 0 ? sc_ : 0); \
        _Pragma("unroll") for (int i = 0; i < 8; ++i) v[i] = __builtin_nontemporal_load((const GAS f32x4*)(wp_ + (size_t)(8 * i) * ldw)); \
        if (gain) { _Pragma("unroll") for (int i = 0; i < 8; ++i) gv[i] = ((const GAS float*)gain)[64 * kb_ + 8 * i + r8]; } else { _Pragma("unroll") for (int i = 0; i < 8; ++i) gv[i] = 1.f; } \
        if (sc_ < 0) { _Pragma("unroll") for (int i = 0; i < 8; ++i) gv[i] = 0.f; } } while (0)
    if (it < items) CVT_LOAD(it);
    while (it < items) {
        const int kb = it / nblk, nb = it - kb * nblk, k0 = 64 * kb, n0 = 32 * nb;
#pragma unroll
        for (int i = 0; i < 8; ++i) { const int kk = 8 * i + r8; const f32x4 x = v[i] * gv[i];
            LAS float* d = scr + kk * 33 + 4 * l8; d[0] = x[0]; d[1] = x[1]; d[2] = x[2]; d[3] = x[3]; }
        const int nit = it + NGW;
        if (nit < items) CVT_LOAD(nit);
        LDS_WAIT(); asm volatile("" ::: "memory");
#pragma unroll
        for (int j = 0; j < 4; ++j) { const int n = r8 + 8 * j; const LAS float* s = scr + (8 * l8) * 33 + n;
            v4u o; o.x = pg8::cvt_pk_bf16(s[0 * 33], s[1 * 33]); o.y = pg8::cvt_pk_bf16(s[2 * 33], s[3 * 33]); o.z = pg8::cvt_pk_bf16(s[4 * 33], s[5 * 33]); o.w = pg8::cvt_pk_bf16(s[6 * 33], s[7 * 33]);
            *(GAS v4u*)(WT + (size_t)(n0 + n) * K + k0 + 8 * l8) = o; }
        LDS_WAIT(); asm volatile("" ::: "memory");
        it = nit;
    }
#undef CVT_LOAD
}
__device__ __forceinline__ void norm_row_bf16(const float* xrow, const float* g, bf16_t* orow, int lane) {
    const f32x4* xr = (const f32x4*)xrow + lane; const f32x4* gr = (const f32x4*)g + lane;
    f32x4 v[8]; float s = 0.f;
#pragma unroll
    for (int j = 0; j < 8; ++j) { v[j] = xr[64 * j]; s += (v[j][0] * v[j][0] + v[j][1] * v[j][1]) + (v[j][2] * v[j][2] + v[j][3] * v[j][3]); }
    const float r = rsqrtf(wave_sum(s) * (1.f / D) + 1e-6f);
    unsigned long long* o8 = (unsigned long long*)orow + lane;
#pragma unroll
    for (int j = 0; j < 8; ++j) { const f32x4 gg = gr[64 * j]; o8[64 * j] = (unsigned long long)pk2(v[j][0] * r * gg[0], v[j][1] * r * gg[1]) | ((unsigned long long)pk2(v[j][2] * r * gg[2], v[j][3] * r * gg[3]) << 32); }
}
constexpr float C_DIFF = 0.125f * LOG2E, C_MLA = 0.07216878364870323f * LOG2E, C_128 = 0.08838834764831845f * LOG2E;
__device__ __forceinline__ void diff_unit(const bf16_t* QD, const bf16_t* KD, const bf16_t* VD, float* atmp, bf16_t* OB0, const float* subln, float lam, float one_m_li, int h, int qb, char* lds) {
    int tid = threadIdx.x; asm volatile("" : "+v"(tid));
    const int lane = tid & 63, r32 = lane & 31;
    at::f32x16 o[4]; float rli[16];
    f32x4* tp = (f32x4*)(atmp + ((size_t)blockIdx.x * 512 + tid) * 64);
    for (int c = 0; c < 2; ++c) {
        at::attn_core1<64, false>(QD + (size_t)qb * 256 * 1024 + (2 * h + c) * 64, 1024, KD + (2 * h + c) * 64, 1024, VD + h * 128, 1024, S / 64, at::THR * LOG2E, -1e30f, 0.f, 0, lds, o, rli);
        if (c == 0) {
#pragma unroll
            for (int d0 = 0; d0 < 4; ++d0)
#pragma unroll
                for (int r4 = 0; r4 < 4; ++r4) tp[d0 * 4 + r4] = (f32x4){o[d0][4 * r4] * rli[4 * r4], o[d0][4 * r4 + 1] * rli[4 * r4 + 1], o[d0][4 * r4 + 2] * rli[4 * r4 + 2], o[d0][4 * r4 + 3] * rli[4 * r4 + 3]};
        }
    }
    float ss[16];
#pragma unroll
    for (int r = 0; r < 16; ++r) ss[r] = 0.f;
#pragma unroll
    for (int d0 = 0; d0 < 4; ++d0) {
#pragma unroll
        for (int r4 = 0; r4 < 4; ++r4) { const f32x4 t = tp[d0 * 4 + r4];
#pragma unroll
            for (int j = 0; j < 4; ++j) { const int r = 4 * r4 + j; const float v = t[j] - lam * (o[d0][r] * rli[r]); o[d0][r] = v; ss[r] += v * v; } }
        asm volatile("" ::: "memory"); }
#pragma unroll
    for (int r = 0; r < 16; ++r) { float s = ss[r]; s += __shfl_xor(s, 1); s += __shfl_xor(s, 2); s += __shfl_xor(s, 4); s += __shfl_xor(s, 8); s += __shfl_xor(s, 16);
        rli[r] = rsqrtf(s * (1.f / 128.f) + 1e-5f) * one_m_li; }
#pragma unroll
    for (int d0 = 0; d0 < 4; ++d0) { const float g = subln[d0 * 32 + r32];
#pragma unroll
        for (int r = 0; r < 16; ++r) o[d0][r] *= g; }
    at::store_o(OB0 + (size_t)qb * 256 * 1024 + h * 128, 1024, o, rli);
}
__device__ __forceinline__ void mla_unit(const bf16_t* QM, const bf16_t* KM, const bf16_t* VM, bf16_t* OB1, int h, int qb, char* lds) {
    at::f32x16 o[4]; float rli[16];
    at::attn_core1<192, false>(QM + (size_t)qb * 256 * 1536 + h * 192, 1536, KM + h * 192, 1536, VM + h * 128, 1024, S / 64, at::THR * LOG2E, -1e30f, 0.f, 0, lds, o, rli);
    at::store_o(OB1 + (size_t)qb * 256 * 1024 + h * 128, 1024, o, rli);
}
__device__ __forceinline__ void gqa_unit(const bf16_t* QG, const bf16_t* KG, const bf16_t* VG, bf16_t* OB2, const float* sink, int h, int qb, char* lds) {
    at::f32x16 o[4]; float rli[16];
    int k0 = qb * 256 - 128; if (k0 < 0) k0 = 0; int k1 = qb * 256 + 384; if (k1 > S) k1 = S;
    const int kvh = h >> 2;
    at::attn_core1<128, true>(QG + (size_t)qb * 256 * 1024 + h * 128, 1024, KG + (size_t)k0 * 256 + kvh * 128, 256, VG + (size_t)k0 * 256 + kvh * 128, 256, (k1 - k0) / 64,
                             at::THR * LOG2E, sink[h] * LOG2E, 1.f, qb * 256 - k0, lds, o, rli);
    at::store_o(OB2 + (size_t)qb * 256 * 1024 + h * 128, 1024, o, rli);
}
__device__ __forceinline__ void xattn_unit(const bf16_t* QX, const bf16_t* KVX, bf16_t* OX, int h, int qb, char* lds) {
    at::f32x16 o[4]; float rli[16];
    at::attn_core1<128, false>(QX + (size_t)qb * 256 * 512 + h * 128, 512, KVX + h * 128, 1024, KVX + 512 + h * 128, 1024, MEMLEN / 64, at::THR * LOG2E, -1e30f, 0.f, 0, lds, o, rli);
    at::store_o(OX + (size_t)qb * 256 * 512 + h * 128, 512, o, rli);
}

constexpr int PH_PER_LAYER = 12, N_PHASES = 2 + DEPTH * PH_PER_LAYER + 1;

__device__ __forceinline__ unsigned char* ldptr(volatile LAS unsigned* PT, int i) {
    const unsigned lo = PT[2 * i], hi = PT[2 * i + 1];
    return (unsigned char*)(((unsigned long long)(unsigned)__builtin_amdgcn_readfirstlane((int)hi) << 32) | (unsigned)__builtin_amdgcn_readfirstlane((int)lo));
}
#define PIN(i) ((const float*)ldptr(PT, (i)))
#define WSP(T, off) ((T*)(ws + (off)))
#define PHASE_BEGIN() int tid = threadIdx.x; asm volatile("" : "+v"(tid)); const int lane = tid & 63, wave = __builtin_amdgcn_readfirstlane(tid >> 6), gw = bx * NWAVES + wave; \
    unsigned char* ws = ldptr(PT, 29); (void)lane; (void)gw; (void)ws

__device__ __forceinline__ void cvt_layer_part(volatile LAS unsigned* PT, unsigned char* ws, int l, int part, LAS float* scr, int gw, int NGW, int lane) {
    bf16_t* lw = WSP(bf16_t, WS_LW) + (size_t)l * LW_ELEMS;
    if (part == 0) cvt_matrix(PIN(4) + (size_t)l * D * 2 * DFF, 2 * DFF, D, 2 * DFF, lw + LW_GU1, 1, PIN(3) + (size_t)l * D, scr, gw, NGW, lane);
    if (part == 1) cvt_matrix(PIN(25) + (size_t)l * D * 2 * DFF, 2 * DFF, D, 2 * DFF, lw + LW_GU2, 1, PIN(24) + (size_t)l * D, scr, gw, NGW, lane);
    if (part == 2) {
        cvt_matrix(PIN(12) + (size_t)l * 512 * 1536, 1536, 512, 1536, lw + LW_UQKV, 3, PIN(10) + (size_t)l * 512, scr, gw, NGW, lane);
        cvt_matrix(PIN(13) + (size_t)l * 512 * 2048, 2048, 512, 2048, lw + LW_UQKV + (size_t)1536 * 512, 0, PIN(11) + (size_t)l * 512, scr, gw, NGW, lane);
        cvt_matrix(PIN(21) + (size_t)l * D * 512, 512, D, 512, lw + LW_XQ, 0, PIN(19) + (size_t)l * D, scr, gw, NGW, lane);
        cvt_matrix(PIN(23) + (size_t)l * 512 * D, D, 512, D, lw + LW_XO, 0, nullptr, scr, gw, NGW, lane);
        cvt_matrix(PIN(18) + (size_t)l * D * D, D, D, D, lw + LW_WO, 0, nullptr, scr, gw, NGW, lane);
        for (int n = 0; n < 3; ++n) cvt_matrix(PIN(15) + ((size_t)l * 3 + n) * 1024 * D, D, 1024, D, lw + LW_BR + (size_t)n * D * 1024, 0, nullptr, scr, gw, NGW, lane);
        cvt_matrix(PIN(5) + (size_t)l * DFF * D, D, DFF, D, lw + LW_DN1, 0, nullptr, scr, gw, NGW, lane);
    }
}
constexpr int NCVTD = 27;
__device__ __forceinline__ void cvt_desc_geom(int t, int& l, int& ty, int& f0, int& f1) {
    f0 = 0; f1 = 16;
    if (t < 14) { l = 0; ty = t; }
    else if (t < 23) { const int q = (t - 14) / 3, r = (t - 14) - 3 * q; l = 1 + q; ty = r == 0 ? 8 : r == 1 ? 9 : 13; }
    else { l = t - 23; ty = 14; }
}
__device__ __forceinline__ void cvt_desc_kn(int ty, int& K, int& Nd) {
    K = D; Nd = D;
    if (ty <= 1) Nd = 2 * DFF; else if (ty == 2) { K = 512; Nd = 1536; } else if (ty == 3) { K = 512; Nd = 2048; } else if (ty == 4) Nd = 512; else if (ty == 5) K = 512;
    else if (ty == 7 || ty == 13) K = DFF; else if (ty == 8) Nd = 5888; else if (ty == 9) Nd = 3 * D; else if (ty >= 10 && ty <= 12) K = 1024; else if (ty == 14) Nd = 1024;
}
__device__ __forceinline__ int cvt_desc_cnt(int t, int& item0) {
    int l, ty, f0, f1, K, Nd; cvt_desc_geom(t, l, ty, f0, f1); cvt_desc_kn(ty, K, Nd);
    const int nitems = (K / 64) * (Nd / 32); item0 = (int)((long)nitems * f0 / 16); return (int)((long)nitems * f1 / 16) - item0;
}
__device__ __forceinline__ unsigned long long ldptr_v(volatile LAS unsigned* PT, int i) { return ((unsigned long long)PT[2 * i + 1] << 32) | PT[2 * i]; }
__device__ __forceinline__ void cvt_desc_fill(int t, volatile LAS unsigned* PT, volatile LAS unsigned* DT) {
    int start = 0, dummy;
    for (int u = 0; u < t && u < NCVTD; ++u) start += cvt_desc_cnt(u, dummy);
    if (t == NCVTD) { DT[t * 12 + 11] = (unsigned)start; return; }
    int l, ty, f0, f1, K, Nd, item0; cvt_desc_geom(t, l, ty, f0, f1); cvt_desc_kn(ty, K, Nd); (void)cvt_desc_cnt(t, item0);
    int pw = 0, pg = -1, kind = 0, ldw = Nd; size_t wo = 0, go = (size_t)l * D, dst = 0;
    switch (ty) {
        case 0: pw = 4; wo = (size_t)l * D * 2 * DFF; pg = 3; kind = 1; dst = LW_GU1; break;
        case 1: pw = 25; wo = (size_t)l * D * 2 * DFF; pg = 24; kind = 1; dst = LW_GU2; break;
        case 2: pw = 12; wo = (size_t)l * 512 * 1536; pg = 10; go = (size_t)l * 512; kind = 3; dst = LW_UQKV; break;
        case 3: pw = 13; wo = (size_t)l * 512 * 2048; pg = 11; go = (size_t)l * 512; dst = LW_UQKV + (size_t)1536 * 512; break;
        case 4: pw = 21; wo = (size_t)l * D * 512; pg = 19; dst = LW_XQ; break;
        case 5: pw = 23; wo = (size_t)l * 512 * D; dst = LW_XO; break;
        case 6: pw = 18; wo = (size_t)l * D * D; dst = LW_WO; break;
        case 7: pw = 5; wo = (size_t)l * DFF * D; dst = LW_DN1; break;
        case 8: pw = 7; wo = (size_t)l * D * DIN; ldw = DIN; pg = 6; kind = 2; dst = LW_IN; break;
        case 9: pw = 16; wo = (size_t)l * D * 3 * D; pg = 6; dst = LW_IN + (size_t)5888 * D; break;
        case 10: case 11: case 12: pw = 15; wo = ((size_t)l * 3 + (ty - 10)) * 1024 * D; dst = LW_BR + (size_t)(ty - 10) * D * 1024; break;
        case 13: pw = 26; wo = (size_t)l * DFF * D; dst = LW_DN2; break;
        default: pw = 22; wo = (size_t)l * D * 1024; break;
    }
    const unsigned long long wsb = ldptr_v(PT, 29);
    const unsigned long long W = ldptr_v(PT, pw) + 4ull * wo, G_ = pg >= 0 ? ldptr_v(PT, pg) + 4ull * go : 0ull;
    const unsigned long long WT = ty == 14 ? wsb + WS_WXKV + 2ull * ((size_t)l * 1024 * D) : wsb + WS_LW + 2ull * ((size_t)l * LW_ELEMS + dst);
    volatile LAS unsigned* d = DT + t * 12;
    d[0] = (unsigned)W; d[1] = (unsigned)(W >> 32); d[2] = (unsigned)WT; d[3] = (unsigned)(WT >> 32); d[4] = (unsigned)G_; d[5] = (unsigned)(G_ >> 32);
    d[6] = (unsigned)ldw; d[7] = (unsigned)K; d[8] = (unsigned)(Nd / 32); d[9] = (unsigned)kind; d[10] = (unsigned)item0; d[11] = (unsigned)start;
}
template <int MODE = 0> __device__ __forceinline__ void cvt_flat(volatile LAS unsigned* DT, LAS float* scr, int gw, int NGW, int lane) {
#define DW(m_, j_) __builtin_amdgcn_readfirstlane((int)DT[(m_) * 12 + (j_)])
#define DP(m_, j_) (((unsigned long long)(unsigned)DW(m_, (j_) + 1) << 32) | (unsigned)DW(m_, j_))
    const int total = DW(NCVTD, 11);
    const int l8 = lane & 7, r8 = lane >> 3;
    f32x4 v[8]; float gv[8];
    int it = gw, m = 0;
    bf16_t* WTn = nullptr; int Kn = 0, k0n = 0, n0n = 0;
#define FLAT_LOAD(item) do { while ((item) >= DW(m + 1, 11)) ++m; \
        const int loc_ = (item) - DW(m, 11) + DW(m, 10), nblk_ = DW(m, 8), kind_ = DW(m, 9), ldw_ = DW(m, 6); \
        const int kb_ = loc_ / nblk_, nb_ = loc_ - kb_ * nblk_; const int sc_ = srccol(kind_, 32 * nb_ + 4 * l8); \
        const float* wp_ = (const float*)DP(m, 0) + (size_t)(64 * kb_ + r8) * ldw_ + (sc_ >= 0 ? sc_ : 0); \
        _Pragma("unroll") for (int i = 0; i < 8; ++i) { if (MODE == 2) { v[i] = (f32x4){0.f, 0.f, 0.f, 0.f}; asm volatile("" : "+v"(v[i]) : "v"(wp_)); } else v[i] = __builtin_nontemporal_load((const GAS f32x4*)(wp_ + (size_t)(8 * i) * ldw_)); } \
        const float* g_ = (const float*)DP(m, 4); \
        if (g_) { _Pragma("unroll") for (int i = 0; i < 8; ++i) gv[i] = ((const GAS float*)g_)[64 * kb_ + 8 * i + r8]; } else { _Pragma("unroll") for (int i = 0; i < 8; ++i) gv[i] = 1.f; } \
        if (sc_ < 0) { _Pragma("unroll") for (int i = 0; i < 8; ++i) gv[i] = 0.f; } \
        WTn = (bf16_t*)DP(m, 2); Kn = DW(m, 7); k0n = 64 * kb_; n0n = 32 * nb_; } while (0)
    if (it < total) FLAT_LOAD(it);
    while (it < total) {
        bf16_t* WT = WTn; const int K = Kn, k0 = k0n, n0 = n0n;
#pragma unroll
        for (int i = 0; i < 8; ++i) { const int kk = 8 * i + r8; const f32x4 x = v[i] * gv[i];
            LAS float* d = scr + kk * 33 + 4 * l8; d[0] = x[0]; d[1] = x[1]; d[2] = x[2]; d[3] = x[3]; }
        const int nit = it + NGW;
        if (nit < total) FLAT_LOAD(nit);
        LDS_WAIT(); asm volatile("" ::: "memory");
#pragma unroll
        for (int j = 0; j < 4; ++j) { const int n = r8 + 8 * j; const LAS float* s = scr + (8 * l8) * 33 + n;
            v4u o; o.x = pg8::cvt_pk_bf16(s[0 * 33], s[1 * 33]); o.y = pg8::cvt_pk_bf16(s[2 * 33], s[3 * 33]); o.z = pg8::cvt_pk_bf16(s[4 * 33], s[5 * 33]); o.w = pg8::cvt_pk_bf16(s[6 * 33], s[7 * 33]);
            if (MODE == 1) asm volatile("" :: "v"(o), "v"(WT + (size_t)(n0 + n) * K + k0 + 8 * l8)); else *(GAS v4u*)(WT + (size_t)(n0 + n) * K + k0 + 8 * l8) = o; }
        LDS_WAIT(); asm volatile("" ::: "memory");
        it = nit;
    }
#undef FLAT_LOAD
#undef DP
#undef DW
}
constexpr int CVT_WG = 16;
__device__ __forceinline__ bool in_rng(int k, int lo, int hi) { asm volatile("" : "+s"(k)); return lo <= k && k < hi; }
__global__ void __launch_bounds__(NWAVES * 64, 2) mega(Args args) {
    extern __shared__ __attribute__((aligned(16))) unsigned char lds_raw[];
    LAS unsigned char* lds = (LAS unsigned char*)lds_raw;
    volatile LAS unsigned* MISC = (volatile LAS unsigned*)(lds + MISC_OFF);
    volatile LAS unsigned* PT = (volatile LAS unsigned*)(lds + MISC_OFF + 256);
    const int G = gridDim.x, bx = blockIdx.x, NGW = G * NWAVES;
    for (int u = threadIdx.x; u < (LDS_BYTES - RING_BYTES) / 4; u += NWAVES * 64) ((LAS unsigned*)(lds + RING_BYTES))[u] = 0u;
    __syncthreads();
    if (threadIdx.x == 0) {
#define PT_SET(i, p) do { const unsigned long long v_ = (unsigned long long)(p); PT[2 * (i)] = (unsigned)v_; PT[2 * (i) + 1] = (unsigned)(v_ >> 32); } while (0)
        PT_SET(0, args.in[0]); PT_SET(1, args.in[1]); PT_SET(2, args.in[2]); PT_SET(3, args.in[3]); PT_SET(4, args.in[4]); PT_SET(5, args.in[5]); PT_SET(6, args.in[6]);
        PT_SET(7, args.in[7]); PT_SET(8, args.in[8]); PT_SET(9, args.in[9]); PT_SET(10, args.in[10]); PT_SET(11, args.in[11]); PT_SET(12, args.in[12]); PT_SET(13, args.in[13]);
        PT_SET(14, args.in[14]); PT_SET(15, args.in[15]); PT_SET(16, args.in[16]); PT_SET(17, args.in[17]); PT_SET(18, args.in[18]); PT_SET(19, args.in[19]); PT_SET(20, args.in[20]);
        PT_SET(21, args.in[21]); PT_SET(22, args.in[22]); PT_SET(23, args.in[23]); PT_SET(24, args.in[24]); PT_SET(25, args.in[25]); PT_SET(26, args.in[26]); PT_SET(27, args.in[27]);
        PT_SET(28, args.out); PT_SET(29, args.ws);
#undef PT_SET
    }
    __syncthreads();
#if MK_PER_PHASE
#define GRID_BAR() do { } while (0)
#else
    XcdBarrier bar = xcd_barrier_post((unsigned*)(args.ws + WS_CTL) + CW_BAR, MISC + 8);
#if MK_STAMP >= 0
    int nbar = 0; unsigned long long st0 = __builtin_amdgcn_s_memrealtime(), st1 = st0;
#define GRID_BAR() do { xcd_barrier(bar); if (nbar == MK_STAMP - 1) st0 = __builtin_amdgcn_s_memrealtime(); if (nbar == MK_STAMP) st1 = __builtin_amdgcn_s_memrealtime(); ++nbar; } while (0)
#else
#define GRID_BAR() xcd_barrier(bar)
#endif
#endif
    const int lo = args.ph_lo, hi = args.ph_hi;
#define IN(k) in_rng((k), lo, hi)
#define PH_ON(j) (MK_ONLY < 0 || MK_ONLY == (j))
#define BOTH(k) (IN(k) && IN((k) + 1))

    if (PH_ON(0) && IN(0)) {
        PHASE_BEGIN();
        LAS float* scr = (LAS float*)(lds + wave * 16384);
        bf16_t* WXKV = WSP(bf16_t, WS_WXKV); bf16_t* MEMN = WSP(bf16_t, WS_MEMN);
        { volatile LAS unsigned* DT = (volatile LAS unsigned*)(lds + RSS_LDS_OFF);
          if (tid <= NCVTD) cvt_desc_fill(tid, PT, DT);
          __syncthreads();
          if (MK_DUP == 101) cvt_flat<1>(DT, scr, gw, NGW, lane);
          if (MK_DUP == 102) cvt_flat<2>(DT, scr, gw, NGW, lane);
          for (int rep = 0; rep < (MK_DUP == 100 ? 2 : 1); ++rep) cvt_flat<0>(DT, scr, gw, NGW, lane);
          __syncthreads(); }
        for (int l = 0; l < DEPTH; ++l)
            for (int m = gw; m < MEMLEN; m += NGW) norm_row_bf16(PIN(1) + (size_t)m * D, PIN(20) + (size_t)l * D, MEMN + ((size_t)l * MEMLEN + m) * D, lane);
        { float2* CS64 = WSP(float2, WS_CS64); float2* CS128 = WSP(float2, WS_CS128); const int* pos = (const int*)PIN(2);
          for (int idx = bx * 512 + tid; idx < S * 96; idx += G * 512) {
            const int s = idx / 96, j = idx - 96 * s; const int dim = j < 32 ? 64 : 128, i = j < 32 ? j : j - 32;
            const float inv = powf(10000.0f, -((float)(2 * i) / (float)dim)); const float ang = (float)pos[s] * inv;
            const float2 v = make_float2(cosf(ang), sinf(ang));
            if (j < 32) CS64[s * 32 + i] = v; else CS128[s * 64 + i] = v; } }
        { const float* x = PIN(0); bf16_t* AN = WSP(bf16_t, WS_AN); _Float16* H16 = WSP(_Float16, WS_H); rss_t* RSS0 = (rss_t*)(ws + WS_PART);
          for (int m = gw; m < S; m += NGW) {
            const GAS f32x4* xr = (const GAS f32x4*)(x + (size_t)m * D) + lane; GAS unsigned long long* o8 = (GAS unsigned long long*)(AN + (size_t)m * D) + lane; float s = 0.f;
            typedef _Float16 h16x4 __attribute__((ext_vector_type(4))); GAS h16x4* h8 = (GAS h16x4*)(H16 + (size_t)m * D) + lane;
            f32x4 xv[8];
#pragma unroll
            for (int j = 0; j < 8; ++j) xv[j] = xr[64 * j];
#pragma unroll
            for (int j = 0; j < 8; ++j) { const f32x4 v = xv[j]; s += (v[0] * v[0] + v[1] * v[1]) + (v[2] * v[2] + v[3] * v[3]);
                o8[64 * j] = (unsigned long long)pg8::cvt_pk_bf16(v[0], v[1]) | ((unsigned long long)pg8::cvt_pk_bf16(v[2], v[3]) << 32); h8[64 * j] = __builtin_convertvector(v, h16x4); }
            s = wave_sum(s); if (lane < 8) RSS0[(size_t)m * 8 + lane] = lane == 0 ? s : 0.f; } }
        if (BOTH(0)) GRID_BAR();
    }
    for (int l = 0; l < DEPTH; ++l) {
        const int pb = 2 + l * PH_PER_LAYER;
        const float lambda_init = 0.8f - 0.6f * expf(-0.3f * (float)l);
#define NREP(j) ((MK_DUP == (j) && l == 0) ? 2 : 1)
#define LWP(off) (WSP(bf16_t, WS_LW) + (size_t)l * LW_ELEMS + (off))
#define RSSP(k) ((rss_t*)(ws + WS_PART) + (size_t)(4 * l + (k)) * S * 8)
#define RSSMP() ((rss_t*)(ws + WS_PARTM) + (size_t)l * 2 * S * 2)
        for (int rep = 0; rep < NREP(0); ++rep) if (PH_ON(2 + 0) && IN(pb + 0)) {
            PHASE_BEGIN();
            const int gg = (l + 1 < DEPTH && rep == 0) ? G - CVT_WG : G;
            if (bx >= gg) cvt_layer_part(PT, ws, l + 1, 0, (LAS float*)(lds + wave * 16384), (bx - gg) * NWAVES + wave, CVT_WG * NWAVES, lane);
            else {
            pg8::Gemm g{WSP(bf16_t, WS_AN), LWP(LW_GU1), S, 2 * DFF, D}; pg8::StaticOrder O; O.init(S, 2 * DFF, gg, bx); EpiSwiglu E{WSP(bf16_t, WS_HID), RSSP(0), lds, 64 * (4 * l + 0) + 1};
            pg8::gemm_phase<EpiSwiglu, pg8::StaticOrder>(lds, g, O, E);
            }
            if (BOTH(pb + 0)) GRID_BAR();
        }
        for (int rep = 0; rep < NREP(1); ++rep) if (PH_ON(2 + 1) && IN(pb + 1)) {
            PHASE_BEGIN();
            pg8::Gemm g{WSP(bf16_t, WS_HID), LWP(LW_DN1), S, D, DFF}; pg8::StaticOrder O; O.init(S, D, G, bx); EpiResid E{WSP(_Float16, WS_H), WSP(bf16_t, WS_AN), rep ? 0.f : 0.5f, rep == 0, RSSP(1), lds};
            pg8::gemm_phase<EpiResid, pg8::StaticOrder>(lds, g, O, E);
            if (BOTH(pb + 1)) GRID_BAR();
        }
        for (int rep = 0; rep < NREP(2); ++rep) if (PH_ON(2 + 2) && IN(pb + 2)) {
            PHASE_BEGIN();
#if MK_SPLIT_IN
            pg8::Gemm g{WSP(bf16_t, WS_AN), LWP(LW_IN), S, 5888, D}; pg8::StaticOrder O; O.init(S, 5888, G, bx);
#else
            pg8::Gemm g{WSP(bf16_t, WS_AN), LWP(LW_IN), S, NIN, D}; pg8::StaticOrder O; O.init(S, NIN, G, bx);
#endif
            EpiIn E{WSP(bf16_t, WS_QD), WSP(bf16_t, WS_KD), WSP(bf16_t, WS_VD), WSP(bf16_t, WS_CQR), WSP(bf16_t, WS_CKVR), WSP(bf16_t, WS_QG), WSP(bf16_t, WS_KG), WSP(bf16_t, WS_VG), WSP(bf16_t, WS_KM),
                    WSP(bf16_t, WS_GATE), WSP(float2, WS_CS64), WSP(float2, WS_CS128), PIN(17) + (size_t)l * 3 * D, RSSP(1), rep ? (rss_t*)nullptr : RSSMP(), lds, 64 * (4 * l + 1) + 1};
            pg8::gemm_phase<EpiIn, pg8::StaticOrder>(lds, g, O, E);
#if MK_SPLIT_IN
            { pg8::Gemm g2{WSP(bf16_t, WS_AN), LWP(LW_IN) + (size_t)5888 * D, S, 3 * D, D}; pg8::StaticOrder O2; O2.init(S, 3 * D, G, bx); EpiGate E2{WSP(bf16_t, WS_GATE), PIN(17) + (size_t)l * 3 * D, RSSP(1), lds, 64 * (4 * l + 1) + 1};
              pg8::gemm_phase<EpiGate, pg8::StaticOrder>(lds, g2, O2, E2); }
#endif
            if (BOTH(pb + 2)) GRID_BAR();
        }
        for (int rep = 0; rep < NREP(3); ++rep) if (PH_ON(2 + 3) && IN(pb + 3)) {
            PHASE_BEGIN();
            pg8::Gemm g{WSP(bf16_t, WS_CQR), LWP(LW_UQKV), 2 * S, 1536 + 2048, 512}; MlaOrder O{G, bx}; EpiMlaUp E{WSP(bf16_t, WS_QM), WSP(bf16_t, WS_KM), WSP(bf16_t, WS_VM), WSP(float2, WS_CS64), RSSMP()};
            pg8::gemm_phase<EpiMlaUp, MlaOrder>(lds, g, O, E);
            if (BOTH(pb + 3)) GRID_BAR();
        }
        for (int rep = 0; rep < NREP(4); ++rep) if (PH_ON(2 + 4) && IN(pb + 4)) {
            { PHASE_BEGIN();
              const float* lp = PIN(8) + (size_t)l * 256;
              const float lam = expf(wave_sum(lp[lane] * lp[64 + lane])) - expf(wave_sum(lp[128 + lane] * lp[192 + lane])) + lambda_init;
              for (int r2 = 0; r2 < NREP(60); ++r2) for (int L = bx; L < 256; L += G) diff_unit(WSP(bf16_t, WS_QD), WSP(bf16_t, WS_KD), WSP(bf16_t, WS_VD), WSP(float, WS_ATMP), WSP(bf16_t, WS_OB), PIN(9) + (size_t)l * 128, lam, 1.f - lambda_init, L & 7, L >> 3, (char*)lds_raw); }
            { PHASE_BEGIN();
              for (int r2 = 0; r2 < NREP(61); ++r2) for (int L = bx; L < 256; L += G) mla_unit(WSP(bf16_t, WS_QM), WSP(bf16_t, WS_KM), WSP(bf16_t, WS_VM), WSP(bf16_t, WS_OB) + (size_t)S * 1024, L & 7, L >> 3, (char*)lds_raw); }
            { PHASE_BEGIN();
              for (int r2 = 0; r2 < NREP(62); ++r2) for (int L = bx; L < 256; L += G) gqa_unit(WSP(bf16_t, WS_QG), WSP(bf16_t, WS_KG), WSP(bf16_t, WS_VG), WSP(bf16_t, WS_OB) + (size_t)2 * S * 1024, PIN(14) + (size_t)l * 8, L & 7, L >> 3, (char*)lds_raw); }
            __syncthreads();
            if (BOTH(pb + 4)) GRID_BAR();
        }
        for (int rep = 0; rep < NREP(5); ++rep) if (PH_ON(2 + 5) && IN(pb + 5)) {
            PHASE_BEGIN();
            pg8::Gemm g{WSP(bf16_t, WS_OB), LWP(LW_BR), 3 * S, 3 * D, 1024}; BranchOrder O; O.so.init(S, D, G, bx); EpiBranch E{WSP(bf16_t, WS_GATE), WSP(bf16_t, WS_MG)};
            pg8::gemm_phase<EpiBranch, BranchOrder>(lds, g, O, E);
            if (BOTH(pb + 5)) GRID_BAR();
        }
        for (int rep = 0; rep < NREP(6); ++rep) if (PH_ON(2 + 6) && IN(pb + 6)) {
            PHASE_BEGIN();
            pg8::Gemm g{WSP(bf16_t, WS_MG), LWP(LW_WO), S, D, D}; pg8::StaticOrder O; O.init(S, D, G, bx); EpiResid E{WSP(_Float16, WS_H), WSP(bf16_t, WS_AN), rep ? 0.f : 1.f, rep == 0, RSSP(2), lds};
            pg8::gemm_phase<EpiResid, pg8::StaticOrder>(lds, g, O, E);
            if (BOTH(pb + 6)) GRID_BAR();
        }
        for (int rep = 0; rep < NREP(7); ++rep) if (PH_ON(2 + 7) && IN(pb + 7)) {
            PHASE_BEGIN();
            if (l == 0 && bx >= 64 && bx < 80) {
                pg8::Gemm g{WSP(bf16_t, WS_MEMN), WSP(bf16_t, WS_WXKV), 4 * MEMLEN, 4 * 1024, D}; KvxOrder O{16, bx - 64}; EpiPlain E{WSP(bf16_t, WS_KVX), 1024, 4, nullptr, lds, 0};
                pg8::gemm_phase<EpiPlain, KvxOrder>(lds, g, O, E);
            } else if (bx >= 80) {
                if (l + 1 < DEPTH && rep == 0) cvt_layer_part(PT, ws, l + 1, 2, (LAS float*)(lds + wave * 16384), (bx - 80) * NWAVES + wave, (G - 80) * NWAVES, lane);
            } else {
            pg8::Gemm g{WSP(bf16_t, WS_AN), LWP(LW_XQ), S, 512, D}; pg8::StaticOrder O; O.init(S, 512, G, bx); EpiPlain E{WSP(bf16_t, WS_QX), 512, 0, RSSP(2), lds, 64 * (4 * l + 2) + 1, QS_128};
            pg8::gemm_phase<EpiPlain, pg8::StaticOrder>(lds, g, O, E);
            }
            if (BOTH(pb + 7)) GRID_BAR();
        }
        for (int rep = 0; rep < NREP(8); ++rep) if (PH_ON(2 + 8) && IN(pb + 8)) {
            PHASE_BEGIN();
            for (int L = bx; L < 128; L += G) xattn_unit(WSP(bf16_t, WS_QX), WSP(bf16_t, WS_KVX) + (size_t)l * MEMLEN * 1024, WSP(bf16_t, WS_OX), L & 3, L >> 2, (char*)lds_raw);
            __syncthreads();
            if (BOTH(pb + 8)) GRID_BAR();
        }
        for (int rep = 0; rep < NREP(9); ++rep) if (PH_ON(2 + 9) && IN(pb + 9)) {
            PHASE_BEGIN();
            pg8::Gemm g{WSP(bf16_t, WS_OX), LWP(LW_XO), S, D, 512}; pg8::StaticOrder O; O.init(S, D, G, bx); EpiResid E{WSP(_Float16, WS_H), WSP(bf16_t, WS_AN), rep ? 0.f : 1.f, rep == 0, RSSP(3), lds};
            pg8::gemm_phase<EpiResid, pg8::StaticOrder>(lds, g, O, E);
            if (BOTH(pb + 9)) GRID_BAR();
        }
        for (int rep = 0; rep < NREP(10); ++rep) if (PH_ON(2 + 10) && IN(pb + 10)) {
            PHASE_BEGIN();
            const int gg = (l + 1 < DEPTH && rep == 0) ? G - CVT_WG : G;
            if (bx >= gg) cvt_layer_part(PT, ws, l + 1, 1, (LAS float*)(lds + wave * 16384), (bx - gg) * NWAVES + wave, CVT_WG * NWAVES, lane);
            else {
            pg8::Gemm g{WSP(bf16_t, WS_AN), LWP(LW_GU2), S, 2 * DFF, D}; pg8::StaticOrder O; O.init(S, 2 * DFF, gg, bx); EpiSwiglu E{WSP(bf16_t, WS_HID), RSSP(3), lds, 64 * (4 * l + 3) + 1};
            pg8::gemm_phase<EpiSwiglu, pg8::StaticOrder>(lds, g, O, E);
            }
            if (BOTH(pb + 10)) GRID_BAR();
        }
        for (int rep = 0; rep < NREP(11); ++rep) if (PH_ON(2 + 11) && IN(pb + 11)) {
            PHASE_BEGIN();
            pg8::Gemm g{WSP(bf16_t, WS_HID), LWP(LW_DN2), S, D, DFF}; pg8::StaticOrder O; O.init(S, D, G, bx); EpiResid E{WSP(_Float16, WS_H), WSP(bf16_t, WS_AN), rep ? 0.f : 0.5f, rep == 0, RSSP(4), lds};
            pg8::gemm_phase<EpiResid, pg8::StaticOrder>(lds, g, O, E);
            if (BOTH(pb + 11)) GRID_BAR();
        }
#undef LWP
#undef RSSP
#undef RSSMP
    }
    if (PH_ON(14) && IN(2 + DEPTH * PH_PER_LAYER)) {
        PHASE_BEGIN();
        const _Float16* H16 = WSP(_Float16, WS_H); const float* fg = PIN(27); float* out = (float*)ldptr(PT, 28);
        f32x4 fgv[4][2];
#pragma unroll
        for (int j = 0; j < 4; ++j)
#pragma unroll
            for (int e = 0; e < 2; ++e) fgv[j][e] = *(const GAS f32x4*)(fg + (64 * j + lane) * 8 + 4 * e);
        for (int m = gw; m < S; m += NGW) {
            const GAS h16x8* ar = (const GAS h16x8*)(H16 + (size_t)m * D) + lane; f32x8e v[4]; float s = 0.f;
#pragma unroll
            for (int j = 0; j < 4; ++j) { v[j] = __builtin_convertvector(ar[64 * j], f32x8e);
#pragma unroll
                for (int e = 0; e < 8; ++e) s += v[j][e] * v[j][e]; }
            const float r = rsqrtf(wave_sum(s) * (1.f / D) + 1e-6f);
#pragma unroll
            for (int j = 0; j < 4; ++j)
#pragma unroll
                for (int e = 0; e < 2; ++e) { const int c = (64 * j + lane) * 8 + 4 * e; const f32x4 g = fgv[j][e];
                    const f32x4 vv = {v[j][4 * e], v[j][4 * e + 1], v[j][4 * e + 2], v[j][4 * e + 3]}; *(GAS f32x4*)(out + (size_t)m * D + c) = vv * r * g; } }
    }
#if !MK_PER_PHASE && MK_STAMP >= 0
    if (bx == 0) { const unsigned long long te = __builtin_amdgcn_s_memrealtime(), wait = (st1 - st0) * 16ull; while (__builtin_amdgcn_s_memrealtime() - te < wait) __builtin_amdgcn_s_sleep(8); }
#endif
#undef IN
#undef BOTH
}
}

extern "C" void kernel_launch(void* const* d_in, const int* in_sizes, int n_in, void* d_out, int out_size, void* d_ws, size_t ws_size, hipStream_t stream) {
    using namespace mk;
    static int grid = 0;
    if (grid == 0) {
        if (n_in != 28 || out_size != S * D || ws_size < WS_END) { fprintf(stderr, "kernel_launch: unexpected n_in %d out %d ws %zu (need %zu)\n", n_in, out_size, ws_size, (size_t)WS_END); grid = -1; return; }
        int dev = 0, cus = 0, per_cu = 0;
        if (hipGetDevice(&dev) != hipSuccess || hipDeviceGetAttribute(&cus, hipDeviceAttributeMultiprocessorCount, dev) != hipSuccess) { grid = -1; return; }
        if (hipFuncSetAttribute((const void*)mega, hipFuncAttributeMaxDynamicSharedMemorySize, LDS_BYTES) != hipSuccess) { fprintf(stderr, "kernel_launch: hipFuncSetAttribute failed\n"); grid = -1; return; }
        if (hipOccupancyMaxActiveBlocksPerMultiprocessor(&per_cu, (const void*)mega, NWAVES * 64, LDS_BYTES) != hipSuccess || per_cu < 1) { fprintf(stderr, "kernel_launch: occupancy query says %d\n", per_cu); }
        (void)hipGetLastError();
        grid = cus;
    }
    if (grid < 0) return;
    (void)hipMemsetAsync((char*)d_ws + WS_CTL, 0, CTL_ZERO_BYTES, stream);
    Args a{};
    for (int i = 0; i < 28; ++i) a.in[i] = d_in[i];
    a.out = (float*)d_out; a.ws = (unsigned char*)d_ws;
#if MK_PER_PHASE
    for (int p = 0; p < N_PHASES; ++p) { a.ph_lo = p; a.ph_hi = p + 1; hipLaunchKernelGGL(mega, dim3(grid), dim3(NWAVES * 64), LDS_BYTES, stream, a); }
#else
    a.ph_lo = 0; a.ph_hi = N_PHASES; hipLaunchKernelGGL(mega, dim3(grid), dim3(NWAVES * 64), LDS_BYTES, stream, a);
#endif
    const hipError_t le = hipPeekAtLastError();
    if (le != hipSuccess) fprintf(stderr, "kernel_launch: launch failed: %s\n", hipGetErrorName(le));
}
```

```cpp
#include <hip/hip_runtime.h>
#include <cstdio>
#include <cmath>
#include <cstdint>
#ifndef MK_PER_PHASE
#define MK_PER_PHASE 0
#endif
#ifndef MK_ONLY
#define MK_ONLY -1
#endif
#ifndef MK_DUP
#define MK_DUP -1
#endif
#ifndef MK_STAMP
#define MK_STAMP -1
#endif
#ifndef MK_SPLIT_IN
#define MK_SPLIT_IN 1
#endif
namespace pg8 {
#define PG8_LAS __attribute__((address_space(3)))
typedef unsigned short bf16_t;
typedef short bf16x8 __attribute__((ext_vector_type(8)));
typedef float f32x4 __attribute__((ext_vector_type(4)));
typedef unsigned u32x4 __attribute__((ext_vector_type(4)));
constexpr int BM = 256, BK = 64, HALF = 128, HTB = HALF * BK * 2, STAGE_BYTES = 8 * HTB, NXCD = 8, WGM = 8;

__host__ __device__ __forceinline__ int lds_byte(int r, int c) { const int st = (r >> 4) * 2 + (c >> 5), rr = r & 15, cc = c & 31, ob = rr * 64 + cc * 2; return st * 1024 + (ob ^ (((ob >> 9) & 1) << 5)); }
__host__ __device__ __forceinline__ void stage_rc(int b, int& R, int& C) { const int st = b / 1024, sb = b % 1024, swz = sb ^ (((sb >> 9) & 1) << 5); R = (st >> 1) * 16 + swz / 64; C = (st & 1) * 32 + (swz % 64) / 2; }
__host__ __device__ __forceinline__ int perm32(int rho) { const int n = rho >> 4, i = rho & 15; return 8 * (i >> 2) + 4 * n + (i & 3); }

struct Unit { int pm, pn; };
struct Gemm { const bf16_t* A; const bf16_t* Bt; int M, N, K; };

struct StaticOrder {
    int nM, nN, nwg, G, c;
    __host__ __device__ void init(int M, int N, int G_, int c_) { nM = M / BM; nN = N / BM; nwg = nM * nN; G = G_; c = c_; }
    __host__ __device__ bool map(int L, Unit& u) const {
        if (L >= nwg) return false;
        int wgid = (int)L; { const int q = nwg / NXCD, r = nwg % NXCD, xcd = wgid % NXCD, off = wgid / NXCD; wgid = (xcd < r ? xcd * (q + 1) : r * (q + 1) + (xcd - r) * q) + off; }
        const int nig = WGM * nN, gid = wgid / nig, fm = gid * WGM, gsz = (nM - fm) < WGM ? (nM - fm) : WGM;
        u.pm = fm + ((wgid % nig) % gsz); u.pn = (wgid % nig) / gsz; return true;
    }
    __host__ __device__ bool next(int i, Unit& u) const { return map(i * G + c, u); }
    __device__ __forceinline__ void a_ready(const Unit&) const {}
    __device__ __forceinline__ void done(const Unit&) const {}
};

__device__ __forceinline__ unsigned cvt_pk_bf16(float lo, float hi) { unsigned r; asm volatile("v_cvt_pk_bf16_f32 %0, %1, %2" : "=v"(r) : "v"(lo), "v"(hi)); return r; }
__device__ __forceinline__ u32x4 pack8(const f32x4 v0, const f32x4 v1) { u32x4 w; w.x = cvt_pk_bf16(v0[0], v0[1]); w.y = cvt_pk_bf16(v0[2], v0[3]); w.z = cvt_pk_bf16(v1[0], v1[1]); w.w = cvt_pk_bf16(v1[2], v1[3]); return w; }
__device__ __forceinline__ void unpack8(const u32x4 w, f32x4& v0, f32x4& v1) {
    v0[0] = __uint_as_float(w.x << 16); v0[1] = __uint_as_float(w.x & 0xffff0000u); v0[2] = __uint_as_float(w.y << 16); v0[3] = __uint_as_float(w.y & 0xffff0000u);
    v1[0] = __uint_as_float(w.z << 16); v1[1] = __uint_as_float(w.z & 0xffff0000u); v1[2] = __uint_as_float(w.w << 16); v1[3] = __uint_as_float(w.w & 0xffff0000u); }

template <class Epi, class Sched, bool ALIGN_EPI = true, bool SP2 = true>
__device__ __forceinline__ void gemm_phase(PG8_LAS unsigned char* lds, const Gemm g, const Sched& S, const Epi& E) {
    int tid = threadIdx.x; asm volatile("" : "+v"(tid));
    const int wid = __builtin_amdgcn_readfirstlane(tid >> 6), lane = tid & 63, wr = wid >> 2, wc = wid & 3, fr = lane & 15, fq = lane >> 4;
    const int K = g.K, nt = K / BK;
    unsigned voffA[2], voffB[2];
#pragma unroll
    for (int i = 0; i < 2; ++i) { int R, C; stage_rc(tid * 16 + i * 8192, R, C); const int Rb = Epi::PERM ? ((R & ~31) + perm32(R & 31)) : R;
        voffA[i] = (unsigned)(R * K + C) * 2u; voffB[i] = (unsigned)(Rb * K + C) * 2u; }
    const size_t kstep = (size_t)(BK * 2);
    const size_t hstep = (size_t)HALF * K * 2;
    const size_t tstep = 2 * hstep;
    const unsigned ldsw = (unsigned)wid * 1024u;
    const int aoff = lds_byte(wr * 64 + fr, fq * 8), boff = lds_byte(wc * 32 + fr, fq * 8);
#define PG8_SA(b, h) (((b) * 2 + (h)) * HTB)
#define PG8_SB(b, h) ((4 + (b) * 2 + (h)) * HTB)
#define PG8_STAGE(bufoff, gbase, voff) do { _Pragma("unroll") for (int _i = 0; _i < 2; ++_i) \
        __builtin_amdgcn_global_load_lds((const unsigned*)((const char*)(gbase) + (voff)[_i]), (PG8_LAS unsigned*)(lds + (bufoff) + ldsw + _i * 8192), 16, 0, 0); } while (0)
#define PG8_LDA(dst, b, h) do { _Pragma("unroll") for (int m = 0; m < 4; ++m) _Pragma("unroll") for (int k = 0; k < 2; ++k) dst[m][k] = *(const PG8_LAS bf16x8*)(lds + PG8_SA(b, h) + aoff + m * 2048 + k * 1024); } while (0)
#define PG8_LDB(dst, b, h) do { _Pragma("unroll") for (int n = 0; n < 2; ++n) _Pragma("unroll") for (int k = 0; k < 2; ++k) dst[n][k] = *(const PG8_LAS bf16x8*)(lds + PG8_SB(b, h) + boff + n * 2048 + k * 1024); } while (0)
#define PG8_MMA(ai, bj, At, Bt) do { __builtin_amdgcn_s_setprio(1); _Pragma("unroll") for (int m = 0; m < 4; ++m) _Pragma("unroll") for (int n = 0; n < 2; ++n) _Pragma("unroll") for (int k = 0; k < 2; ++k) \
        acc[ai][bj][m][n] = __builtin_amdgcn_mfma_f32_16x16x32_bf16(Bt[n][k], At[m][k], acc[ai][bj][m][n], 0, 0, 0); __builtin_amdgcn_s_setprio(0); } while (0)
#define PG8_WAIT_V(n) asm volatile("s_waitcnt vmcnt(" #n ")" ::: "memory")
#define PG8_WAIT_L(n) asm volatile("s_waitcnt lgkmcnt(" #n ")" ::: "memory")
#define PG8_BAR __builtin_amdgcn_s_barrier()
#define PG8_SCHED __builtin_amdgcn_sched_barrier(0)
    Unit cur, nxt; int ui = 0;
    if (!S.next(0, cur)) return;
    f32x4 acc[2][2][4][2];
#pragma unroll
    for (int a = 0; a < 2; ++a)
#pragma unroll
        for (int b = 0; b < 2; ++b)
#pragma unroll
            for (int m = 0; m < 4; ++m)
#pragma unroll
                for (int n = 0; n < 2; ++n) acc[a][b][m][n] = (f32x4){0.f, 0.f, 0.f, 0.f};
    bf16x8 At[4][2], B0[2][2], B1[2][2];
    const char* cA = (const char*)g.A + (size_t)cur.pm * tstep; const char* cB = (const char*)g.Bt + (size_t)cur.pn * tstep;
    S.a_ready(cur);
    if constexpr (SP2) {
        PG8_STAGE(PG8_SB(0, 0), cB, voffB); PG8_STAGE(PG8_SB(0, 1), cB + hstep, voffB); PG8_STAGE(PG8_SA(0, 0), cA, voffA); PG8_STAGE(PG8_SA(0, 1), cA + hstep, voffA);
        if (wr == 1) PG8_BAR;
        PG8_WAIT_V(2); PG8_BAR;
        PG8_STAGE(PG8_SB(1, 0), cB + kstep, voffB); PG8_STAGE(PG8_SA(1, 0), cA + kstep, voffA); PG8_STAGE(PG8_SB(1, 1), cB + hstep + kstep, voffB);
        PG8_WAIT_V(6); PG8_BAR;
    } else {
        PG8_STAGE(PG8_SB(0, 0), cB, voffB); PG8_STAGE(PG8_SA(0, 0), cA, voffA); PG8_STAGE(PG8_SB(0, 1), cB + hstep, voffB); PG8_STAGE(PG8_SA(0, 1), cA + hstep, voffA);
        if (wr == 1) PG8_BAR;
        PG8_WAIT_V(4); PG8_BAR;
        PG8_STAGE(PG8_SB(1, 0), cB + kstep, voffB); PG8_STAGE(PG8_SA(1, 0), cA + kstep, voffA); PG8_STAGE(PG8_SB(1, 1), cB + hstep + kstep, voffB);
        PG8_WAIT_V(6); PG8_BAR;
    }
    for (;;) {
        const bool has_next = S.next(ui + 1, nxt);
        const char* nA = has_next ? (const char*)g.A + (size_t)nxt.pm * tstep : cA; const char* nB = has_next ? (const char*)g.Bt + (size_t)nxt.pn * tstep : cB;
        for (int t = 0; t < nt; t += 2) {
            const bool last = (t == nt - 2);
            const char* a1 = cA + (size_t)(t + 1) * kstep;
            const char* a2 = last ? nA : cA + (size_t)(t + 2) * kstep; const char* b2 = last ? nB : cB + (size_t)(t + 2) * kstep;
            const char* a3 = a2 + kstep; const char* b3 = b2 + kstep;
            if (last && has_next) S.a_ready(nxt);
            if constexpr (SP2) {
            PG8_LDB(B0, 0, 0); PG8_LDB(B1, 0, 1); PG8_SCHED; PG8_LDA(At, 0, 0); PG8_STAGE(PG8_SA(1, 1), a1 + hstep, voffA);
            PG8_WAIT_V(8); PG8_WAIT_L(0); PG8_BAR; PG8_MMA(0, 0, At, B0); PG8_MMA(0, 1, At, B1); PG8_BAR; PG8_SCHED;
            PG8_LDA(At, 0, 1); PG8_STAGE(PG8_SB(0, 0), b2, voffB); PG8_STAGE(PG8_SB(0, 1), b2 + hstep, voffB); PG8_STAGE(PG8_SA(0, 0), a2, voffA);
            PG8_WAIT_V(8); PG8_WAIT_L(0); PG8_BAR; PG8_MMA(1, 0, At, B0); PG8_MMA(1, 1, At, B1); PG8_BAR; PG8_SCHED;
            PG8_LDB(B0, 1, 0); PG8_LDB(B1, 1, 1); PG8_SCHED; PG8_LDA(At, 1, 0); PG8_STAGE(PG8_SA(0, 1), a2 + hstep, voffA);
            PG8_WAIT_V(8); PG8_WAIT_L(0); PG8_BAR; PG8_MMA(0, 0, At, B0); PG8_MMA(0, 1, At, B1); PG8_BAR; PG8_SCHED;
            PG8_LDA(At, 1, 1); PG8_STAGE(PG8_SB(1, 0), b3, voffB); PG8_STAGE(PG8_SB(1, 1), b3 + hstep, voffB); PG8_STAGE(PG8_SA(1, 0), a3, voffA);
            PG8_WAIT_V(8); PG8_WAIT_L(0); PG8_BAR; PG8_MMA(1, 0, At, B0); PG8_MMA(1, 1, At, B1); PG8_BAR; PG8_SCHED;
            } else {
            PG8_LDB(B0, 0, 0); PG8_SCHED; PG8_LDA(At, 0, 0); PG8_STAGE(PG8_SA(1, 1), a1 + hstep, voffA);
            PG8_WAIT_L(8); PG8_BAR; PG8_WAIT_L(0); PG8_MMA(0, 0, At, B0); PG8_BAR; PG8_SCHED;
            PG8_LDB(B1, 0, 1); PG8_STAGE(PG8_SB(0, 0), b2, voffB);
            PG8_BAR; PG8_WAIT_L(0); PG8_MMA(0, 1, At, B1); PG8_BAR;
            PG8_LDA(At, 0, 1); PG8_STAGE(PG8_SA(0, 0), a2, voffA);
            PG8_BAR; PG8_WAIT_L(0); PG8_MMA(1, 0, At, B0); PG8_BAR; PG8_SCHED;
            PG8_STAGE(PG8_SB(0, 1), b2 + hstep, voffB);
            PG8_WAIT_V(6); PG8_BAR; PG8_MMA(1, 1, At, B1); PG8_BAR;
            PG8_LDB(B0, 1, 0); PG8_SCHED; PG8_LDA(At, 1, 0); PG8_STAGE(PG8_SA(0, 1), a2 + hstep, voffA);
            PG8_WAIT_L(8); PG8_BAR; PG8_WAIT_L(0); PG8_MMA(0, 0, At, B0); PG8_BAR; PG8_SCHED;
            PG8_LDB(B1, 1, 1); PG8_STAGE(PG8_SB(1, 0), b3, voffB);
            PG8_BAR; PG8_WAIT_L(0); PG8_MMA(0, 1, At, B1); PG8_BAR;
            PG8_LDA(At, 1, 1); PG8_STAGE(PG8_SA(1, 0), a3, voffA);
            PG8_BAR; PG8_WAIT_L(0); PG8_MMA(1, 0, At, B0); PG8_BAR; PG8_SCHED;
            PG8_STAGE(PG8_SB(1, 1), b3 + hstep, voffB);
            PG8_WAIT_V(6); PG8_BAR; PG8_MMA(1, 1, At, B1); PG8_BAR;
            }
        }
        if constexpr (ALIGN_EPI) { if (wr == 0) PG8_BAR; }
        E(acc, cur, wr, wc, fr, fq); S.done(cur);
        if (!has_next) break;
        bool keep = false;
        if constexpr (Epi::CHAIN) keep = E.keep(cur);
        if (!keep) {
#pragma unroll
        for (int a = 0; a < 2; ++a)
#pragma unroll
            for (int b = 0; b < 2; ++b)
#pragma unroll
                for (int m = 0; m < 4; ++m)
#pragma unroll
                    for (int n = 0; n < 2; ++n) acc[a][b][m][n] = (f32x4){0.f, 0.f, 0.f, 0.f};
        }
        cur = nxt; cA = nA; cB = nB; ++ui;
        if constexpr (ALIGN_EPI) { if (wr == 1) PG8_BAR; }
    }
    PG8_WAIT_V(0);
    if constexpr (!ALIGN_EPI) { if (wr == 0) PG8_BAR; }
    PG8_BAR;
#undef PG8_SA
#undef PG8_SB
#undef PG8_STAGE
#undef PG8_LDA
#undef PG8_LDB
#undef PG8_MMA
#undef PG8_WAIT_V
#undef PG8_WAIT_L
#undef PG8_BAR
#undef PG8_SCHED
}
}
namespace mk {
using pg8::bf16_t; using pg8::f32x4; using pg8::u32x4; using pg8::Unit; using pg8::pack8; using pg8::unpack8;
constexpr int S = 8192, D = 2048, DEPTH = 4, DFF = 5632, DIN = 5696, MEMLEN = 256;
constexpr int NIN = 12032;
constexpr float LOG2E = 1.4426950408889634f;
constexpr float QS_DIFF = 0.125f * LOG2E, QS_MLA = 0.07216878364870323f * LOG2E, QS_128 = 0.08838834764831845f * LOG2E;

#define GA1 __attribute__((address_space(1)))
#define LA3 __attribute__((address_space(3)))
typedef float rss_t;
constexpr int RSS_LDS_OFF = 131072 + 1024;
__device__ __forceinline__ float rss_rstd(const rss_t* p  , float inv_n) {
    const f32x4 a = *(const GA1 f32x4*)p, b = *(const GA1 f32x4*)(p + 4);
    return rsqrtf((((a[0] + a[1]) + (a[2] + a[3])) + ((b[0] + b[1]) + (b[2] + b[3]))) * inv_n + 1e-6f);
}
typedef float f32x2e __attribute__((ext_vector_type(2)));
__device__ __forceinline__ float rss_rstd2(const rss_t* p  , float inv_n) { const f32x2e a = *(const GA1 f32x2e*)p; return rsqrtf((a[0] + a[1]) * inv_n + 1e-6f); }
__device__ __forceinline__ void rss_reduce_store(const float (&ssv)[2][4], int wr, int wc, int fr, int fq, LA3 unsigned char* ldsbase, rss_t* out, int stride) {
    LA3 float* P = (LA3 float*)(ldsbase + RSS_LDS_OFF);
    if (fq == 0) {
#pragma unroll
        for (int ai = 0; ai < 2; ++ai)
#pragma unroll
            for (int m = 0; m < 4; ++m) P[(ai * 128 + wr * 64 + m * 16 + fr) * 4 + wc] = ssv[ai][m]; }
    asm volatile("s_waitcnt lgkmcnt(0)" ::: "memory"); __builtin_amdgcn_s_barrier(); asm volatile("" ::: "memory");
    const int t = (wr * 4 + wc) * 64 + fq * 16 + fr;
    if (t < 256) { const LA3 f32x4* pr = (const LA3 f32x4*)(P + t * 4); const f32x4 v = *pr; ((GA1 rss_t*)out)[(size_t)t * stride] = (v[0] + v[1]) + (v[2] + v[3]); }
}
__device__ __forceinline__ void rstd_cached(const rss_t* rss  , int pm, int tag, LA3 unsigned char* ldsb, int wr, int wc, int fr, int fq, float (&rsv)[2][4]) {
    LA3 float* T = (LA3 float*)(ldsb + RSS_LDS_OFF + 4096); volatile LA3 int* TAG = (volatile LA3 int*)(ldsb + RSS_LDS_OFF + 4096 + 1024);
    const int t = (wr * 4 + wc) * 64 + fq * 16 + fr;
    if (__builtin_amdgcn_readfirstlane(*TAG) != tag) {
        if (t < 256) T[t] = rss_rstd(rss + (size_t)(pm * 256 + t) * 8, 1.f / D);
        asm volatile("s_waitcnt lgkmcnt(0)" ::: "memory"); __builtin_amdgcn_s_barrier(); asm volatile("" ::: "memory");
        if (t == 0) *TAG = tag;
    }
#pragma unroll
    for (int ai = 0; ai < 2; ++ai)
#pragma unroll
        for (int m = 0; m < 4; ++m) rsv[ai][m] = T[ai * 128 + wr * 64 + m * 16 + fr];
}
__device__ __forceinline__ float fast_sigmoid(float x) { return __builtin_amdgcn_rcpf(1.f + __builtin_amdgcn_exp2f(-x * LOG2E)); }


struct EpiSwiglu {
    static constexpr bool PERM = true, CHAIN = false;
    bf16_t* HID; const rss_t* rss; LA3 unsigned char* ldsb; int tag0;
    __device__ __forceinline__ void operator()(f32x4 (&acc)[2][2][4][2], const Unit& u, int wr, int wc, int fr, int fq) const {
        const int row0 = u.pm * 256 + wr * 64 + fr, col = u.pn * 128 + wc * 32 + 8 * fq;
        float rsv[2][4]; rstd_cached(rss, u.pm, tag0 + u.pm, ldsb, wr, wc, fr, fq, rsv);
#pragma unroll
        for (int ai = 0; ai < 2; ++ai)
#pragma unroll
            for (int m = 0; m < 4; ++m) {
                const float rs = rsv[ai][m];
                f32x4 h0, h1;
#pragma unroll
                for (int j = 0; j < 4; ++j) { const float g0 = acc[ai][0][m][0][j] * rs, g1 = acc[ai][0][m][1][j] * rs;
                    h0[j] = g0 * fast_sigmoid(g0) * (acc[ai][1][m][0][j] * rs); h1[j] = g1 * fast_sigmoid(g1) * (acc[ai][1][m][1][j] * rs); }
                *(GA1 u32x4*)(HID + (size_t)(row0 + ai * 128 + m * 16) * DFF + col) = pack8(h0, h1);
            }
    }
};
typedef _Float16 h16x8 __attribute__((ext_vector_type(8)));
typedef float f32x8e __attribute__((ext_vector_type(8)));
struct EpiResid {
    static constexpr bool PERM = true, CHAIN = false;
    _Float16* h16; bf16_t* an; float alpha; bool stats; rss_t* rss; LA3 unsigned char* ldsb;
    __device__ __forceinline__ void operator()(f32x4 (&acc)[2][2][4][2], const Unit& u, int wr, int wc, int fr, int fq) const {
        const int row0 = u.pm * 256 + wr * 64 + fr, col0 = u.pn * 256 + wc * 32 + 8 * fq;
        float ssv[2][4];
#pragma unroll
        for (int ai = 0; ai < 2; ++ai) {
            h16x8 hb[4][2];
#pragma unroll
            for (int m = 0; m < 4; ++m)
#pragma unroll
                for (int bj = 0; bj < 2; ++bj) hb[m][bj] = *(const GA1 h16x8*)(h16 + (size_t)(row0 + ai * 128 + m * 16) * D + col0 + bj * 128);
#pragma unroll
            for (int m = 0; m < 4; ++m) { const int row = row0 + ai * 128 + m * 16; float ss = 0.f;
#pragma unroll
                for (int bj = 0; bj < 2; ++bj) { const f32x8e hf = __builtin_convertvector(hb[m][bj], f32x8e);
                    f32x4 h0 = {hf[0], hf[1], hf[2], hf[3]}, h1 = {hf[4], hf[5], hf[6], hf[7]};
                    h0 = h0 + acc[ai][bj][m][0] * alpha; h1 = h1 + acc[ai][bj][m][1] * alpha;
                    ss += (h0[0] * h0[0] + h0[1] * h0[1]) + (h0[2] * h0[2] + h0[3] * h0[3]) + (h1[0] * h1[0] + h1[1] * h1[1]) + (h1[2] * h1[2] + h1[3] * h1[3]);
                    const f32x8e hn = {h0[0], h0[1], h0[2], h0[3], h1[0], h1[1], h1[2], h1[3]};
                    *(GA1 h16x8*)(h16 + (size_t)row * D + col0 + bj * 128) = __builtin_convertvector(hn, h16x8);
                    *(GA1 u32x4*)(an + (size_t)row * D + col0 + bj * 128) = pack8(h0, h1); }
                ss += __shfl_xor(ss, 16); ss += __shfl_xor(ss, 32); ssv[ai][m] = ss; }
        }
        if (stats) rss_reduce_store(ssv, wr, wc, fr, fq, ldsb, rss + (size_t)u.pm * 256 * 8 + u.pn, 8);
    }
};
struct EpiPlain {
    static constexpr bool PERM = true, CHAIN = false;
    bf16_t* O; int ldc; int npp; const rss_t* rss; LA3 unsigned char* ldsb; int tag0; float osc = 1.f;
    __device__ __forceinline__ void operator()(f32x4 (&acc)[2][2][4][2], const Unit& u, int wr, int wc, int fr, int fq) const {
        const int row0 = u.pm * 256 + wr * 64 + fr, col0 = (u.pn - u.pm * npp) * 256 + wc * 32 + 8 * fq;
        float rsv[2][4];
        if (rss) rstd_cached(rss, u.pm, tag0 + u.pm, ldsb, wr, wc, fr, fq, rsv);
        else {
#pragma unroll
            for (int ai = 0; ai < 2; ++ai)
#pragma unroll
                for (int m = 0; m < 4; ++m) rsv[ai][m] = 1.f; }
#pragma unroll
        for (int ai = 0; ai < 2; ++ai)
#pragma unroll
            for (int m = 0; m < 4; ++m) { const int row = row0 + ai * 128 + m * 16; bf16_t* rp = O + (size_t)row * ldc + col0;
                const float rs = rsv[ai][m] * osc;
#pragma unroll
                for (int bj = 0; bj < 2; ++bj) *(GA1 u32x4*)(rp + bj * 128) = pack8(acc[ai][bj][m][0] * rs, acc[ai][bj][m][1] * rs); }
    }
};
__device__ __forceinline__ void rope8_apply(f32x4& v0, f32x4& v1, const f32x4 t0, const f32x4 t1) {
    const f32x4 c = {t0[0], t0[2], t1[0], t1[2]}, s = {t0[1], t0[3], t1[1], t1[3]};
    const f32x4 y1 = v0 * c - v1 * s, y2 = v1 * c + v0 * s; v0 = y1; v1 = y2;
}
__device__ __forceinline__ void rope8(f32x4& v0, f32x4& v1, const float2* cs) { rope8_apply(v0, v1, *(const GA1 f32x4*)cs, *(const GA1 f32x4*)(cs + 2)); }
struct EpiIn {
    static constexpr bool PERM = true, CHAIN = false;
    bf16_t *QD, *KD, *VD, *CQR, *CKVR, *QG, *KG, *VG, *KM, *GATE; const float2 *cs64, *cs128; const float* bg; const rss_t* rss; rss_t* rssm; LA3 unsigned char* ldsb; int tag0;
    __device__ __forceinline__ void operator()(f32x4 (&acc)[2][2][4][2], const Unit& u, int wr, int wc, int fr, int fq) const {
        const int pn = u.pn, row0 = u.pm * 256 + wr * 64 + fr, c8 = wc * 32 + 8 * fq;
        int kind, ld, colt; bf16_t* base;
        if (pn < 4)        { kind = 1; base = QD;   ld = 1024; colt = 256 * pn; }
        else if (pn < 8)   { kind = 1; base = KD;   ld = 1024; colt = 256 * (pn - 4); }
        else if (pn < 12)  { kind = 0; base = VD;   ld = 1024; colt = 256 * (pn - 8); }
        else if (pn < 14)  { kind = 0; base = CQR;  ld = 512;  colt = 256 * (pn - 12); }
        else if (pn < 16)  { kind = 0; base = CKVR; ld = 512;  colt = 256 * (pn - 14); }
        else if (pn < 20)  { kind = 2; base = QG;   ld = 1024; colt = 256 * (pn - 16); }
        else if (pn == 20) { kind = 2; base = KG;   ld = 256;  colt = 0; }
        else if (pn == 21) { kind = 0; base = VG;   ld = 256;  colt = 0; }
        else if (pn == 22) { kind = 4; base = KM;   ld = 1536; colt = 0; }
        else               { kind = 3; base = GATE; ld = 6144; colt = 256 * (pn - 23); }
        float rsv[2][4]; rstd_cached(rss, u.pm, tag0 + u.pm, ldsb, wr, wc, fr, fq, rsv);
        if (pn >= 12 && pn < 16) {
            float ssv[2][4];
#pragma unroll
            for (int ai = 0; ai < 2; ++ai)
#pragma unroll
                for (int m = 0; m < 4; ++m) { const int row = row0 + ai * 128 + m * 16; const float rs = rsv[ai][m]; float ss = 0.f;
#pragma unroll
                    for (int bj = 0; bj < 2; ++bj) { const f32x4 v0 = acc[ai][bj][m][0] * rs, v1 = acc[ai][bj][m][1] * rs;
                        ss += (v0[0] * v0[0] + v0[1] * v0[1]) + (v0[2] * v0[2] + v0[3] * v0[3]) + (v1[0] * v1[0] + v1[1] * v1[1]) + (v1[2] * v1[2] + v1[3] * v1[3]);
                        *(GA1 u32x4*)(base + (size_t)row * ld + colt + bj * 128 + c8) = pack8(v0, v1); }
                    ss += __shfl_xor(ss, 16); ss += __shfl_xor(ss, 32); ssv[ai][m] = ss; }
            if (rssm) rss_reduce_store(ssv, wr, wc, fr, fq, ldsb, rssm + ((size_t)(pn >= 14 ? S : 0) + (size_t)u.pm * 256) * 2 + (pn & 1), 2);
            return;
        }
        if (kind == 1 || kind == 2) {
            const float2* cs = (kind == 1 ? cs64 + (size_t)row0 * 32 : cs128 + (size_t)row0 * 64) + (((colt + c8) & (kind == 1 ? 63 : 127)) >> 3) * 4;
            const int rstr = kind == 1 ? 32 : 64;
            const float qs = pn < 4 ? QS_DIFF : (pn >= 16 && pn < 20) ? QS_128 : 1.f;
#pragma unroll
            for (int ai = 0; ai < 2; ++ai) {
                f32x4 tb[4][2];
#pragma unroll
                for (int m = 0; m < 4; ++m) { const float2* p = cs + (size_t)(ai * 128 + m * 16) * rstr; tb[m][0] = *(const GA1 f32x4*)p; tb[m][1] = *(const GA1 f32x4*)(p + 2); }
#pragma unroll
                for (int m = 0; m < 4; ++m) { const int row = row0 + ai * 128 + m * 16; const float rs = rsv[ai][m] * qs;
#pragma unroll
                    for (int bj = 0; bj < 2; ++bj) { f32x4 v0 = acc[ai][bj][m][0] * rs, v1 = acc[ai][bj][m][1] * rs; rope8_apply(v0, v1, tb[m][0], tb[m][1]);
                        *(GA1 u32x4*)(base + (size_t)row * ld + colt + bj * 128 + c8) = pack8(v0, v1); } }
            }
        } else if (kind == 0) {
#pragma unroll
            for (int ai = 0; ai < 2; ++ai)
#pragma unroll
                for (int m = 0; m < 4; ++m) { const int row = row0 + ai * 128 + m * 16; const float rs = rsv[ai][m];
#pragma unroll
                    for (int bj = 0; bj < 2; ++bj) *(GA1 u32x4*)(base + (size_t)row * ld + colt + bj * 128 + c8) = pack8(acc[ai][bj][m][0] * rs, acc[ai][bj][m][1] * rs); }
        } else if (kind == 4) {
            if (wc < 2) {
                const float2* cs = cs64 + (size_t)row0 * 32 + (c8 >> 3) * 4;
#pragma unroll
                for (int ai = 0; ai < 2; ++ai) {
                    f32x4 tb[4][2];
#pragma unroll
                    for (int m = 0; m < 4; ++m) { const float2* p = cs + (size_t)(ai * 128 + m * 16) * 32; tb[m][0] = *(const GA1 f32x4*)p; tb[m][1] = *(const GA1 f32x4*)(p + 2); }
#pragma unroll
                    for (int m = 0; m < 4; ++m) { const int row = row0 + ai * 128 + m * 16; const float rs = rsv[ai][m];
                        f32x4 v0 = acc[ai][0][m][0] * rs, v1 = acc[ai][0][m][1] * rs; rope8_apply(v0, v1, tb[m][0], tb[m][1]); const u32x4 w = pack8(v0, v1);
#pragma unroll
                        for (int h = 0; h < 8; ++h) *(GA1 u32x4*)(KM + (size_t)row * 1536 + h * 192 + 128 + c8) = w; }
                }
            }
        } else {
            f32x4 bv[2][2];
#pragma unroll
            for (int bj = 0; bj < 2; ++bj) { bv[bj][0] = *(const GA1 f32x4*)(bg + colt + bj * 128 + c8); bv[bj][1] = *(const GA1 f32x4*)(bg + colt + bj * 128 + c8 + 4); }
#pragma unroll
            for (int ai = 0; ai < 2; ++ai)
#pragma unroll
                for (int m = 0; m < 4; ++m) { const int row = row0 + ai * 128 + m * 16; const float rs = rsv[ai][m];
#pragma unroll
                    for (int bj = 0; bj < 2; ++bj) { f32x4 v0 = acc[ai][bj][m][0] * rs + bv[bj][0], v1 = acc[ai][bj][m][1] * rs + bv[bj][1];
#pragma unroll
                        for (int j = 0; j < 4; ++j) { v0[j] = fmaxf(fast_sigmoid(v0[j]), 1e-20f); v1[j] = fmaxf(fast_sigmoid(v1[j]), 1e-20f); }
                        *(GA1 u32x4*)(base + (size_t)row * ld + colt + bj * 128 + c8) = pack8(v0, v1); } }
        }
    }
};
struct EpiGate {
    static constexpr bool PERM = true, CHAIN = false;
    bf16_t* GATE; const float* bg; const rss_t* rss; LA3 unsigned char* ldsb; int tag0;
    __device__ __forceinline__ void operator()(f32x4 (&acc)[2][2][4][2], const Unit& u, int wr, int wc, int fr, int fq) const {
        const int row0 = u.pm * 256 + wr * 64 + fr, col0 = u.pn * 256 + wc * 32 + 8 * fq;
        float rsv[2][4]; rstd_cached(rss, u.pm, tag0 + u.pm, ldsb, wr, wc, fr, fq, rsv);
        f32x4 bv[2][2];
#pragma unroll
        for (int bj = 0; bj < 2; ++bj) { bv[bj][0] = *(const GA1 f32x4*)(bg + col0 + bj * 128); bv[bj][1] = *(const GA1 f32x4*)(bg + col0 + bj * 128 + 4); }
#pragma unroll
        for (int ai = 0; ai < 2; ++ai)
#pragma unroll
            for (int m = 0; m < 4; ++m) { const int row = row0 + ai * 128 + m * 16; const float rs = rsv[ai][m];
#pragma unroll
                for (int bj = 0; bj < 2; ++bj) { f32x4 v0 = acc[ai][bj][m][0] * rs + bv[bj][0], v1 = acc[ai][bj][m][1] * rs + bv[bj][1];
#pragma unroll
                    for (int j = 0; j < 4; ++j) { v0[j] = fmaxf(fast_sigmoid(v0[j]), 1e-20f); v1[j] = fmaxf(fast_sigmoid(v1[j]), 1e-20f); }
                    *(GA1 u32x4*)(GATE + (size_t)row * 6144 + col0 + bj * 128) = pack8(v0, v1); } }
    }
};
struct EpiMlaUp {
    static constexpr bool PERM = true, CHAIN = false;
    bf16_t *QM, *KM, *VM; const float2* cs64; const rss_t* rssm;
    __device__ __forceinline__ void operator()(f32x4 (&acc)[2][2][4][2], const Unit& u, int wr, int wc, int fr, int fq) const {
        const int c8 = wc * 32 + 8 * fq;
        if (u.pm < 32) {
            const int row0 = u.pm * 256 + wr * 64 + fr;
            float rsv[2][4]; f32x2e pr[2][4];
#pragma unroll
            for (int ai = 0; ai < 2; ++ai)
#pragma unroll
                for (int m = 0; m < 4; ++m) pr[ai][m] = *(const GA1 f32x2e*)(rssm + (size_t)(row0 + ai * 128 + m * 16) * 2);
#pragma unroll
            for (int ai = 0; ai < 2; ++ai)
#pragma unroll
                for (int m = 0; m < 4; ++m) rsv[ai][m] = rsqrtf((pr[ai][m][0] + pr[ai][m][1]) * (1.f / 512.f) + 1e-6f);
#pragma unroll
            for (int bj = 0; bj < 2; ++bj) { const int col = u.pn * 256 + bj * 128 + c8, p = col % 192; const bool rp = p >= 128; const int a = rp ? ((p - 128) >> 3) : 0;
#pragma unroll
                for (int ai = 0; ai < 2; ++ai) {
                    f32x4 tb[4][2];
#pragma unroll
                    for (int m = 0; m < 4; ++m) { const float2* cs = cs64 + (size_t)(row0 + ai * 128 + m * 16) * 32 + a * 4; tb[m][0] = *(const GA1 f32x4*)cs; tb[m][1] = *(const GA1 f32x4*)(cs + 2); }
#pragma unroll
                    for (int m = 0; m < 4; ++m) { const int row = row0 + ai * 128 + m * 16; const float rs = rsv[ai][m] * QS_MLA; f32x4 v0 = acc[ai][bj][m][0] * rs, v1 = acc[ai][bj][m][1] * rs;
                        if (rp) rope8_apply(v0, v1, tb[m][0], tb[m][1]);
                        *(GA1 u32x4*)(QM + (size_t)row * 1536 + col) = pack8(v0, v1); } } }
        } else {
            const int row0 = (u.pm - 32) * 256 + wr * 64 + fr, h = u.pn - 6;
            float rsv[2][4]; f32x2e pr[2][4];
#pragma unroll
            for (int ai = 0; ai < 2; ++ai)
#pragma unroll
                for (int m = 0; m < 4; ++m) pr[ai][m] = *(const GA1 f32x2e*)(rssm + (size_t)(S + row0 + ai * 128 + m * 16) * 2);
#pragma unroll
            for (int ai = 0; ai < 2; ++ai)
#pragma unroll
                for (int m = 0; m < 4; ++m) rsv[ai][m] = rsqrtf((pr[ai][m][0] + pr[ai][m][1]) * (1.f / 512.f) + 1e-6f);
#pragma unroll
            for (int ai = 0; ai < 2; ++ai)
#pragma unroll
                for (int m = 0; m < 4; ++m) { const int row = row0 + ai * 128 + m * 16; const float rs = rsv[ai][m];
                    *(GA1 u32x4*)(KM + (size_t)row * 1536 + h * 192 + c8) = pack8(acc[ai][0][m][0] * rs, acc[ai][0][m][1] * rs);
                    *(GA1 u32x4*)(VM + (size_t)row * 1024 + h * 128 + c8) = pack8(acc[ai][1][m][0] * rs, acc[ai][1][m][1] * rs); }
        }
    }
};
struct EpiBranch {
    static constexpr bool PERM = true, CHAIN = true;
    const bf16_t* GATE; bf16_t* MG;
    __device__ __forceinline__ bool keep(const Unit& u) const { return (u.pm >> 5) < 2; }
    __device__ __forceinline__ void operator()(f32x4 (&acc)[2][2][4][2], const Unit& u, int wr, int wc, int fr, int fq) const {
        const int n = u.pm >> 5, row0 = (u.pm & 31) * 256 + wr * 64 + fr, col0 = (u.pn - 8 * n) * 256 + wc * 32 + 8 * fq;
        const GA1 u32x4* gp = (const GA1 u32x4*)(GATE + (size_t)row0 * 6144 + n * 2048 + col0);
        if (n < 2) {
#pragma unroll
            for (int ai = 0; ai < 2; ++ai) {
                u32x4 a[4][2], b[4][2];
#pragma unroll
                for (int m = 0; m < 4; ++m)
#pragma unroll
                    for (int bj = 0; bj < 2; ++bj) { const GA1 u32x4* p = gp + (size_t)(ai * 128 + m * 16) * 768 + bj * 16; a[m][bj] = p[0]; b[m][bj] = p[256]; }
#pragma unroll
                for (int m = 0; m < 4; ++m)
#pragma unroll
                    for (int bj = 0; bj < 2; ++bj) { f32x4 g0, g1, h0, h1; unpack8(a[m][bj], g0, g1); unpack8(b[m][bj], h0, h1);
#pragma unroll
                        for (int j = 0; j < 4; ++j) { acc[ai][bj][m][0][j] *= g0[j] * __builtin_amdgcn_rcpf(h0[j]); acc[ai][bj][m][1][j] *= g1[j] * __builtin_amdgcn_rcpf(h1[j]); } }
            }
        } else {
            GA1 u32x4* op = (GA1 u32x4*)(MG + (size_t)row0 * D + col0);
#pragma unroll
            for (int ai = 0; ai < 2; ++ai) {
                u32x4 a[4][2];
#pragma unroll
                for (int m = 0; m < 4; ++m)
#pragma unroll
                    for (int bj = 0; bj < 2; ++bj) a[m][bj] = gp[(size_t)(ai * 128 + m * 16) * 768 + bj * 16];
#pragma unroll
                for (int m = 0; m < 4; ++m)
#pragma unroll
                    for (int bj = 0; bj < 2; ++bj) { f32x4 g0, g1; unpack8(a[m][bj], g0, g1); op[(size_t)(ai * 128 + m * 16) * 256 + bj * 16] = pack8(acc[ai][bj][m][0] * g0, acc[ai][bj][m][1] * g1); }
            }
        }
    }
};

struct MlaOrder {
    int G, c;
    __device__ bool next(int i, Unit& u) const { const int L = i * G + c; if (L < 192) { u.pm = L & 31; u.pn = L >> 5; return true; } if (L < 448) { const int l2 = L - 192; u.pm = 32 + (l2 & 31); u.pn = 6 + (l2 >> 5); return true; } return false; }
    __device__ __forceinline__ void a_ready(const Unit&) const {}
    __device__ __forceinline__ void done(const Unit&) const {}
};
struct BranchOrder {
    pg8::StaticOrder so;
    __device__ bool next(int i, Unit& u) const { const int t = i / 3, n = i - 3 * t; if (!so.map(t * so.G + so.c, u)) return false; u.pm += 32 * n; u.pn += 8 * n; return true; }
    __device__ __forceinline__ void a_ready(const Unit&) const {}
    __device__ __forceinline__ void done(const Unit&) const {}
};
struct KvxOrder {
    int G, c;
    __device__ bool next(int i, Unit& u) const { const int L = i * G + c; if (L >= 16) return false; u.pm = L >> 2; u.pn = L; return true; }
    __device__ __forceinline__ void a_ready(const Unit&) const {}
    __device__ __forceinline__ void done(const Unit&) const {}
};
}
namespace at {
typedef unsigned short bf16;
using bf16x8 = __attribute__((ext_vector_type(8))) short;
using s16x4  = __attribute__((ext_vector_type(4))) short;
using f32x16 = __attribute__((ext_vector_type(16))) float;
using u32x4  = __attribute__((ext_vector_type(4))) unsigned;
typedef const __attribute__((address_space(1))) bf16x8* gp8;
constexpr int KVBLK = 64, SHM_V = KVBLK * 128 * 2;
constexpr float THR = 8.f;
#define AT_SBAR() __builtin_amdgcn_sched_barrier(0)
#ifndef AT_GRP
#define AT_GRP 0
#endif
#ifndef AT_PRIO
#define AT_PRIO 0
#endif
#ifndef AT_QPIPE
#define AT_QPIPE 0
#endif
#ifndef AT_VPIPE
#define AT_VPIPE 1
#endif
__device__ __forceinline__ int crow(int r, int hi) { return (r & 3) + 8 * (r >> 2) + 4 * hi; }
__device__ __forceinline__ unsigned cvtpk(float lo, float hi) { unsigned r; asm volatile("v_cvt_pk_bf16_f32 %0, %1, %2" : "=v"(r) : "v"(lo), "v"(hi)); return r; }

template <bool WIN>
__device__ __forceinline__ void partialSM(f32x16& p0, f32x16& p1, float& m_reg, float& msh, f32x16& negm, float& alpha, float thr, int krel, int hi) {
  if (WIN) {
#pragma unroll
    for (int r = 0; r < 16; ++r) { const int d0 = krel + crow(r, hi), d1 = d0 + 32;
      if (d0 > 128 || d0 < -128) p0[r] = -1e30f; if (d1 > 128 || d1 < -128) p1[r] = -1e30f; }
  }
  float pmax = p0[0];
#pragma unroll
  for (int r = 1; r < 16; ++r) pmax = fmaxf(pmax, p0[r]);
#pragma unroll
  for (int r = 0; r < 16; ++r) pmax = fmaxf(pmax, p1[r]);
  { auto rr = __builtin_amdgcn_permlane32_swap(__float_as_uint(pmax), __float_as_uint(pmax), false, false);
    pmax = fmaxf(__uint_as_float(rr[0]), __uint_as_float(rr[1])); }
  const float pt = pmax + msh;
  if (__builtin_expect(__all(pt - m_reg <= thr), 1)) alpha = 1.f;
  else { const float mn = fmaxf(m_reg, pt); alpha = __builtin_amdgcn_exp2f(m_reg - mn); m_reg = mn; const float d = mn - msh; msh = mn;
#pragma unroll
    for (int r = 0; r < 16; ++r) { p0[r] -= d; p1[r] -= d; negm[r] = -mn; } }
#pragma unroll
  for (int r = 0; r < 16; ++r) p0[r] = __builtin_amdgcn_exp2f(p0[r]);
}
__device__ __forceinline__ void finishSM(f32x16& p0, f32x16& p1, float alpha, float& l_reg, bf16x8& pa0, bf16x8& pa1, bf16x8& pa2, bf16x8& pa3) {
#pragma unroll
  for (int r = 0; r < 16; ++r) p1[r] = __builtin_amdgcn_exp2f(p1[r]);
  float ps = 0;
#pragma unroll
  for (int r = 0; r < 16; ++r) ps += p0[r];
#pragma unroll
  for (int r = 0; r < 16; ++r) ps += p1[r];
  { auto rr = __builtin_amdgcn_permlane32_swap(__float_as_uint(ps), __float_as_uint(ps), false, false);
    ps = __uint_as_float(rr[0]) + __uint_as_float(rr[1]); }
  l_reg = l_reg * alpha + ps;
#define AT_PK4(P, BASE, OUT) do { unsigned a0 = cvtpk(P[BASE + 0], P[BASE + 1]), a1 = cvtpk(P[BASE + 2], P[BASE + 3]);   \
    unsigned b0 = cvtpk(P[BASE + 4], P[BASE + 5]), b1 = cvtpk(P[BASE + 6], P[BASE + 7]);                              \
    auto r0 = __builtin_amdgcn_permlane32_swap(a0, b0, false, false); auto r1 = __builtin_amdgcn_permlane32_swap(a1, b1, false, false); \
    u32x4 w = {r0[0], r1[0], r0[1], r1[1]}; OUT = *reinterpret_cast<bf16x8*>(&w); } while (0)
  AT_PK4(p0, 0, pa0); AT_PK4(p0, 8, pa1); AT_PK4(p1, 0, pa2); AT_PK4(p1, 8, pa3);
#undef AT_PK4
}
template <int DQK> __device__ __forceinline__ int kswz_x(int row) { return DQK == 128 ? (row & 15) : ((row >> 1) & 7); }
template <int DQK> __device__ __forceinline__ int kswz(int row, int colB) { return row * (DQK * 2) + (colB ^ (kswz_x<DQK>(row) << 4)); }
template <int DQK, int QL, int GRP>
__device__ __forceinline__ void qkt(f32x16& p0, f32x16& p1, const f32x16& ini  , int ks  , const int (&kb)[8], const bf16x8* qr, int qa, int r32, int hi) {
  typedef const __attribute__((address_space(3))) bf16x8* lp;
  p0 = ini; p1 = ini;
  if (QL > 0) asm volatile("" : "+v"(qa));
#if AT_QPIPE
  const int ka0 = DQK == 128 ? kb[0] : kb[0];
  bf16x8 b0 = *(lp)(uintptr_t)(unsigned)(ks + ka0), b1 = *(lp)(uintptr_t)(unsigned)(ks + ka0 + 32 * DQK * 2);
#pragma unroll
  for (int d0 = 0; d0 < DQK / 16; ++d0) {
    bf16x8 n0 = b0, n1 = b1;
    if (d0 + 1 < DQK / 16) { const int g = (d0 + 1) >> 2, e = (d0 + 1) & 3; const int ka = DQK == 128 ? kb[e + 4 * g] : kb[e] + g * 128;
      n0 = *(lp)(uintptr_t)(unsigned)(ks + ka); n1 = *(lp)(uintptr_t)(unsigned)(ks + ka + 32 * DQK * 2); }
    bf16x8 q;
    if (d0 < DQK / 16 - QL) q = qr[d0]; else q = *(lp)(uintptr_t)(unsigned)(qa + (d0 - (DQK / 16 - QL)) * 1024);
    AT_SBAR();
    if (AT_PRIO) __builtin_amdgcn_s_setprio(1);
    p0 = __builtin_amdgcn_mfma_f32_32x32x16_bf16(b0, q, p0, 0, 0, 0);
    p1 = __builtin_amdgcn_mfma_f32_32x32x16_bf16(b1, q, p1, 0, 0, 0);
    if (AT_PRIO) __builtin_amdgcn_s_setprio(0);
    AT_SBAR();
    b0 = n0; b1 = n1; }
#else
#pragma unroll
  for (int d0 = 0; d0 < DQK / 16; ++d0) { const int g = d0 >> 2, e = d0 & 3;
    const int ka = DQK == 128 ? kb[e + 4 * g] : kb[e] + g * 128;
    const bf16x8 b0 = *(lp)(uintptr_t)(unsigned)(ks + ka);
    const bf16x8 b1 = *(lp)(uintptr_t)(unsigned)(ks + ka + 32 * DQK * 2);
    bf16x8 q;
    if (d0 < DQK / 16 - QL) q = qr[d0]; else q = *(lp)(uintptr_t)(unsigned)(qa + (d0 - (DQK / 16 - QL)) * 1024);
    p0 = __builtin_amdgcn_mfma_f32_32x32x16_bf16(b0, q, p0, 0, 0, 0);
    p1 = __builtin_amdgcn_mfma_f32_32x32x16_bf16(b1, q, p1, 0, 0, 0);
    if (GRP > 0 && (d0 % (GRP > 0 ? GRP : 1)) == (GRP > 0 ? GRP : 1) - 1) AT_SBAR(); }
#endif
}
__device__ __forceinline__ int v_st(int k, int c) { const int kk = (k & ~0xC) | ((k & 4) << 1) | ((k & 8) >> 1); return ((kk >> 3) * 4 + (c >> 5)) * 512 + ((kk & 7) * 32 + (c & 31)) * 2; }
__device__ __forceinline__ int v_rd_base(int lane) { return ((lane & 3) << 3) | (((lane >> 2) & 3) << 6) | (((lane >> 4) & 1) << 5) | (((lane >> 5) & 1) << 8); }
constexpr int v_rd_off(int d0, int ks, int half) { return d0 * 512 + ks * 4096 + half * 2048; }
template <int OFF> __device__ __forceinline__ s16x4 tr_read(int vb) {
  s16x4 r; asm volatile("ds_read_b64_tr_b16 %0, %1 offset:%2" : "=&v"(r) : "v"(vb), "i"(OFF) : "memory"); return r;
}
struct VFrag { s16x4 l0, h0, l1, h1, l2, h2, l3, h3; };
template <int D0> __device__ __forceinline__ void pv_load(VFrag& f, int vb) {
  f.l0 = tr_read<v_rd_off(D0, 0, 0)>(vb); f.h0 = tr_read<v_rd_off(D0, 0, 1)>(vb); f.l1 = tr_read<v_rd_off(D0, 1, 0)>(vb); f.h1 = tr_read<v_rd_off(D0, 1, 1)>(vb);
  f.l2 = tr_read<v_rd_off(D0, 2, 0)>(vb); f.h2 = tr_read<v_rd_off(D0, 2, 1)>(vb); f.l3 = tr_read<v_rd_off(D0, 3, 0)>(vb); f.h3 = tr_read<v_rd_off(D0, 3, 1)>(vb);
}
#define AT_PK(L, H) (bf16x8){L[0], L[1], L[2], L[3], H[0], H[1], H[2], H[3]}
__device__ __forceinline__ void pv_mma(f32x16& od, const VFrag& f, bf16x8 pa0, bf16x8 pa1, bf16x8 pa2, bf16x8 pa3) {
  if (AT_PRIO) __builtin_amdgcn_s_setprio(1);
  od = __builtin_amdgcn_mfma_f32_32x32x16_bf16(pa0, AT_PK(f.l0, f.h0), od, 0, 0, 0);
  od = __builtin_amdgcn_mfma_f32_32x32x16_bf16(pa1, AT_PK(f.l1, f.h1), od, 0, 0, 0);
  od = __builtin_amdgcn_mfma_f32_32x32x16_bf16(pa2, AT_PK(f.l2, f.h2), od, 0, 0, 0);
  od = __builtin_amdgcn_mfma_f32_32x32x16_bf16(pa3, AT_PK(f.l3, f.h3), od, 0, 0, 0);
  if (AT_PRIO) __builtin_amdgcn_s_setprio(0);
}
template <int D0> __device__ __forceinline__ void pv_one(f32x16& od, int vb, bf16x8 pa0, bf16x8 pa1, bf16x8 pa2, bf16x8 pa3) {
  VFrag f; pv_load<D0>(f, vb);
  asm volatile("s_waitcnt lgkmcnt(0)" ::: "memory"); AT_SBAR();
  pv_mma(od, f, pa0, pa1, pa2, pa3);
}
__device__ __forceinline__ void pv_d0(f32x16* o, int vb, bf16x8 pa0, bf16x8 pa1, bf16x8 pa2, bf16x8 pa3) {
#if AT_VPIPE == 2
  VFrag fa, fb, fc;
  pv_load<0>(fa, vb); pv_load<1>(fb, vb); pv_load<2>(fc, vb);
  asm volatile("s_waitcnt lgkmcnt(15)" ::: "memory"); AT_SBAR();
  pv_mma(o[0], fa, pa0, pa1, pa2, pa3); AT_SBAR();
  pv_load<3>(fa, vb);
  asm volatile("s_waitcnt lgkmcnt(15)" ::: "memory"); asm volatile("s_waitcnt lgkmcnt(15)" ::: "memory"); AT_SBAR();
  pv_mma(o[1], fb, pa0, pa1, pa2, pa3); AT_SBAR();
  asm volatile("s_waitcnt lgkmcnt(8)" ::: "memory"); AT_SBAR();
  pv_mma(o[2], fc, pa0, pa1, pa2, pa3); AT_SBAR();
  asm volatile("s_waitcnt lgkmcnt(0)" ::: "memory"); AT_SBAR();
  pv_mma(o[3], fa, pa0, pa1, pa2, pa3);
#elif AT_VPIPE
  VFrag fa, fb;
  pv_load<0>(fa, vb); pv_load<1>(fb, vb);
  asm volatile("s_waitcnt lgkmcnt(8)" ::: "memory"); AT_SBAR();
  pv_mma(o[0], fa, pa0, pa1, pa2, pa3); AT_SBAR();
  pv_load<2>(fa, vb);
  asm volatile("s_waitcnt lgkmcnt(8)" ::: "memory"); AT_SBAR();
  pv_mma(o[1], fb, pa0, pa1, pa2, pa3); AT_SBAR();
  pv_load<3>(fb, vb);
  asm volatile("s_waitcnt lgkmcnt(8)" ::: "memory"); AT_SBAR();
  pv_mma(o[2], fa, pa0, pa1, pa2, pa3); AT_SBAR();
  asm volatile("s_waitcnt lgkmcnt(0)" ::: "memory"); AT_SBAR();
  pv_mma(o[3], fb, pa0, pa1, pa2, pa3);
#else
  pv_one<0>(o[0], vb, pa0, pa1, pa2, pa3); pv_one<1>(o[1], vb, pa0, pa1, pa2, pa3); pv_one<2>(o[2], vb, pa0, pa1, pa2, pa3); pv_one<3>(o[3], vb, pa0, pa1, pa2, pa3);
#endif
}
#undef AT_PK

template <int DQK, bool WIN>
__device__ __forceinline__ void attn_core1(const bf16* __restrict__ Qb, int ldq, const bf16* __restrict__ Kh, int ldk, const bf16* __restrict__ Vh, int ldv,
                                           int NT, float thr, float m_init, float l_init, int qrel0, char* lds, f32x16 (&o)[4], float (&rli)[16]) {
  constexpr int SHM_K = KVBLK * DQK * 2, CPR = DQK / 8, NKC = DQK / 64;
  int tid = threadIdx.x; asm volatile("" : "+v"(tid));
  const int wid = tid >> 6, lane = tid & 63, r32 = lane & 31, hi = lane >> 5;
  char* V_lds = lds; char* K_lds = lds + 2 * SHM_V;
  float* ws = (float*)(lds + 2 * SHM_V + 2 * SHM_K) + wid * 64; float* li_l = ws; float* al_l = ws + 32;
  float m_reg = m_init, l_reg = l_init, msh = m_init > -1e29f ? m_init : 0.f; bf16x8 qr[DQK / 16];
  f32x16 negm;
#pragma unroll
  for (int r = 0; r < 16; ++r) negm[r] = -msh;
#pragma unroll
  for (int d = 0; d < 4; ++d) o[d] = f32x16{};
  const bf16* Qw = Qb + (long)(wid * 32 + r32) * ldq + hi * 8;
#pragma unroll
  for (int d0 = 0; d0 < DQK / 16; ++d0) qr[d0] = *(gp8)(Qw + d0 * 16);
  const int qme = qrel0 + wid * 32 + r32;
  const int sr = tid >> 4, sc = (tid & 15) * 8, vst0 = v_st(sr, sc), vst1 = v_st(32 + sr, sc);
  const unsigned vgo0 = (unsigned)(sr * ldv + sc) * 2u, vgo1 = vgo0 + 64u * (unsigned)ldv;
  unsigned kgo[NKC]; int klo[NKC];
#pragma unroll
  for (int i = 0; i < NKC; ++i) { const int id = tid + 512 * i, row = id / CPR, ch = id % CPR; kgo[i] = (unsigned)(row * ldk + ch * 8) * 2u; klo[i] = kswz<DQK>(row, ch * 16); }
  const int vb0 = (int)(uintptr_t)V_lds + v_rd_base(lane);
  const int ksa = (int)(uintptr_t)K_lds; int kb[8];
#pragma unroll
  for (int e = 0; e < 8; ++e) kb[e] = (DQK == 128 || e < 4) ? kswz<DQK>(r32, ((((e & 3) << 1) | hi) + 8 * (e >> 2)) << 4) : 0;
  bf16x8 vs0, vs1, ks[NKC];
#define A1_LOAD(k0) do { const char* vb_ = (const char*)Vh + (size_t)(k0) * (size_t)ldv * 2; const char* kb_ = (const char*)Kh + (size_t)(k0) * (size_t)ldk * 2; \
    vs0 = *(gp8)(vb_ + vgo0); vs1 = *(gp8)(vb_ + vgo1); \
    _Pragma("unroll") for (int _c = 0; _c < NKC; ++_c) ks[_c] = *(gp8)(kb_ + kgo[_c]); } while (0)
#define A1_WRITE(b) do { *(bf16x8*)(V_lds + (b) * SHM_V + vst0) = vs0; *(bf16x8*)(V_lds + (b) * SHM_V + vst1) = vs1; \
    _Pragma("unroll") for (int _c = 0; _c < NKC; ++_c) *(bf16x8*)(K_lds + (b) * SHM_K + klo[_c]) = ks[_c]; } while (0)
  __syncthreads();
  A1_LOAD(0); A1_WRITE(0);
  if (NT > 1) A1_LOAD(KVBLK);
  __syncthreads();
  for (int j = 0; j < NT; ++j) {
    const int b = j & 1;
    f32x16 p0, p1; float al; bf16x8 pa0, pa1, pa2, pa3;
    qkt<DQK, 0, AT_GRP>(p0, p1, negm, ksa + b * SHM_K, kb, qr, 0, r32, hi);
    partialSM<WIN>(p0, p1, m_reg, msh, negm, al, thr, j * KVBLK - qme, hi);
    if (__any(al < 1.f)) { if (hi == 0) al_l[r32] = al; asm volatile("s_waitcnt lgkmcnt(0)" ::: "memory");
#pragma unroll
      for (int d = 0; d < 4; ++d)
#pragma unroll
        for (int r = 0; r < 16; ++r) o[d][r] *= al_l[crow(r, hi)]; }
    finishSM(p0, p1, al, l_reg, pa0, pa1, pa2, pa3);
    if (j + 1 < NT) { A1_WRITE(b ^ 1); if (j + 2 < NT) A1_LOAD((j + 2) * KVBLK); }
    AT_SBAR();
    pv_d0(o, vb0 + b * SHM_V, pa0, pa1, pa2, pa3);
    __syncthreads();
  }
  if (hi == 0) li_l[r32] = l_reg; asm volatile("s_waitcnt lgkmcnt(0)" ::: "memory");
#pragma unroll
  for (int r = 0; r < 16; ++r) rli[r] = __builtin_amdgcn_rcpf(li_l[crow(r, hi)]);
#undef A1_LOAD
#undef A1_WRITE
}
__device__ __forceinline__ void store_o(bf16* Ob, int ldo, const f32x16 (&o)[4], const float (&rli)[16]) {
  int tid = threadIdx.x; asm volatile("" : "+v"(tid));
  const int wid = tid >> 6, lane = tid & 63, r32 = lane & 31, hi = lane >> 5;
  bf16* Ow = Ob + (long)(wid * 32) * ldo + r32;
#pragma unroll
  for (int r = 0; r < 16; ++r) { const int orow = crow(r, hi);
#pragma unroll
    for (int d0 = 0; d0 < 4; ++d0) ((__attribute__((address_space(1))) bf16*)Ow)[(long)orow * ldo + d0 * 32] = (bf16)(cvtpk(o[d0][r] * rli[r], 0.f) & 0xffffu); }
}
}
namespace mk {
#define GAS __attribute__((address_space(1)))
#define LAS __attribute__((address_space(3)))
constexpr size_t MiB = 1u << 20;
constexpr size_t al256(size_t x) { return (x + 255) & ~(size_t)255; }
constexpr size_t WS_CTL = 0, CTL_ZERO_BYTES = 1 * MiB;
constexpr size_t WS_PART = WS_CTL + CTL_ZERO_BYTES;
constexpr size_t WS_PARTM = WS_PART + (size_t)20 * S * 8 * 4;
constexpr size_t WS_CS64 = WS_PARTM + (size_t)4 * 2 * S * 2 * 4;
constexpr size_t WS_CS128 = WS_CS64 + (size_t)S * 32 * 8;
constexpr size_t WS_H = WS_CS128 + (size_t)S * 64 * 8;
constexpr size_t WS_AN = WS_H + (size_t)S * D * 4;
constexpr size_t WS_HID = WS_AN + (size_t)S * D * 2;
constexpr size_t WS_QD = WS_HID + (size_t)S * DFF * 2;
constexpr size_t WS_KD = WS_QD + (size_t)S * 1024 * 2, WS_VD = WS_KD + (size_t)S * 1024 * 2;
constexpr size_t WS_CQR = WS_VD + (size_t)S * 1024 * 2, WS_CKVR = WS_CQR + (size_t)S * 512 * 2;
constexpr size_t WS_ACQ = WS_CKVR + (size_t)S * 512 * 2;
constexpr size_t WS_QG = WS_ACQ + (size_t)2 * S * 512 * 2, WS_KG = WS_QG + (size_t)S * 1024 * 2, WS_VG = WS_KG + (size_t)S * 256 * 2;
constexpr size_t WS_QM = WS_VG + (size_t)S * 256 * 2, WS_KM = WS_QM + (size_t)S * 1536 * 2, WS_VM = WS_KM + (size_t)S * 1536 * 2;
constexpr size_t WS_GATE = WS_VM + (size_t)S * 1024 * 2;
constexpr size_t WS_OB = WS_GATE + (size_t)S * 6144 * 2;
constexpr size_t WS_MG = WS_OB + (size_t)3 * S * 1024 * 2;
constexpr size_t WS_ATMP = WS_MG + (size_t)S * D * 2;
constexpr size_t WS_QX = WS_ATMP + (size_t)256 * 64 * 512 * 4, WS_OX = WS_QX + (size_t)S * 512 * 2;
constexpr size_t WS_MEMN = WS_OX + (size_t)S * 512 * 2;
constexpr size_t WS_KVX = WS_MEMN + (size_t)4 * 256 * D * 2;
constexpr size_t WS_WXKV = WS_KVX + (size_t)4 * 256 * 1024 * 2;
constexpr size_t WS_LW = WS_WXKV + (size_t)4 * 1024 * D * 2;
constexpr size_t LW_GU1 = 0, LW_DN1 = LW_GU1 + (size_t)2 * DFF * D, LW_IN = LW_DN1 + (size_t)D * DFF, LW_UQKV = LW_IN + (size_t)NIN * D, LW_BR = LW_UQKV + (size_t)(1536 + 2048) * 512,
                 LW_WO = LW_BR + (size_t)3 * D * 1024, LW_XQ = LW_WO + (size_t)D * D, LW_XO = LW_XQ + (size_t)512 * D, LW_GU2 = LW_XO + (size_t)D * 512, LW_DN2 = LW_GU2 + (size_t)2 * DFF * D,
                 LW_ELEMS = LW_DN2 + (size_t)D * DFF;
constexpr size_t WS_END = WS_LW + 4 * LW_ELEMS * 2;
constexpr int CW_BAR = 4096;
constexpr int RING_BYTES = 131072, MISC_OFF = RING_BYTES + 320, LDS_BYTES = 147456;
constexpr int NWAVES = 8;

typedef unsigned v4u __attribute__((ext_vector_type(4)));
#define LDS_WAIT() asm volatile("s_waitcnt lgkmcnt(0)" ::: "memory")
__device__ __forceinline__ unsigned f2bf(float f) { unsigned u = __builtin_bit_cast(unsigned, f); return (u + 0x7fffu + ((u >> 16) & 1u)) >> 16; }
__device__ __forceinline__ unsigned pk2(float lo, float hi) { return f2bf(lo) | (f2bf(hi) << 16); }
__device__ __forceinline__ float wave_sum(float v) {
#pragma unroll
    for (int o = 1; o < 64; o <<= 1) v += __shfl_xor(v, o);
    return v;
}

#define XB_TMO      128
#define XB_XCNT(j)  (256  + 64 * (j))
#define XB_XSUB(j)  (1280 + 64 * (j))
#define XB_XGEN(j)  (2304 + 64 * (j))
#define XB_TOP      3328
#define XB_TOPGEN   3392
#define XCD_BAR_WORDS 3456
#define XB_SPIN_CAP (1u << 18)
__device__ __forceinline__ unsigned xb_ld(unsigned* p)              { return __hip_atomic_load(p, __ATOMIC_RELAXED, __HIP_MEMORY_SCOPE_AGENT); }
__device__ __forceinline__ unsigned xb_add(unsigned* p, unsigned v) { return __hip_atomic_fetch_add(p, v, __ATOMIC_RELAXED, __HIP_MEMORY_SCOPE_AGENT); }
__device__ __forceinline__ unsigned xb_xcc_id() { return (unsigned)__builtin_amdgcn_s_getreg((3 << 11) | 20) & 0xFu; }
#define XB_SPIN(cond, bar) do { unsigned _sp = 0; while (cond) { __builtin_amdgcn_s_sleep(1); \
    if ((++_sp & 255u) == 0u) { if (xb_ld(&(bar)[XB_TMO])) break; if (_sp > XB_SPIN_CAP) { atomicAdd(&(bar)[XB_TMO], 1u); break; } } } } while (0)
struct XcdBarrier { unsigned* bar; unsigned x; volatile LAS unsigned* st; };
__device__ __forceinline__ XcdBarrier xcd_barrier_post(unsigned* bar, volatile LAS unsigned* st) {
    XcdBarrier b; b.bar = bar; b.x = xb_xcc_id(); b.st = st;
    if (threadIdx.x == 0) (void)xb_add(&bar[XB_XCNT(b.x)], 1u);
    return b;
}
__device__ __forceinline__ void xcd_barrier_complete(unsigned* bar, unsigned x, unsigned& nloc, unsigned& nx) {
    const unsigned G = gridDim.x * gridDim.y * gridDim.z;
    unsigned sum, cnt, mine, sp = 0u;
    for (;;) {
        sum = 0u; cnt = 0u; mine = 0u;
#pragma unroll
        for (unsigned j = 0; j < 16; ++j) { const unsigned c = xb_ld(&bar[XB_XCNT(j)]); sum += c; cnt += (c > 0u) ? 1u : 0u; mine = (j == x) ? c : mine; }
        if (sum == G) break;
        __builtin_amdgcn_s_sleep(1);
        if ((++sp & 255u) == 0u) { if (xb_ld(&bar[XB_TMO])) break; if (sp > XB_SPIN_CAP) { atomicAdd(&bar[XB_TMO], 1u); break; } }
    }
    nloc = mine > 0u ? mine : 1u; nx = cnt > 0u ? cnt : 1u;
}
__device__ __forceinline__ void xcd_barrier(const XcdBarrier& b) {
    asm volatile("s_waitcnt vmcnt(0)" ::: "memory");
    __syncthreads();
    if (threadIdx.x == 0) {
        unsigned* bar = b.bar; asm volatile("" : "+s"(bar));
        __builtin_amdgcn_s_waitcnt(0);
        unsigned nloc = b.st[0], nx = b.st[1];
        if (nloc == 0u) { xcd_barrier_complete(bar, b.x, nloc, nx); b.st[0] = nloc; b.st[1] = nx; }
        const unsigned old = xb_add(&bar[XB_XSUB(b.x)], 1u);
        const unsigned gen = old / nloc;
        if (old + 1u == (gen + 1u) * nloc) {
            __builtin_amdgcn_fence(__ATOMIC_RELEASE, "agent");
            asm volatile("s_waitcnt vmcnt(0)" ::: "memory");
            const unsigned og = xb_add(&bar[XB_TOP], 1u);
            const unsigned tg = og / nx;
            if (og + 1u == (tg + 1u) * nx) xb_add(&bar[XB_TOPGEN], 1u);
            else XB_SPIN(xb_ld(&bar[XB_TOPGEN]) == tg, bar);
            __builtin_amdgcn_fence(__ATOMIC_ACQUIRE, "agent");
            xb_add(&bar[XB_XGEN(b.x)], 1u);
            asm volatile("s_waitcnt vmcnt(0)" ::: "memory");
        } else {
            XB_SPIN(xb_ld(&bar[XB_XGEN(b.x)]) == gen, bar);
            __builtin_amdgcn_fence(__ATOMIC_ACQUIRE, "agent");
            asm volatile("s_waitcnt vmcnt(0)" ::: "memory");
        }
    }
    __syncthreads();
}

struct Args { const void* in[28]; float* out; unsigned char* ws; int ph_lo, ph_hi; };

__device__ __forceinline__ int perm64(int p) { const int a = p >> 3, j = p & 7; return j < 4 ? 4 * a + j : 32 + 4 * a + (j - 4); }
__device__ __forceinline__ int perm128(int p) { const int a = p >> 3, j = p & 7; return j < 4 ? 4 * a + j : 64 + 4 * a + (j - 4); }
__device__ __forceinline__ int srccol(int kind, int n) {
    if (kind == 0) return n;
    if (kind == 1) { const int pn = n >> 8, j = n & 255; return j < 128 ? pn * 128 + j : DFF + pn * 128 + (j - 128); }
    if (kind == 2) {
        if (n < 2048) return (n & ~63) + perm64(n & 63);
        if (n < 4096) return n;
        if (n < 5376) { const int m = n - 4096; return 4160 + (m & ~127) + perm128(m & 127); }
        if (n < 5632) return 5440 + (n - 5376);
        const int j = n - 5632; return j < 64 ? 4096 + perm64(j) : -1;
    }
    { const int h = n / 192, p = n - 192 * h; return p < 128 ? n : h * 192 + 128 + perm64(p - 128); }
}
__device__ __forceinline__ void cvt_matrix(const float* W, int ldw, int K, int Nd, bf16_t* WT, int kind, const float* gain, LAS float* scr, int gw, int NGW, int lane, int f0 = 0, int f1 = 16) {
    const int nblk = Nd / 32, nitems = (K / 64) * nblk, items = (int)((long)nitems * f1 / 16), item0 = (int)((long)nitems * f0 / 16);
    const int l8 = lane & 7, r8 = lane >> 3;
    f32x4 v[8]; float gv[8];
    int it = item0 + gw;
#define CVT_LOAD(item) do { const int kb_ = (item) / nblk, nb_ = (item) - kb_ * nblk; const int sc_ = srccol(kind, 32 * nb_ + 4 * l8); \
        const float* wp_ = W + (size_t)(64 * kb_ + r8) * ldw + (sc_ >= 0 ? sc_ : 0); \
        _Pragma("unroll") for (int i = 0; i < 8; ++i) v[i] = __builtin_nontemporal_load((const GAS f32x4*)(wp_ + (size_t)(8 * i) * ldw)); \
        if (gain) { _Pragma("unroll") for (int i = 0; i < 8; ++i) gv[i] = ((const GAS float*)gain)[64 * kb_ + 8 * i + r8]; } else { _Pragma("unroll") for (int i = 0; i < 8; ++i) gv[i] = 1.f; } \
        if (sc_ < 0) { _Pragma("unroll") for (int i = 0; i < 8; ++i) gv[i] = 0.f; } } while (0)
    if (it < items) CVT_LOAD(it);
    while (it < items) {
        const int kb = it / nblk, nb = it - kb * nblk, k0 = 64 * kb, n0 = 32 * nb;
#pragma unroll
        for (int i = 0; i < 8; ++i) { const int kk = 8 * i + r8; const f32x4 x = v[i] * gv[i];
            LAS float* d = scr + kk * 33 + 4 * l8; d[0] = x[0]; d[1] = x[1]; d[2] = x[2]; d[3] = x[3]; }
        const int nit = it + NGW;
        if (nit < items) CVT_LOAD(nit);
        LDS_WAIT(); asm volatile("" ::: "memory");
#pragma unroll
        for (int j = 0; j < 4; ++j) { const int n = r8 + 8 * j; const LAS float* s = scr + (8 * l8) * 33 + n;
            v4u o; o.x = pg8::cvt_pk_bf16(s[0 * 33], s[1 * 33]); o.y = pg8::cvt_pk_bf16(s[2 * 33], s[3 * 33]); o.z = pg8::cvt_pk_bf16(s[4 * 33], s[5 * 33]); o.w = pg8::cvt_pk_bf16(s[6 * 33], s[7 * 33]);
            *(GAS v4u*)(WT + (size_t)(n0 + n) * K + k0 + 8 * l8) = o; }
        LDS_WAIT(); asm volatile("" ::: "memory");
        it = nit;
    }
#undef CVT_LOAD
}
__device__ __forceinline__ void norm_row_bf16(const float* xrow, const float* g, bf16_t* orow, int lane) {
    const f32x4* xr = (const f32x4*)xrow + lane; const f32x4* gr = (const f32x4*)g + lane;
    f32x4 v[8]; float s = 0.f;
#pragma unroll
    for (int j = 0; j < 8; ++j) { v[j] = xr[64 * j]; s += (v[j][0] * v[j][0] + v[j][1] * v[j][1]) + (v[j][2] * v[j][2] + v[j][3] * v[j][3]); }
    const float r = rsqrtf(wave_sum(s) * (1.f / D) + 1e-6f);
    unsigned long long* o8 = (unsigned long long*)orow + lane;
#pragma unroll
    for (int j = 0; j < 8; ++j) { const f32x4 gg = gr[64 * j]; o8[64 * j] = (unsigned long long)pk2(v[j][0] * r * gg[0], v[j][1] * r * gg[1]) | ((unsigned long long)pk2(v[j][2] * r * gg[2], v[j][3] * r * gg[3]) << 32); }
}
__device__ __forceinline__ void diff_unit(const bf16_t* QD, const bf16_t* KD, const bf16_t* VD, float* atmp, bf16_t* OB0, const float* subln, float lam, float one_m_li, int h, int qb, char* lds) {
    int tid = threadIdx.x; asm volatile("" : "+v"(tid));
    const int lane = tid & 63, r32 = lane & 31;
    at::f32x16 o[4]; float rli[16];
    f32x4* tp = (f32x4*)(atmp + ((size_t)blockIdx.x * 512 + tid) * 64);
    for (int c = 0; c < 2; ++c) {
        at::attn_core1<64, false>(QD + (size_t)qb * 256 * 1024 + (2 * h + c) * 64, 1024, KD + (2 * h + c) * 64, 1024, VD + h * 128, 1024, S / 64, at::THR * LOG2E, -1e30f, 0.f, 0, lds, o, rli);
        if (c == 0) {
#pragma unroll
            for (int d0 = 0; d0 < 4; ++d0)
#pragma unroll
                for (int r4 = 0; r4 < 4; ++r4) tp[d0 * 4 + r4] = (f32x4){o[d0][4 * r4] * rli[4 * r4], o[d0][4 * r4 + 1] * rli[4 * r4 + 1], o[d0][4 * r4 + 2] * rli[4 * r4 + 2], o[d0][4 * r4 + 3] * rli[4 * r4 + 3]};
        }
    }
    float ss[16];
#pragma unroll
    for (int r = 0; r < 16; ++r) ss[r] = 0.f;
#pragma unroll
    for (int d0 = 0; d0 < 4; ++d0) {
#pragma unroll
        for (int r4 = 0; r4 < 4; ++r4) { const f32x4 t = tp[d0 * 4 + r4];
#pragma unroll
            for (int j = 0; j < 4; ++j) { const int r = 4 * r4 + j; const float v = t[j] - lam * (o[d0][r] * rli[r]); o[d0][r] = v; ss[r] += v * v; } }
        asm volatile("" ::: "memory"); }
#pragma unroll
    for (int r = 0; r < 16; ++r) { float s = ss[r]; s += __shfl_xor(s, 1); s += __shfl_xor(s, 2); s += __shfl_xor(s, 4); s += __shfl_xor(s, 8); s += __shfl_xor(s, 16);
        rli[r] = rsqrtf(s * (1.f / 128.f) + 1e-5f) * one_m_li; }
#pragma unroll
    for (int d0 = 0; d0 < 4; ++d0) { const float g = subln[d0 * 32 + r32];
#pragma unroll
        for (int r = 0; r < 16; ++r) o[d0][r] *= g; }
    at::store_o(OB0 + (size_t)qb * 256 * 1024 + h * 128, 1024, o, rli);
}
__device__ __forceinline__ void mla_unit(const bf16_t* QM, const bf16_t* KM, const bf16_t* VM, bf16_t* OB1, int h, int qb, char* lds) {
    at::f32x16 o[4]; float rli[16];
    at::attn_core1<192, false>(QM + (size_t)qb * 256 * 1536 + h * 192, 1536, KM + h * 192, 1536, VM + h * 128, 1024, S / 64, at::THR * LOG2E, -1e30f, 0.f, 0, lds, o, rli);
    at::store_o(OB1 + (size_t)qb * 256 * 1024 + h * 128, 1024, o, rli);
}
__device__ __forceinline__ void gqa_unit(const bf16_t* QG, const bf16_t* KG, const bf16_t* VG, bf16_t* OB2, const float* sink, int h, int qb, char* lds) {
    at::f32x16 o[4]; float rli[16];
    int k0 = qb * 256 - 128; if (k0 < 0) k0 = 0; int k1 = qb * 256 + 384; if (k1 > S) k1 = S;
    const int kvh = h >> 2;
    at::attn_core1<128, true>(QG + (size_t)qb * 256 * 1024 + h * 128, 1024, KG + (size_t)k0 * 256 + kvh * 128, 256, VG + (size_t)k0 * 256 + kvh * 128, 256, (k1 - k0) / 64,
                             at::THR * LOG2E, sink[h] * LOG2E, 1.f, qb * 256 - k0, lds, o, rli);
    at::store_o(OB2 + (size_t)qb * 256 * 1024 + h * 128, 1024, o, rli);
}
__device__ __forceinline__ void xattn_unit(const bf16_t* QX, const bf16_t* KVX, bf16_t* OX, int h, int qb, char* lds) {
    at::f32x16 o[4]; float rli[16];
    at::attn_core1<128, false>(QX + (size_t)qb * 256 * 512 + h * 128, 512, KVX + h * 128, 1024, KVX + 512 + h * 128, 1024, MEMLEN / 64, at::THR * LOG2E, -1e30f, 0.f, 0, lds, o, rli);
    at::store_o(OX + (size_t)qb * 256 * 512 + h * 128, 512, o, rli);
}

constexpr int PH_PER_LAYER = 12, N_PHASES = 2 + DEPTH * PH_PER_LAYER + 1;

__device__ __forceinline__ unsigned char* ldptr(volatile LAS unsigned* PT, int i) {
    const unsigned lo = PT[2 * i], hi = PT[2 * i + 1];
    return (unsigned char*)(((unsigned long long)(unsigned)__builtin_amdgcn_readfirstlane((int)hi) << 32) | (unsigned)__builtin_amdgcn_readfirstlane((int)lo));
}
#define PIN(i) ((const float*)ldptr(PT, (i)))
#define WSP(T, off) ((T*)(ws + (off)))
#define PHASE_BEGIN() int tid = threadIdx.x; asm volatile("" : "+v"(tid)); const int lane = tid & 63, wave = __builtin_amdgcn_readfirstlane(tid >> 6), gw = bx * NWAVES + wave; \
    unsigned char* ws = ldptr(PT, 29); (void)lane; (void)gw; (void)ws

__device__ __forceinline__ void cvt_layer_part(volatile LAS unsigned* PT, unsigned char* ws, int l, int part, LAS float* scr, int gw, int NGW, int lane) {
    bf16_t* lw = WSP(bf16_t, WS_LW) + (size_t)l * LW_ELEMS;
    if (part == 0) cvt_matrix(PIN(4) + (size_t)l * D * 2 * DFF, 2 * DFF, D, 2 * DFF, lw + LW_GU1, 1, PIN(3) + (size_t)l * D, scr, gw, NGW, lane);
    if (part == 1) cvt_matrix(PIN(25) + (size_t)l * D * 2 * DFF, 2 * DFF, D, 2 * DFF, lw + LW_GU2, 1, PIN(24) + (size_t)l * D, scr, gw, NGW, lane);
    if (part == 2) {
        cvt_matrix(PIN(12) + (size_t)l * 512 * 1536, 1536, 512, 1536, lw + LW_UQKV, 3, PIN(10) + (size_t)l * 512, scr, gw, NGW, lane);
        cvt_matrix(PIN(13) + (size_t)l * 512 * 2048, 2048, 512, 2048, lw + LW_UQKV + (size_t)1536 * 512, 0, PIN(11) + (size_t)l * 512, scr, gw, NGW, lane);
        cvt_matrix(PIN(21) + (size_t)l * D * 512, 512, D, 512, lw + LW_XQ, 0, PIN(19) + (size_t)l * D, scr, gw, NGW, lane);
        cvt_matrix(PIN(23) + (size_t)l * 512 * D, D, 512, D, lw + LW_XO, 0, nullptr, scr, gw, NGW, lane);
        cvt_matrix(PIN(18) + (size_t)l * D * D, D, D, D, lw + LW_WO, 0, nullptr, scr, gw, NGW, lane);
        for (int n = 0; n < 3; ++n) cvt_matrix(PIN(15) + ((size_t)l * 3 + n) * 1024 * D, D, 1024, D, lw + LW_BR + (size_t)n * D * 1024, 0, nullptr, scr, gw, NGW, lane);
        cvt_matrix(PIN(5) + (size_t)l * DFF * D, D, DFF, D, lw + LW_DN1, 0, nullptr, scr, gw, NGW, lane);
    }
}
constexpr int NCVTD = 27;
__device__ __forceinline__ void cvt_desc_geom(int t, int& l, int& ty, int& f0, int& f1) {
    f0 = 0; f1 = 16;
    if (t < 14) { l = 0; ty = t; }
    else if (t < 23) { const int q = (t - 14) / 3, r = (t - 14) - 3 * q; l = 1 + q; ty = r == 0 ? 8 : r == 1 ? 9 : 13; }
    else { l = t - 23; ty = 14; }
}
__device__ __forceinline__ void cvt_desc_kn(int ty, int& K, int& Nd) {
    K = D; Nd = D;
    if (ty <= 1) Nd = 2 * DFF; else if (ty == 2) { K = 512; Nd = 1536; } else if (ty == 3) { K = 512; Nd = 2048; } else if (ty == 4) Nd = 512; else if (ty == 5) K = 512;
    else if (ty == 7 || ty == 13) K = DFF; else if (ty == 8) Nd = 5888; else if (ty == 9) Nd = 3 * D; else if (ty >= 10 && ty <= 12) K = 1024; else if (ty == 14) Nd = 1024;
}
__device__ __forceinline__ int cvt_desc_cnt(int t, int& item0) {
    int l, ty, f0, f1, K, Nd; cvt_desc_geom(t, l, ty, f0, f1); cvt_desc_kn(ty, K, Nd);
    const int nitems = (K / 64) * (Nd / 32); item0 = (int)((long)nitems * f0 / 16); return (int)((long)nitems * f1 / 16) - item0;
}
__device__ __forceinline__ unsigned long long ldptr_v(volatile LAS unsigned* PT, int i) { return ((unsigned long long)PT[2 * i + 1] << 32) | PT[2 * i]; }
__device__ __forceinline__ void cvt_desc_fill(int t, volatile LAS unsigned* PT, volatile LAS unsigned* DT) {
    int start = 0, dummy;
    for (int u = 0; u < t && u < NCVTD; ++u) start += cvt_desc_cnt(u, dummy);
    if (t == NCVTD) { DT[t * 12 + 11] = (unsigned)start; return; }
    int l, ty, f0, f1, K, Nd, item0; cvt_desc_geom(t, l, ty, f0, f1); cvt_desc_kn(ty, K, Nd); (void)cvt_desc_cnt(t, item0);
    int pw = 0, pg = -1, kind = 0, ldw = Nd; size_t wo = 0, go = (size_t)l * D, dst = 0;
    switch (ty) {
        case 0: pw = 4; wo = (size_t)l * D * 2 * DFF; pg = 3; kind = 1; dst = LW_GU1; break;
        case 1: pw = 25; wo = (size_t)l * D * 2 * DFF; pg = 24; kind = 1; dst = LW_GU2; break;
        case 2: pw = 12; wo = (size_t)l * 512 * 1536; pg = 10; go = (size_t)l * 512; kind = 3; dst = LW_UQKV; break;
        case 3: pw = 13; wo = (size_t)l * 512 * 2048; pg = 11; go = (size_t)l * 512; dst = LW_UQKV + (size_t)1536 * 512; break;
        case 4: pw = 21; wo = (size_t)l * D * 512; pg = 19; dst = LW_XQ; break;
        case 5: pw = 23; wo = (size_t)l * 512 * D; dst = LW_XO; break;
        case 6: pw = 18; wo = (size_t)l * D * D; dst = LW_WO; break;
        case 7: pw = 5; wo = (size_t)l * DFF * D; dst = LW_DN1; break;
        case 8: pw = 7; wo = (size_t)l * D * DIN; ldw = DIN; pg = 6; kind = 2; dst = LW_IN; break;
        case 9: pw = 16; wo = (size_t)l * D * 3 * D; pg = 6; dst = LW_IN + (size_t)5888 * D; break;
        case 10: case 11: case 12: pw = 15; wo = ((size_t)l * 3 + (ty - 10)) * 1024 * D; dst = LW_BR + (size_t)(ty - 10) * D * 1024; break;
        case 13: pw = 26; wo = (size_t)l * DFF * D; dst = LW_DN2; break;
        default: pw = 22; wo = (size_t)l * D * 1024; break;
    }
    const unsigned long long wsb = ldptr_v(PT, 29);
    const unsigned long long W = ldptr_v(PT, pw) + 4ull * wo, G_ = pg >= 0 ? ldptr_v(PT, pg) + 4ull * go : 0ull;
    const unsigned long long WT = ty == 14 ? wsb + WS_WXKV + 2ull * ((size_t)l * 1024 * D) : wsb + WS_LW + 2ull * ((size_t)l * LW_ELEMS + dst);
    volatile LAS unsigned* d = DT + t * 12;
    d[0] = (unsigned)W; d[1] = (unsigned)(W >> 32); d[2] = (unsigned)WT; d[3] = (unsigned)(WT >> 32); d[4] = (unsigned)G_; d[5] = (unsigned)(G_ >> 32);
    d[6] = (unsigned)ldw; d[7] = (unsigned)K; d[8] = (unsigned)(Nd / 32); d[9] = (unsigned)kind; d[10] = (unsigned)item0; d[11] = (unsigned)start;
}
template <int MODE = 0> __device__ __forceinline__ void cvt_flat(volatile LAS unsigned* DT, LAS float* scr, int gw, int NGW, int lane) {
#define DW(m_, j_) __builtin_amdgcn_readfirstlane((int)DT[(m_) * 12 + (j_)])
#define DP(m_, j_) (((unsigned long long)(unsigned)DW(m_, (j_) + 1) << 32) | (unsigned)DW(m_, j_))
    const int total = DW(NCVTD, 11);
    const int l8 = lane & 7, r8 = lane >> 3;
    f32x4 v[8]; float gv[8];
    int it = gw, m = 0;
    bf16_t* WTn = nullptr; int Kn = 0, k0n = 0, n0n = 0;
#define FLAT_LOAD(item) do { while ((item) >= DW(m + 1, 11)) ++m; \
        const int loc_ = (item) - DW(m, 11) + DW(m, 10), nblk_ = DW(m, 8), kind_ = DW(m, 9), ldw_ = DW(m, 6); \
        const int kb_ = loc_ / nblk_, nb_ = loc_ - kb_ * nblk_; const int sc_ = srccol(kind_, 32 * nb_ + 4 * l8); \
        const float* wp_ = (const float*)DP(m, 0) + (size_t)(64 * kb_ + r8) * ldw_ + (sc_ >= 0 ? sc_ : 0); \
        _Pragma("unroll") for (int i = 0; i < 8; ++i) { if (MODE == 2) { v[i] = (f32x4){0.f, 0.f, 0.f, 0.f}; asm volatile("" : "+v"(v[i]) : "v"(wp_)); } else v[i] = __builtin_nontemporal_load((const GAS f32x4*)(wp_ + (size_t)(8 * i) * ldw_)); } \
        const float* g_ = (const float*)DP(m, 4); \
        if (g_) { _Pragma("unroll") for (int i = 0; i < 8; ++i) gv[i] = ((const GAS float*)g_)[64 * kb_ + 8 * i + r8]; } else { _Pragma("unroll") for (int i = 0; i < 8; ++i) gv[i] = 1.f; } \
        if (sc_ < 0) { _Pragma("unroll") for (int i = 0; i < 8; ++i) gv[i] = 0.f; } \
        WTn = (bf16_t*)DP(m, 2); Kn = DW(m, 7); k0n = 64 * kb_; n0n = 32 * nb_; } while (0)
    if (it < total) FLAT_LOAD(it);
    while (it < total) {
        bf16_t* WT = WTn; const int K = Kn, k0 = k0n, n0 = n0n;
#pragma unroll
        for (int i = 0; i < 8; ++i) { const int kk = 8 * i + r8; const f32x4 x = v[i] * gv[i];
            LAS float* d = scr + kk * 33 + 4 * l8; d[0] = x[0]; d[1] = x[1]; d[2] = x[2]; d[3] = x[3]; }
        const int nit = it + NGW;
        if (nit < total) FLAT_LOAD(nit);
        LDS_WAIT(); asm volatile("" ::: "memory");
#pragma unroll
        for (int j = 0; j < 4; ++j) { const int n = r8 + 8 * j; const LAS float* s = scr + (8 * l8) * 33 + n;
            v4u o; o.x = pg8::cvt_pk_bf16(s[0 * 33], s[1 * 33]); o.y = pg8::cvt_pk_bf16(s[2 * 33], s[3 * 33]); o.z = pg8::cvt_pk_bf16(s[4 * 33], s[5 * 33]); o.w = pg8::cvt_pk_bf16(s[6 * 33], s[7 * 33]);
            if (MODE == 1) asm volatile("" :: "v"(o), "v"(WT + (size_t)(n0 + n) * K + k0 + 8 * l8)); else *(GAS v4u*)(WT + (size_t)(n0 + n) * K + k0 + 8 * l8) = o; }
        LDS_WAIT(); asm volatile("" ::: "memory");
        it = nit;
    }
#undef FLAT_LOAD
#undef DP
#undef DW
}
constexpr int CVT_WG = 16;
__device__ __forceinline__ bool in_rng(int k, int lo, int hi) { asm volatile("" : "+s"(k)); return lo <= k && k < hi; }
__global__ void __launch_bounds__(NWAVES * 64, 2) mega(Args args) {
    extern __shared__ __attribute__((aligned(16))) unsigned char lds_raw[];
    LAS unsigned char* lds = (LAS unsigned char*)lds_raw;
    volatile LAS unsigned* MISC = (volatile LAS unsigned*)(lds + MISC_OFF);
    volatile LAS unsigned* PT = (volatile LAS unsigned*)(lds + MISC_OFF + 256);
    const int G = gridDim.x, bx = blockIdx.x, NGW = G * NWAVES;
    for (int u = threadIdx.x; u < (LDS_BYTES - RING_BYTES) / 4; u += NWAVES * 64) ((LAS unsigned*)(lds + RING_BYTES))[u] = 0u;
    __syncthreads();
    if (threadIdx.x == 0) {
#define PT_SET(i, p) do { const unsigned long long v_ = (unsigned long long)(p); PT[2 * (i)] = (unsigned)v_; PT[2 * (i) + 1] = (unsigned)(v_ >> 32); } while (0)
        PT_SET(0, args.in[0]); PT_SET(1, args.in[1]); PT_SET(2, args.in[2]); PT_SET(3, args.in[3]); PT_SET(4, args.in[4]); PT_SET(5, args.in[5]); PT_SET(6, args.in[6]);
        PT_SET(7, args.in[7]); PT_SET(8, args.in[8]); PT_SET(9, args.in[9]); PT_SET(10, args.in[10]); PT_SET(11, args.in[11]); PT_SET(12, args.in[12]); PT_SET(13, args.in[13]);
        PT_SET(14, args.in[14]); PT_SET(15, args.in[15]); PT_SET(16, args.in[16]); PT_SET(17, args.in[17]); PT_SET(18, args.in[18]); PT_SET(19, args.in[19]); PT_SET(20, args.in[20]);
        PT_SET(21, args.in[21]); PT_SET(22, args.in[22]); PT_SET(23, args.in[23]); PT_SET(24, args.in[24]); PT_SET(25, args.in[25]); PT_SET(26, args.in[26]); PT_SET(27, args.in[27]);
        PT_SET(28, args.out); PT_SET(29, args.ws);
#undef PT_SET
    }
    __syncthreads();
#if MK_PER_PHASE
#define GRID_BAR() do { } while (0)
#else
    XcdBarrier bar = xcd_barrier_post((unsigned*)(args.ws + WS_CTL) + CW_BAR, MISC + 8);
#if MK_STAMP >= 0
    int nbar = 0; unsigned long long st0 = __builtin_amdgcn_s_memrealtime(), st1 = st0;
#define GRID_BAR() do { xcd_barrier(bar); if (nbar == MK_STAMP - 1) st0 = __builtin_amdgcn_s_memrealtime(); if (nbar == MK_STAMP) st1 = __builtin_amdgcn_s_memrealtime(); ++nbar; } while (0)
#else
#define GRID_BAR() xcd_barrier(bar)
#endif
#endif
    const int lo = args.ph_lo, hi = args.ph_hi;
#define IN(k) in_rng((k), lo, hi)
#define PH_ON(j) (MK_ONLY < 0 || MK_ONLY == (j))
#define BOTH(k) (IN(k) && IN((k) + 1))

    if (PH_ON(0) && IN(0)) {
        PHASE_BEGIN();
        LAS float* scr = (LAS float*)(lds + wave * 16384);
        bf16_t* WXKV = WSP(bf16_t, WS_WXKV); bf16_t* MEMN = WSP(bf16_t, WS_MEMN);
        { volatile LAS unsigned* DT = (volatile LAS unsigned*)(lds + RSS_LDS_OFF);
          if (tid <= NCVTD) cvt_desc_fill(tid, PT, DT);
          __syncthreads();
          if (MK_DUP == 101) cvt_flat<1>(DT, scr, gw, NGW, lane);
          if (MK_DUP == 102) cvt_flat<2>(DT, scr, gw, NGW, lane);
          for (int rep = 0; rep < (MK_DUP == 100 ? 2 : 1); ++rep) cvt_flat<0>(DT, scr, gw, NGW, lane);
          __syncthreads(); }
        for (int l = 0; l < DEPTH; ++l)
            for (int m = gw; m < MEMLEN; m += NGW) norm_row_bf16(PIN(1) + (size_t)m * D, PIN(20) + (size_t)l * D, MEMN + ((size_t)l * MEMLEN + m) * D, lane);
        { float2* CS64 = WSP(float2, WS_CS64); float2* CS128 = WSP(float2, WS_CS128); const int* pos = (const int*)PIN(2);
          for (int idx = bx * 512 + tid; idx < S * 96; idx += G * 512) {
            const int s = idx / 96, j = idx - 96 * s; const int dim = j < 32 ? 64 : 128, i = j < 32 ? j : j - 32;
            const float inv = powf(10000.0f, -((float)(2 * i) / (float)dim)); const float ang = (float)pos[s] * inv;
            const float2 v = make_float2(cosf(ang), sinf(ang));
            if (j < 32) CS64[s * 32 + i] = v; else CS128[s * 64 + i] = v; } }
        { const float* x = PIN(0); bf16_t* AN = WSP(bf16_t, WS_AN); _Float16* H16 = WSP(_Float16, WS_H); rss_t* RSS0 = (rss_t*)(ws + WS_PART);
          for (int m = gw; m < S; m += NGW) {
            const GAS f32x4* xr = (const GAS f32x4*)(x + (size_t)m * D) + lane; GAS unsigned long long* o8 = (GAS unsigned long long*)(AN + (size_t)m * D) + lane; float s = 0.f;
            typedef _Float16 h16x4 __attribute__((ext_vector_type(4))); GAS h16x4* h8 = (GAS h16x4*)(H16 + (size_t)m * D) + lane;
            f32x4 xv[8];
#pragma unroll
            for (int j = 0; j < 8; ++j) xv[j] = xr[64 * j];
#pragma unroll
            for (int j = 0; j < 8; ++j) { const f32x4 v = xv[j]; s += (v[0] * v[0] + v[1] * v[1]) + (v[2] * v[2] + v[3] * v[3]);
                o8[64 * j] = (unsigned long long)pg8::cvt_pk_bf16(v[0], v[1]) | ((unsigned long long)pg8::cvt_pk_bf16(v[2], v[3]) << 32); h8[64 * j] = __builtin_convertvector(v, h16x4); }
            s = wave_sum(s); if (lane < 8) RSS0[(size_t)m * 8 + lane] = lane == 0 ? s : 0.f; } }
        if (BOTH(0)) GRID_BAR();
    }
    for (int l = 0; l < DEPTH; ++l) {
        const int pb = 2 + l * PH_PER_LAYER;
        const float lambda_init = 0.8f - 0.6f * expf(-0.3f * (float)l);
#define NREP(j) ((MK_DUP == (j) && l == 0) ? 2 : 1)
#define LWP(off) (WSP(bf16_t, WS_LW) + (size_t)l * LW_ELEMS + (off))
#define RSSP(k) ((rss_t*)(ws + WS_PART) + (size_t)(4 * l + (k)) * S * 8)
#define RSSMP() ((rss_t*)(ws + WS_PARTM) + (size_t)l * 2 * S * 2)
        for (int rep = 0; rep < NREP(0); ++rep) if (PH_ON(2 + 0) && IN(pb + 0)) {
            PHASE_BEGIN();
            const int gg = (l + 1 < DEPTH && rep == 0) ? G - CVT_WG : G;
            if (bx >= gg) cvt_layer_part(PT, ws, l + 1, 0, (LAS float*)(lds + wave * 16384), (bx - gg) * NWAVES + wave, CVT_WG * NWAVES, lane);
            else {
            pg8::Gemm g{WSP(bf16_t, WS_AN), LWP(LW_GU1), S, 2 * DFF, D}; pg8::StaticOrder O; O.init(S, 2 * DFF, gg, bx); EpiSwiglu E{WSP(bf16_t, WS_HID), RSSP(0), lds, 64 * (4 * l + 0) + 1};
            pg8::gemm_phase<EpiSwiglu, pg8::StaticOrder>(lds, g, O, E);
            }
            if (BOTH(pb + 0)) GRID_BAR();
        }
        for (int rep = 0; rep < NREP(1); ++rep) if (PH_ON(2 + 1) && IN(pb + 1)) {
            PHASE_BEGIN();
            pg8::Gemm g{WSP(bf16_t, WS_HID), LWP(LW_DN1), S, D, DFF}; pg8::StaticOrder O; O.init(S, D, G, bx); EpiResid E{WSP(_Float16, WS_H), WSP(bf16_t, WS_AN), rep ? 0.f : 0.5f, rep == 0, RSSP(1), lds};
            pg8::gemm_phase<EpiResid, pg8::StaticOrder>(lds, g, O, E);
            if (BOTH(pb + 1)) GRID_BAR();
        }
        for (int rep = 0; rep < NREP(2); ++rep) if (PH_ON(2 + 2) && IN(pb + 2)) {
            PHASE_BEGIN();
#if MK_SPLIT_IN
            pg8::Gemm g{WSP(bf16_t, WS_AN), LWP(LW_IN), S, 5888, D}; pg8::StaticOrder O; O.init(S, 5888, G, bx);
#else
            pg8::Gemm g{WSP(bf16_t, WS_AN), LWP(LW_IN), S, NIN, D}; pg8::StaticOrder O; O.init(S, NIN, G, bx);
#endif
            EpiIn E{WSP(bf16_t, WS_QD), WSP(bf16_t, WS_KD), WSP(bf16_t, WS_VD), WSP(bf16_t, WS_CQR), WSP(bf16_t, WS_CKVR), WSP(bf16_t, WS_QG), WSP(bf16_t, WS_KG), WSP(bf16_t, WS_VG), WSP(bf16_t, WS_KM),
                    WSP(bf16_t, WS_GATE), WSP(float2, WS_CS64), WSP(float2, WS_CS128), PIN(17) + (size_t)l * 3 * D, RSSP(1), rep ? (rss_t*)nullptr : RSSMP(), lds, 64 * (4 * l + 1) + 1};
            pg8::gemm_phase<EpiIn, pg8::StaticOrder>(lds, g, O, E);
#if MK_SPLIT_IN
            { pg8::Gemm g2{WSP(bf16_t, WS_AN), LWP(LW_IN) + (size_t)5888 * D, S, 3 * D, D}; pg8::StaticOrder O2; O2.init(S, 3 * D, G, bx); EpiGate E2{WSP(bf16_t, WS_GATE), PIN(17) + (size_t)l * 3 * D, RSSP(1), lds, 64 * (4 * l + 1) + 1};
              pg8::gemm_phase<EpiGate, pg8::StaticOrder>(lds, g2, O2, E2); }
#endif
            if (BOTH(pb + 2)) GRID_BAR();
        }
        for (int rep = 0; rep < NREP(3); ++rep) if (PH_ON(2 + 3) && IN(pb + 3)) {
            PHASE_BEGIN();
            pg8::Gemm g{WSP(bf16_t, WS_CQR), LWP(LW_UQKV), 2 * S, 1536 + 2048, 512}; MlaOrder O{G, bx}; EpiMlaUp E{WSP(bf16_t, WS_QM), WSP(bf16_t, WS_KM), WSP(bf16_t, WS_VM), WSP(float2, WS_CS64), RSSMP()};
            pg8::gemm_phase<EpiMlaUp, MlaOrder>(lds, g, O, E);
            if (BOTH(pb + 3)) GRID_BAR();
        }
        for (int rep = 0; rep < NREP(4); ++rep) if (PH_ON(2 + 4) && IN(pb + 4)) {
            { PHASE_BEGIN();
              const float* lp = PIN(8) + (size_t)l * 256;
              const float lam = expf(wave_sum(lp[lane] * lp[64 + lane])) - expf(wave_sum(lp[128 + lane] * lp[192 + lane])) + lambda_init;
              for (int r2 = 0; r2 < NREP(60); ++r2) for (int L = bx; L < 256; L += G) diff_unit(WSP(bf16_t, WS_QD), WSP(bf16_t, WS_KD), WSP(bf16_t, WS_VD), WSP(float, WS_ATMP), WSP(bf16_t, WS_OB), PIN(9) + (size_t)l * 128, lam, 1.f - lambda_init, L & 7, L >> 3, (char*)lds_raw); }
            { PHASE_BEGIN();
              for (int r2 = 0; r2 < NREP(61); ++r2) for (int L = bx; L < 256; L += G) mla_unit(WSP(bf16_t, WS_QM), WSP(bf16_t, WS_KM), WSP(bf16_t, WS_VM), WSP(bf16_t, WS_OB) + (size_t)S * 1024, L & 7, L >> 3, (char*)lds_raw); }
            { PHASE_BEGIN();
              for (int r2 = 0; r2 < NREP(62); ++r2) for (int L = bx; L < 256; L += G) gqa_unit(WSP(bf16_t, WS_QG), WSP(bf16_t, WS_KG), WSP(bf16_t, WS_VG), WSP(bf16_t, WS_OB) + (size_t)2 * S * 1024, PIN(14) + (size_t)l * 8, L & 7, L >> 3, (char*)lds_raw); }
            __syncthreads();
            if (BOTH(pb + 4)) GRID_BAR();
        }
        for (int rep = 0; rep < NREP(5); ++rep) if (PH_ON(2 + 5) && IN(pb + 5)) {
            PHASE_BEGIN();
            pg8::Gemm g{WSP(bf16_t, WS_OB), LWP(LW_BR), 3 * S, 3 * D, 1024}; BranchOrder O; O.so.init(S, D, G, bx); EpiBranch E{WSP(bf16_t, WS_GATE), WSP(bf16_t, WS_MG)};
            pg8::gemm_phase<EpiBranch, BranchOrder>(lds, g, O, E);
            if (BOTH(pb + 5)) GRID_BAR();
        }
        for (int rep = 0; rep < NREP(6); ++rep) if (PH_ON(2 + 6) && IN(pb + 6)) {
            PHASE_BEGIN();
            pg8::Gemm g{WSP(bf16_t, WS_MG), LWP(LW_WO), S, D, D}; pg8::StaticOrder O; O.init(S, D, G, bx); EpiResid E{WSP(_Float16, WS_H), WSP(bf16_t, WS_AN), rep ? 0.f : 1.f, rep == 0, RSSP(2), lds};
            pg8::gemm_phase<EpiResid, pg8::StaticOrder>(lds, g, O, E);
            if (BOTH(pb + 6)) GRID_BAR();
        }
        for (int rep = 0; rep < NREP(7); ++rep) if (PH_ON(2 + 7) && IN(pb + 7)) {
            PHASE_BEGIN();
            if (l == 0 && bx >= 64 && bx < 80) {
                pg8::Gemm g{WSP(bf16_t, WS_MEMN), WSP(bf16_t, WS_WXKV), 4 * MEMLEN, 4 * 1024, D}; KvxOrder O{16, bx - 64}; EpiPlain E{WSP(bf16_t, WS_KVX), 1024, 4, nullptr, lds, 0};
                pg8::gemm_phase<EpiPlain, KvxOrder>(lds, g, O, E);
            } else if (bx >= 80) {
                if (l + 1 < DEPTH && rep == 0) cvt_layer_part(PT, ws, l + 1, 2, (LAS float*)(lds + wave * 16384), (bx - 80) * NWAVES + wave, (G - 80) * NWAVES, lane);
            } else {
            pg8::Gemm g{WSP(bf16_t, WS_AN), LWP(LW_XQ), S, 512, D}; pg8::StaticOrder O; O.init(S, 512, G, bx); EpiPlain E{WSP(bf16_t, WS_QX), 512, 0, RSSP(2), lds, 64 * (4 * l + 2) + 1, QS_128};
            pg8::gemm_phase<EpiPlain, pg8::StaticOrder>(lds, g, O, E);
            }
            if (BOTH(pb + 7)) GRID_BAR();
        }
        for (int rep = 0; rep < NREP(8); ++rep) if (PH_ON(2 + 8) && IN(pb + 8)) {
            PHASE_BEGIN();
            for (int L = bx; L < 128; L += G) xattn_unit(WSP(bf16_t, WS_QX), WSP(bf16_t, WS_KVX) + (size_t)l * MEMLEN * 1024, WSP(bf16_t, WS_OX), L & 3, L >> 2, (char*)lds_raw);
            __syncthreads();
            if (BOTH(pb + 8)) GRID_BAR();
        }
        for (int rep = 0; rep < NREP(9); ++rep) if (PH_ON(2 + 9) && IN(pb + 9)) {
            PHASE_BEGIN();
            pg8::Gemm g{WSP(bf16_t, WS_OX), LWP(LW_XO), S, D, 512}; pg8::StaticOrder O; O.init(S, D, G, bx); EpiResid E{WSP(_Float16, WS_H), WSP(bf16_t, WS_AN), rep ? 0.f : 1.f, rep == 0, RSSP(3), lds};
            pg8::gemm_phase<EpiResid, pg8::StaticOrder>(lds, g, O, E);
            if (BOTH(pb + 9)) GRID_BAR();
        }
        for (int rep = 0; rep < NREP(10); ++rep) if (PH_ON(2 + 10) && IN(pb + 10)) {
            PHASE_BEGIN();
            const int gg = (l + 1 < DEPTH && rep == 0) ? G - CVT_WG : G;
            if (bx >= gg) cvt_layer_part(PT, ws, l + 1, 1, (LAS float*)(lds + wave * 16384), (bx - gg) * NWAVES + wave, CVT_WG * NWAVES, lane);
            else {
            pg8::Gemm g{WSP(bf16_t, WS_AN), LWP(LW_GU2), S, 2 * DFF, D}; pg8::StaticOrder O; O.init(S, 2 * DFF, gg, bx); EpiSwiglu E{WSP(bf16_t, WS_HID), RSSP(3), lds, 64 * (4 * l + 3) + 1};
            pg8::gemm_phase<EpiSwiglu, pg8::StaticOrder>(lds, g, O, E);
            }
            if (BOTH(pb + 10)) GRID_BAR();
        }
        for (int rep = 0; rep < NREP(11); ++rep) if (PH_ON(2 + 11) && IN(pb + 11)) {
            PHASE_BEGIN();
            pg8::Gemm g{WSP(bf16_t, WS_HID), LWP(LW_DN2), S, D, DFF}; pg8::StaticOrder O; O.init(S, D, G, bx); EpiResid E{WSP(_Float16, WS_H), WSP(bf16_t, WS_AN), rep ? 0.f : 0.5f, rep == 0, RSSP(4), lds};
            pg8::gemm_phase<EpiResid, pg8::StaticOrder>(lds, g, O, E);
            if (BOTH(pb + 11)) GRID_BAR();
        }
#undef LWP
#undef RSSP
#undef RSSMP
    }
    if (PH_ON(14) && IN(2 + DEPTH * PH_PER_LAYER)) {
        PHASE_BEGIN();
        const _Float16* H16 = WSP(_Float16, WS_H); const float* fg = PIN(27); float* out = (float*)ldptr(PT, 28);
        f32x4 fgv[4][2];
#pragma unroll
        for (int j = 0; j < 4; ++j)
#pragma unroll
            for (int e = 0; e < 2; ++e) fgv[j][e] = *(const GAS f32x4*)(fg + (64 * j + lane) * 8 + 4 * e);
        for (int m = gw; m < S; m += NGW) {
            const GAS h16x8* ar = (const GAS h16x8*)(H16 + (size_t)m * D) + lane; f32x8e v[4]; float s = 0.f;
#pragma unroll
            for (int j = 0; j < 4; ++j) { v[j] = __builtin_convertvector(ar[64 * j], f32x8e);
#pragma unroll
                for (int e = 0; e < 8; ++e) s += v[j][e] * v[j][e]; }
            const float r = rsqrtf(wave_sum(s) * (1.f / D) + 1e-6f);
#pragma unroll
            for (int j = 0; j < 4; ++j)
#pragma unroll
                for (int e = 0; e < 2; ++e) { const int c = (64 * j + lane) * 8 + 4 * e; const f32x4 g = fgv[j][e];
                    const f32x4 vv = {v[j][4 * e], v[j][4 * e + 1], v[j][4 * e + 2], v[j][4 * e + 3]}; *(GAS f32x4*)(out + (size_t)m * D + c) = vv * r * g; } }
    }
#if !MK_PER_PHASE && MK_STAMP >= 0
    if (bx == 0) { const unsigned long long te = __builtin_amdgcn_s_memrealtime(), wait = (st1 - st0) * 16ull; while (__builtin_amdgcn_s_memrealtime() - te < wait) __builtin_amdgcn_s_sleep(8); }
#endif
#undef IN
#undef BOTH
}
}

extern "C" void kernel_launch(void* const* d_in, const int* in_sizes, int n_in, void* d_out, int out_size, void* d_ws, size_t ws_size, hipStream_t stream) {
    using namespace mk;
    static int grid = 0;
    if (grid == 0) {
        if (n_in != 28 || out_size != S * D || ws_size < WS_END) { fprintf(stderr, "kernel_launch: unexpected n_in %d out %d ws %zu (need %zu)\n", n_in, out_size, ws_size, (size_t)WS_END); grid = -1; return; }
        int dev = 0, cus = 0, per_cu = 0;
        if (hipGetDevice(&dev) != hipSuccess || hipDeviceGetAttribute(&cus, hipDeviceAttributeMultiprocessorCount, dev) != hipSuccess) { grid = -1; return; }
        if (hipFuncSetAttribute((const void*)mega, hipFuncAttributeMaxDynamicSharedMemorySize, LDS_BYTES) != hipSuccess) { fprintf(stderr, "kernel_launch: hipFuncSetAttribute failed\n"); grid = -1; return; }
        if (hipOccupancyMaxActiveBlocksPerMultiprocessor(&per_cu, (const void*)mega, NWAVES * 64, LDS_BYTES) != hipSuccess || per_cu < 1) { fprintf(stderr, "kernel_launch: occupancy query says %d\n", per_cu); }
        (void)hipGetLastError();
        grid = cus;
    }
    if (grid < 0) return;
    (void)hipMemsetAsync((char*)d_ws + WS_CTL, 0, CTL_ZERO_BYTES, stream);
    Args a{};
    for (int i = 0; i < 28; ++i) a.in[i] = d_in[i];
    a.out = (float*)d_out; a.ws = (unsigned char*)d_ws;
#if MK_PER_PHASE
    for (int p = 0; p < N_PHASES; ++p) { a.ph_lo = p; a.ph_hi = p + 1; hipLaunchKernelGGL(mega, dim3(grid), dim3(NWAVES * 64), LDS_BYTES, stream, a); }
#else
    a.ph_lo = 0; a.ph_hi = N_PHASES; hipLaunchKernelGGL(mega, dim3(grid), dim3(NWAVES * 64), LDS_BYTES, stream, a);
#endif
    const hipError_t le = hipPeekAtLastError();
    if (le != hipSuccess) fprintf(stderr, "kernel_launch: launch failed: %s\n", hipGetErrorName(le));
}
```
